# Optimizing an MI355X kernel written in HIP

```python
import math
import jax
import jax.numpy as jnp
from jax import lax
import numpy as np

D_MODEL = 1024
BATCH = 2
SEQ = 8192
DEPTH = 4

ATTN_HEADS = 8
HEAD_DIM = 64
D_ATTN = ATTN_HEADS * HEAD_DIM
RNN_BLOCKS = 8
D_RNN = 512
RNN_BLOCK_W = D_RNN // RNN_BLOCKS
D_MIX = D_ATTN + D_RNN
D_IN = 3 * D_ATTN + 2 * D_RNN
DILATED_BRANCHES = ((128, 1), (512, 4), (2048, 16))
Q_BLOCK = 128
REL_BUCKETS = 32
REL_MAX_DIST = 2048
CONV_WIDTH = 4
RG_C = 8.0
N_GROUPS = 4
EXPERTS_PER_GROUP = 8
N_EXPERTS = N_GROUPS * EXPERTS_PER_GROUP
TOP_K = 2
D_EXPERT = 512
MOE_BLOCK = 128
EPS = 1e-6
NEG_INF = -1e30

kernel_name = 'hymba_dilated_rglru_hmoe'


def rms_norm(x, gain):
    xf = x.astype(jnp.float32)
    y = xf * lax.rsqrt(jnp.mean(xf * xf, axis=-1, keepdims=True) + EPS)
    return (y * gain.astype(jnp.float32)).astype(x.dtype)


def t5_bucket(dist):
    exact = REL_BUCKETS // 2
    d = jnp.maximum(dist, 1).astype(jnp.float32)
    log_b = exact + (jnp.log(d / exact) / math.log(REL_MAX_DIST / exact) * (REL_BUCKETS - exact)).astype(jnp.int32)
    return jnp.where(dist < exact, dist, jnp.minimum(log_b, REL_BUCKETS - 1))


def dilated_branch(q, k, v, rel_table, window, dil):
    b, s, h, e = q.shape
    span = dil * Q_BLOCK
    s_pad = -(-s // span) * span
    n_blk = s_pad // span
    sub_len = s_pad // dil
    pad = ((0, 0), (0, s_pad - s), (0, 0), (0, 0))
    qb = jnp.pad(q, pad).reshape(b, n_blk, Q_BLOCK, dil, h, e)

    def key_windows(t):
        t = jnp.pad(t, pad).reshape(b, sub_len, dil, h, e)
        t = jnp.pad(t, ((0, 0), (Q_BLOCK, 0), (0, 0), (0, 0), (0, 0)))
        t = t.reshape(b, n_blk + 1, Q_BLOCK, dil, h, e)
        return jnp.concatenate([t[:, :-1], t[:, 1:]], axis=2)

    kw = key_windows(k)
    vw = key_windows(v)
    j_idx = jnp.arange(2 * Q_BLOCK)
    steps = jnp.arange(Q_BLOCK)[:, None] + Q_BLOCK - j_idx[None, :]
    band = (steps >= 0) & (steps <= window // dil)
    first = (jnp.arange(n_blk)[:, None, None] == 0) & (j_idx[None, None, :] < Q_BLOCK)
    valid = band[None] & ~first
    bias = rel_table[t5_bucket(jnp.maximum(steps, 0) * dil)]
    bias = jnp.transpose(bias, (2, 0, 1)).astype(jnp.float32)
    logits = jnp.einsum('bnirhe,bnjrhe->bnrhij', qb, kw).astype(jnp.float32) + bias
    logits = jnp.where(valid[None, :, None, None], logits, NEG_INF)
    m = jnp.max(logits, axis=-1, keepdims=True)
    p = jnp.exp(logits - m)
    denom = jnp.sum(p, axis=-1, keepdims=True)
    o = jnp.einsum('bnrhij,bnjrhe->bnirhe', (p / denom).astype(v.dtype), vw)
    lse = (m + jnp.log(denom))[..., 0]
    o = o.reshape(b, s_pad, h, e)[:, :s]
    lse = jnp.transpose(lse, (0, 1, 4, 2, 3)).reshape(b, s_pad, h)[:, :s]
    return o, lse


def dilated_attention(q, k, v, rel_table):
    outs = []
    lses = []
    for window, dil in DILATED_BRANCHES:
        o, lse = dilated_branch(q, k, v, rel_table, window, dil)
        outs.append(o)
        lses.append(lse)
    w = jax.nn.softmax(jnp.stack(lses, axis=-1), axis=-1)
    o = sum(outs[i].astype(jnp.float32) * w[..., i, None] for i in range(len(outs)))
    return o.astype(q.dtype)


def lru_combine(left, right):
    a_l, b_l = left
    a_r, b_r = right
    return a_l * a_r, a_r * b_l + b_r


def rglru_branch(xr, gr, conv_w, conv_b, w_a, b_a, w_x, b_x, lam):
    b, s, c = xr.shape
    u = lax.conv_general_dilated(xr, conv_w[:, None, :], window_strides=(1,),
                                 padding=((CONV_WIDTH - 1, 0),),
                                 dimension_numbers=('NWC', 'WIO', 'NWC'),
                                 feature_group_count=c) + conv_b
    ub = u.reshape(b, s, RNN_BLOCKS, RNN_BLOCK_W)
    r = jax.nn.sigmoid(jnp.einsum('bsgi,gij->bsgj', ub, w_a) + b_a).reshape(b, s, c)
    i = jax.nn.sigmoid(jnp.einsum('bsgi,gij->bsgj', ub, w_x) + b_x).reshape(b, s, c)
    log_a = -RG_C * r.astype(jnp.float32) * jax.nn.softplus(-lam.astype(jnp.float32))
    a = jnp.exp(log_a)
    drive = jnp.sqrt(-jnp.expm1(2.0 * log_a)) * (i * u).astype(jnp.float32)
    _, hseq = lax.associative_scan(lru_combine, (a, drive), axis=1)
    return hseq.astype(xr.dtype) * jax.nn.gelu(gr)


def expert_mlp(xb, wg, wu, wd):
    return (jax.nn.silu(xb @ wg) * (xb @ wu)) @ wd


def hier_moe(h, wr_g, br_g, wr_e, br_e, w_gate, w_up, w_down):
    b, s, d = h.shape
    m = b * s
    hf = h.reshape(m, d)
    g_logits = (hf @ wr_g + br_g).astype(jnp.float32)
    _, g_sel = lax.top_k(g_logits, 1)
    g_w = jnp.take_along_axis(jax.nn.softmax(g_logits, axis=-1), g_sel, axis=-1)
    e_logits = (hf @ wr_e + br_e).astype(jnp.float32).reshape(m, N_GROUPS, EXPERTS_PER_GROUP)
    e_logits = jnp.take_along_axis(e_logits, g_sel[:, :, None], axis=1)[:, 0]
    e_top, e_idx = lax.top_k(e_logits, TOP_K)
    gate = (g_w * jax.nn.softmax(e_top, axis=-1)).reshape(-1)
    expert = (g_sel * EXPERTS_PER_GROUP + e_idx).reshape(-1)
    token = jnp.repeat(jnp.arange(m), TOP_K)
    n_assign = m * TOP_K
    order = jnp.argsort(expert)
    e_sorted = expert[order]
    tok_sorted = token[order]
    counts = jnp.zeros((N_EXPERTS,), jnp.int32).at[expert].add(1)
    padded = (counts + MOE_BLOCK - 1) // MOE_BLOCK * MOE_BLOCK
    starts = jnp.cumsum(counts) - counts
    p_ends = jnp.cumsum(padded)
    p_starts = p_ends - padded
    dest = p_starts[e_sorted] + jnp.arange(n_assign) - starts[e_sorted]
    n_rows = n_assign + N_EXPERTS * MOE_BLOCK
    n_blocks = n_rows // MOE_BLOCK
    rows = jnp.zeros((n_rows, d), h.dtype).at[dest].set(hf[tok_sorted])
    block_expert = jnp.minimum(
        jnp.searchsorted(p_ends, jnp.arange(n_blocks) * MOE_BLOCK, side='right'), N_EXPERTS - 1)

    def run_block(args):
        xb, e = args
        return expert_mlp(xb, w_gate[e], w_up[e], w_down[e])

    out_rows = lax.map(run_block, (rows.reshape(n_blocks, MOE_BLOCK, d), block_expert)).reshape(n_rows, d)
    contrib = (out_rows[dest].astype(jnp.float32) * gate[order][:, None]).astype(h.dtype)
    return jnp.zeros((m, d), h.dtype).at[tok_sorted].add(contrib).reshape(b, s, d)


def setup_inputs(seed: int = 0) -> dict:
    key = jax.random.key(seed)
    ks = jax.random.split(key, 24)
    f32 = jnp.float32

    def nrm(k, shape, scale):
        return jax.random.normal(k, shape, f32) * scale

    def gain(k, shape):
        return 1.0 + 0.01 * jax.random.normal(k, shape, f32)

    a0 = jax.random.uniform(ks[12], (DEPTH, D_RNN), f32, minval=0.9, maxval=0.999)
    return {
        'x': nrm(ks[0], (BATCH, SEQ, D_MODEL), 1.0),
        'rel_bias_table': nrm(ks[1], (REL_BUCKETS, ATTN_HEADS), 0.2),
        'norm_mix': gain(ks[2], (DEPTH, D_MODEL)),
        'w_in': nrm(ks[3], (DEPTH, D_MODEL, D_IN), D_MODEL ** -0.5),
        'q_norm': gain(ks[4], (DEPTH, HEAD_DIM)),
        'k_norm': gain(ks[5], (DEPTH, HEAD_DIM)),
        'conv_w': nrm(ks[6], (DEPTH, CONV_WIDTH, D_RNN), CONV_WIDTH ** -0.5),
        'conv_b': nrm(ks[7], (DEPTH, D_RNN), 0.01),
        'rg_w_a': nrm(ks[8], (DEPTH, RNN_BLOCKS, RNN_BLOCK_W, RNN_BLOCK_W), RNN_BLOCK_W ** -0.5),
        'rg_b_a': nrm(ks[9], (DEPTH, RNN_BLOCKS, RNN_BLOCK_W), 0.01),
        'rg_w_x': nrm(ks[10], (DEPTH, RNN_BLOCKS, RNN_BLOCK_W, RNN_BLOCK_W), RNN_BLOCK_W ** -0.5),
        'rg_b_x': nrm(ks[11], (DEPTH, RNN_BLOCKS, RNN_BLOCK_W), 0.01),
        'rg_lambda': jnp.log(a0) - jnp.log1p(-a0),
        'norm_attn_out': gain(ks[13], (DEPTH, D_ATTN)),
        'norm_rnn_out': gain(ks[14], (DEPTH, D_RNN)),
        'w_out': nrm(ks[15], (DEPTH, D_MIX, D_MODEL), D_MIX ** -0.5),
        'norm_ffn': gain(ks[16], (DEPTH, D_MODEL)),
        'router_group_w': nrm(ks[17], (DEPTH, D_MODEL, N_GROUPS), D_MODEL ** -0.5),
        'router_group_b': nrm(ks[18], (DEPTH, N_GROUPS), 0.01),
        'router_expert_w': nrm(ks[19], (DEPTH, D_MODEL, N_EXPERTS), D_MODEL ** -0.5),
        'router_expert_b': nrm(ks[20], (DEPTH, N_EXPERTS), 0.01),
        'expert_w_gate': nrm(ks[21], (DEPTH, N_EXPERTS, D_MODEL, D_EXPERT), D_MODEL ** -0.5),
        'expert_w_up': nrm(ks[22], (DEPTH, N_EXPERTS, D_MODEL, D_EXPERT), D_MODEL ** -0.5),
        'expert_w_down': nrm(ks[23], (DEPTH, N_EXPERTS, D_EXPERT, D_MODEL), D_EXPERT ** -0.5),
    }


def reference(x, rel_bias_table, norm_mix, w_in, q_norm, k_norm, conv_w, conv_b,
              rg_w_a, rg_b_a, rg_w_x, rg_b_x, rg_lambda, norm_attn_out, norm_rnn_out,
              w_out, norm_ffn, router_group_w, router_group_b, router_expert_w,
              router_expert_b, expert_w_gate, expert_w_up, expert_w_down):
    b, s, _ = x.shape
    scale = HEAD_DIM ** -0.5
    splits = [D_ATTN, 2 * D_ATTN, 3 * D_ATTN, 3 * D_ATTN + D_RNN]
    for l in range(DEPTH):
        hn = rms_norm(x, norm_mix[l])
        z = hn @ w_in[l]
        q, k, v, xr, gr = jnp.split(z, splits, axis=-1)
        q = rms_norm(q.reshape(b, s, ATTN_HEADS, HEAD_DIM), q_norm[l]) * scale
        k = rms_norm(k.reshape(b, s, ATTN_HEADS, HEAD_DIM), k_norm[l])
        v = v.reshape(b, s, ATTN_HEADS, HEAD_DIM)
        attn = dilated_attention(q, k, v, rel_bias_table).reshape(b, s, D_ATTN)
        rnn = rglru_branch(xr, gr, conv_w[l], conv_b[l], rg_w_a[l], rg_b_a[l],
                           rg_w_x[l], rg_b_x[l], rg_lambda[l])
        mix = jnp.concatenate([rms_norm(attn, norm_attn_out[l]), rms_norm(rnn, norm_rnn_out[l])], axis=-1)
        x = x + mix @ w_out[l]
        x = x + hier_moe(rms_norm(x, norm_ffn[l]), router_group_w[l], router_group_b[l],
                         router_expert_w[l], router_expert_b[l], expert_w_gate[l],
                         expert_w_up[l], expert_w_down[l])
    return x
```

```cpp
#include <hip/hip_runtime.h>
#include <cstdio>
#include <cstdint>
#include <cmath>

namespace {
constexpr int BATCH = 2, SEQ = 8192, M = BATCH * SEQ, D = 1024, DEPTH = 4;
constexpr int NH = 8, HD = 64, DA = 512, DR = 512, DIN = 2560;
constexpr int NE = 32, EPG = 8, NG = 4, DE = 512;
constexpr float EPS = 1e-6f;

__device__ __forceinline__ float wave_sum(float v) {
#pragma unroll
    for (int o = 1; o < 64; o <<= 1) v += __shfl_xor(v, o);
    return v;
}
__device__ __forceinline__ float wave_max(float v) {
#pragma unroll
    for (int o = 1; o < 64; o <<= 1) v = fmaxf(v, __shfl_xor(v, o));
    return v;
}

__global__ void k_rmsnorm(const float* x, int ldx, float* out, int ldo, const float* gain, int W, int rows, float post) {
    const int row = blockIdx.x * (blockDim.x / 64) + (threadIdx.x >> 6), lane = threadIdx.x & 63;
    if (row >= rows) return;
    const float* xr = x + (size_t)row * ldx; float s = 0.f;
    for (int i = lane; i < W; i += 64) { const float v = xr[i]; s += v * v; }
    s = wave_sum(s);
    const float r = rsqrtf(s / W + EPS) * post;
    for (int i = lane; i < W; i += 64) out[(size_t)row * ldo + i] = xr[i] * r * gain[i];
}

__global__ void __launch_bounds__(256) k_gemm(const float* A, int lda, const float* B, int ldb, size_t bstride, float* C, int ldc, const float* R, int Mrows, int N, int K,
                                               const int* list, const int* counts, int ashift) {
    __shared__ float As[16][65];
    __shared__ float Bs[16][64];
    int rows = Mrows; const int* lst = nullptr;
    if (list) { const int e = blockIdx.z; rows = counts[e]; lst = list + (size_t)e * M; B += (size_t)e * bstride; }
    const int m0 = blockIdx.y * 64, n0 = blockIdx.x * 64;
    if (m0 >= rows) return;
    const int tid = threadIdx.x, tx = tid & 15, ty = tid >> 4;
    float acc[4][4];
#pragma unroll
    for (int i = 0; i < 4; ++i)
#pragma unroll
        for (int j = 0; j < 4; ++j) acc[i][j] = 0.f;
    const int ar = tid >> 2, ak = (tid & 3) * 4;
    int arow_g = -1;
    { const int m = m0 + ar; if (m < rows) arow_g = lst ? (lst[m] >> ashift) : m; }
    const int bk = tid >> 4, bn = (tid & 15) * 4;
    for (int k0 = 0; k0 < K; k0 += 16) {
        float4 av = make_float4(0.f, 0.f, 0.f, 0.f);
        if (arow_g >= 0) av = *(const float4*)(A + (size_t)arow_g * lda + k0 + ak);
        const float4 bv = *(const float4*)(B + (size_t)(k0 + bk) * ldb + n0 + bn);
        __syncthreads();
        As[ak + 0][ar] = av.x; As[ak + 1][ar] = av.y; As[ak + 2][ar] = av.z; As[ak + 3][ar] = av.w;
        *(float4*)&Bs[bk][bn] = bv;
        __syncthreads();
#pragma unroll
        for (int k = 0; k < 16; ++k) {
            float a[4], b[4];
#pragma unroll
            for (int i = 0; i < 4; ++i) a[i] = As[k][ty * 4 + i];
#pragma unroll
            for (int j = 0; j < 4; ++j) b[j] = Bs[k][tx * 4 + j];
#pragma unroll
            for (int i = 0; i < 4; ++i)
#pragma unroll
                for (int j = 0; j < 4; ++j) acc[i][j] += a[i] * b[j];
        }
    }
#pragma unroll
    for (int i = 0; i < 4; ++i) {
        const int m = m0 + ty * 4 + i; if (m >= rows) continue;
        const int cr = lst ? lst[m] : m;
        float4 o = make_float4(acc[i][0], acc[i][1], acc[i][2], acc[i][3]);
        if (R) { const float4 r = *(const float4*)(R + (size_t)cr * ldc + n0 + tx * 4); o.x += r.x; o.y += r.y; o.z += r.z; o.w += r.w; }
        *(float4*)(C + (size_t)cr * ldc + n0 + tx * 4) = o;
    }
}

__global__ void k_qknorm(float* Z, const float* qn, const float* kn, float scale) {
    const int w = blockIdx.x * (blockDim.x / 64) + (threadIdx.x >> 6), lane = threadIdx.x & 63;
    if (w >= M * 16) return;
    const int t = w / 16, r = w % 16, which = r / 8, h = r % 8;
    float* p = Z + (size_t)t * DIN + which * DA + h * HD;
    const float v = p[lane]; const float s = wave_sum(v * v);
    const float g = which ? kn[lane] : qn[lane] * scale;
    p[lane] = v * rsqrtf(s / HD + EPS) * g;
}

__device__ __forceinline__ int t5_bucket(int dist) {
    if (dist < 16) return dist;
    const float d = (float)dist;
    int lb = 16 + (int)(logf(d / 16.f) / logf(128.f) * 16.f);
    return lb < 31 ? lb : 31;
}

__global__ void __launch_bounds__(256) k_attn(const float* Z, const float* rel, float* ATT) {
    __shared__ float qs[4][64];
    __shared__ float ps[4][132];
    const int wl = threadIdx.x >> 6, lane = threadIdx.x & 63;
    const int w = blockIdx.x * 4 + wl;
    const int tok = w / NH, h = w % NH, b = tok / SEQ, t = tok % SEQ;
    qs[wl][lane] = Z[(size_t)tok * DIN + h * HD + lane];
    __syncthreads();
    float ob[3], lse[3];
#pragma unroll
    for (int br = 0; br < 3; ++br) {
        const int dil = (br == 0) ? 1 : (br == 1) ? 4 : 16;
        float lg[3]; float mx = -1e30f;
#pragma unroll
        for (int it = 0; it < 3; ++it) {
            const int n = lane + it * 64; lg[it] = -1e30f;
            if (n <= 128) { const int pos = t - n * dil;
                if (pos >= 0) { const float* kp = Z + (size_t)(b * SEQ + pos) * DIN + DA + h * HD; float s = 0.f;
                    for (int d = 0; d < 64; ++d) s += qs[wl][d] * kp[d];
                    lg[it] = s + rel[t5_bucket(n * dil) * NH + h]; } }
            mx = fmaxf(mx, lg[it]);
        }
        mx = wave_max(mx);
        float den = 0.f;
#pragma unroll
        for (int it = 0; it < 3; ++it) { const int n = lane + it * 64; if (n <= 128) { const float p = (lg[it] > -1e29f) ? expf(lg[it] - mx) : 0.f; ps[wl][n] = p; den += p; } }
        den = wave_sum(den);
        __syncthreads();
        float o = 0.f;
        for (int n = 0; n <= 128; ++n) { const int pos = t - n * dil; if (pos < 0) break; o += ps[wl][n] * Z[(size_t)(b * SEQ + pos) * DIN + 2 * DA + h * HD + lane]; }
        __syncthreads();
        ob[br] = o / den; lse[br] = mx + logf(den);
    }
    const float ml = fmaxf(lse[0], fmaxf(lse[1], lse[2]));
    const float w0 = expf(lse[0] - ml), w1 = expf(lse[1] - ml), w2 = expf(lse[2] - ml), ws = w0 + w1 + w2;
    ATT[(size_t)tok * DA + h * HD + lane] = (ob[0] * w0 + ob[1] * w1 + ob[2] * w2) / ws;
}

__global__ void k_conv(const float* Z, const float* cw, const float* cb, float* U) {
    const size_t i = (size_t)blockIdx.x * blockDim.x + threadIdx.x; if (i >= (size_t)M * DR) return;
    const int tok = (int)(i / DR), c = (int)(i % DR), t = tok % SEQ;
    float s = cb[c];
    for (int w = 0; w < 4; ++w) { const int tt = t + w - 3; if (tt >= 0) s += cw[w * DR + c] * Z[(size_t)(tok + w - 3) * DIN + 3 * DA + c]; }
    U[i] = s;
}
__global__ void k_gates(const float* U, const float* wa, const float* ba, const float* wx, const float* bx, const float* lam, float* Aa, float* Dv) {
    const size_t i = (size_t)blockIdx.x * blockDim.x + threadIdx.x; if (i >= (size_t)M * DR) return;
    const int tok = (int)(i / DR), c = (int)(i % DR), g = c / 64, j = c % 64;
    const float* u = U + (size_t)tok * DR + g * 64;
    float sr = ba[c], si = bx[c];
    for (int k = 0; k < 64; ++k) { const float uv = u[k]; sr += uv * wa[(g * 64 + k) * 64 + j]; si += uv * wx[(g * 64 + k) * 64 + j]; }
    const float r = 1.f / (1.f + expf(-sr)), ig = 1.f / (1.f + expf(-si));
    const float l = -lam[c]; const float sp = fmaxf(l, 0.f) + log1pf(expf(-fabsf(l)));
    const float la = -8.f * r * sp;
    Aa[i] = expf(la); Dv[i] = sqrtf(-expm1f(2.f * la)) * (ig * u[j]);
}
__device__ __forceinline__ float gelu_tanh(float x) { return 0.5f * x * (1.f + tanhf(0.7978845608028654f * (x + 0.044715f * x * x * x))); }
__global__ void k_scan(const float* Aa, const float* Dv, const float* Z, float* R) {
    const int i = blockIdx.x * blockDim.x + threadIdx.x; if (i >= BATCH * DR) return;
    const int b = i / DR, c = i % DR; float h = 0.f;
    for (int t = 0; t < SEQ; ++t) { const size_t o = (size_t)(b * SEQ + t) * DR + c; h = Aa[o] * h + Dv[o];
        R[o] = h * gelu_tanh(Z[(size_t)(b * SEQ + t) * DIN + 3 * DA + DR + c]); }
}

__global__ void __launch_bounds__(256) k_router(const float* H2, const float* wg, const float* bg, const float* we, const float* be, int* eid, float* gatev, int* counts, int* list) {
    const int tok = blockIdx.x * 4 + (threadIdx.x >> 6), lane = threadIdx.x & 63;
    float acc[36];
#pragma unroll
    for (int j = 0; j < 36; ++j) acc[j] = 0.f;
    for (int k = lane; k < D; k += 64) { const float hv = H2[(size_t)tok * D + k];
#pragma unroll
        for (int j = 0; j < 4; ++j) acc[j] += hv * wg[k * 4 + j];
#pragma unroll
        for (int j = 0; j < 32; ++j) acc[4 + j] += hv * we[k * 32 + j]; }
#pragma unroll
    for (int j = 0; j < 36; ++j) acc[j] = wave_sum(acc[j]);
    {
        float gl[4];
#pragma unroll
        for (int j = 0; j < 4; ++j) gl[j] = acc[j] + bg[j];
        int gs = 0; float gm = gl[0];
#pragma unroll
        for (int j = 1; j < 4; ++j) if (gl[j] > gm) { gm = gl[j]; gs = j; }
        float den = 0.f;
#pragma unroll
        for (int j = 0; j < 4; ++j) den += expf(gl[j] - gm);
        const float gw = 1.f / den;
        float el[8];
#pragma unroll
        for (int j = 0; j < 8; ++j) el[j] = (gs == 0 ? acc[4 + j] : gs == 1 ? acc[12 + j] : gs == 2 ? acc[20 + j] : acc[28 + j]) + be[gs * 8 + j];
        int i0 = 0; float m0 = el[0];
#pragma unroll
        for (int j = 1; j < 8; ++j) if (el[j] > m0) { m0 = el[j]; i0 = j; }
        int i1 = -1; float m1 = -3.0e38f;
#pragma unroll
        for (int j = 0; j < 8; ++j) if (j != i0 && el[j] > m1) { m1 = el[j]; i1 = j; }
        const float e1 = expf(m1 - m0); const float p0 = 1.f / (1.f + e1), p1 = e1 / (1.f + e1);
        const int ex0 = gs * 8 + i0, ex1 = gs * 8 + i1;
        if (lane == 0) {
            eid[tok * 2] = ex0; eid[tok * 2 + 1] = ex1; gatev[tok * 2] = gw * p0; gatev[tok * 2 + 1] = gw * p1;
            const int r0 = atomicAdd(&counts[ex0], 1); list[(size_t)ex0 * M + r0] = tok * 2;
            const int r1 = atomicAdd(&counts[ex1], 1); list[(size_t)ex1 * M + r1] = tok * 2 + 1;
        }
    }
}
__global__ void k_silumul(float* G, const float* U, size_t n) {
    const size_t i = (size_t)blockIdx.x * blockDim.x + threadIdx.x; if (i >= n) return;
    const float g = G[i]; G[i] = g / (1.f + expf(-g)) * U[i];
}
__global__ void k_combine(float* X, const float* Y, const float* gatev) {
    const size_t i = (size_t)blockIdx.x * blockDim.x + threadIdx.x; if (i >= (size_t)M * D) return;
    const int tok = (int)(i / D), c = (int)(i % D);
    X[i] = X[i] + (gatev[tok * 2] * Y[(size_t)(tok * 2) * D + c] + gatev[tok * 2 + 1] * Y[(size_t)(tok * 2 + 1) * D + c]);
}

#define LAS __attribute__((address_space(3)))
typedef unsigned short bf16_t;
typedef short bf16x8 __attribute__((ext_vector_type(8)));
typedef short s16x4 __attribute__((ext_vector_type(4)));
typedef float f32x4 __attribute__((ext_vector_type(4)));
typedef float f32x16 __attribute__((ext_vector_type(16)));
typedef unsigned u32x4 __attribute__((ext_vector_type(4)));
typedef unsigned u32x2 __attribute__((ext_vector_type(2)));
__device__ __forceinline__ unsigned cvt_pk_bf16(float lo, float hi) { unsigned r; asm volatile("v_cvt_pk_bf16_f32 %0, %1, %2" : "=v"(r) : "v"(lo), "v"(hi)); return r; }
__device__ __forceinline__ float bf_lo(unsigned w) { return __uint_as_float(w << 16); }
__device__ __forceinline__ float bf_hi(unsigned w) { return __uint_as_float(w & 0xffff0000u); }
__device__ __forceinline__ float bf2f(bf16_t v) { return __uint_as_float(((unsigned)v) << 16); }

constexpr float LOG2E = 1.4426950408889634f;
constexpr size_t MiB = 1ull << 20;
constexpr size_t WS_CTL = 0, CTL_ZERO = 128 * 1024;
constexpr size_t WS_CNT = 64 * 1024;
constexpr size_t WS_BT = 1 * MiB;
constexpr size_t WS_GQK = 1 * MiB + 64 * 1024;
constexpr size_t WS_SPL = 1 * MiB + 128 * 1024;
constexpr size_t WS_RT = 2 * MiB;
constexpr size_t WS_WAT = 3 * MiB;
constexpr size_t WS_WIN = 4 * MiB;
constexpr size_t WS_WOUT = 24 * MiB;
constexpr size_t WS_WGU = 32 * MiB;
constexpr size_t WS_WD = 288 * MiB;
constexpr size_t WS_HN = 416 * MiB;
constexpr size_t WS_ZB = 448 * MiB;
constexpr size_t WS_OB = 528 * MiB;
constexpr size_t WS_LSE = 576 * MiB;
constexpr size_t WS_AGG = 578 * MiB;
constexpr size_t WS_MIX = 580 * MiB;
constexpr size_t WS_TOK = 612 * MiB;
constexpr size_t WS_LIST = 613 * MiB;
constexpr size_t WS_ACT = 616 * MiB;
constexpr size_t WS_Y = 656 * MiB;
constexpr size_t WS_END = 736 * MiB;
constexpr int MAXTILES = 160;
constexpr int LDS_BYTES = 160 * 1024;
constexpr int LDS_STAGE = 0;
constexpr int LDS_TAB = 131072;
constexpr int LDS_MISC = LDS_BYTES - 256;

namespace pg8 {
constexpr int BM = 256, BK = 64, HALF = 128, HTB = HALF * BK * 2, STAGE_BYTES = 8 * HTB, NXCD = 8, WGM = 8;
__host__ __device__ __forceinline__ int lds_byte(int r, int c) { const int st = (r >> 4) * 2 + (c >> 5), rr = r & 15, cc = c & 31, ob = rr * 64 + cc * 2; return st * 1024 + (ob ^ (((ob >> 9) & 1) << 5)); }
__host__ __device__ __forceinline__ void stage_rc(int b, int& R, int& C) { const int st = b / 1024, sb = b % 1024, swz = sb ^ (((sb >> 9) & 1) << 5); R = (st >> 1) * 16 + swz / 64; C = (st & 1) * 32 + (swz % 64) / 2; }
__host__ __device__ __forceinline__ int perm32(int rho) { const int n = rho >> 4, i = rho & 15; return 8 * (i >> 2) + 4 * n + (i & 3); }

struct Unit { int pm, pn; const char* a; const char* b; const int* glist; int gcount; };

struct StaticOrder {
    int nM, nN, nwg, G, c; const char* A; const char* Bt; size_t tA, tB;
    __device__ void init(const bf16_t* A_, const bf16_t* Bt_, int M_, int N_, int K_, int G_, int c_) { nM = M_ / BM; nN = N_ / BM; nwg = nM * nN; G = G_; c = c_; A = (const char*)A_; Bt = (const char*)Bt_; tA = (size_t)BM * K_ * 2; tB = tA; }
    __device__ bool next(int i, Unit& u) const {
        const long L = (long)i * G + c; if (L >= nwg) return false;
        int wgid = (int)L; { const int q = nwg / NXCD, r = nwg % NXCD, xcd = wgid % NXCD, off = wgid / NXCD; wgid = (xcd < r ? xcd * (q + 1) : r * (q + 1) + (xcd - r) * q) + off; }
        const int nig = WGM * nN, gid = wgid / nig, fm = gid * WGM, gsz = (nM - fm) < WGM ? (nM - fm) : WGM;
        u.pm = fm + ((wgid % nig) % gsz); u.pn = (wgid % nig) / gsz; u.a = A + (size_t)u.pm * tA; u.b = Bt + (size_t)u.pn * tB; u.glist = nullptr; u.gcount = 0; return true;
    }
};
struct MoeOrder {
    int G, c, ntiles; const LAS int* tile_e; const LAS int* tile_r0; const LAS int* cnt;
    const char* A; size_t tA; const char* W; size_t estride, tB; const int* list; int Mrows;
    __device__ bool next(int i, Unit& u) const {
        const int L = i * G + c; if (L >= ntiles * 4) return false;
        const int gt = L >> 2, e = tile_e[gt], r0 = tile_r0[gt];
        u.pm = gt; u.pn = L & 3; u.a = A + (size_t)gt * tA; u.b = W + (size_t)e * estride + (size_t)u.pn * tB;
        u.glist = list + (size_t)e * Mrows + r0; u.gcount = cnt[e] - r0; return true;
    }
};

template <class Epi, class Sched, bool GATHER>
__device__ __forceinline__ void gemm_phase(LAS unsigned char* lds, const bf16_t* Abase, int K, const Sched& S, const Epi& E) {
    const int tid = threadIdx.x, wid = __builtin_amdgcn_readfirstlane(tid >> 6), lane = tid & 63, wr = wid >> 2, wc = wid & 3, fr = lane & 15, fq = lane >> 4;
    const int nt = K / BK;
    const size_t kstep = (size_t)(BK * 2);
    const unsigned hstep = (unsigned)HALF * K * 2;
    unsigned voffB[2]; int RA[2], CA[2];
#pragma unroll
    for (int i = 0; i < 2; ++i) { int R, C; stage_rc(tid * 16 + i * 8192, R, C); const int Rb = Epi::PERM ? ((R & ~31) + perm32(R & 31)) : R;
        RA[i] = R; CA[i] = C; voffB[i] = (unsigned)(Rb * K + C) * 2u; }
    unsigned voffB2[2][2];
#pragma unroll
    for (int h = 0; h < 2; ++h)
#pragma unroll
        for (int i = 0; i < 2; ++i) voffB2[h][i] = voffB[i] + h * hstep;
    const unsigned ldsw = (unsigned)wid * 1024u;
    const int aoff = lds_byte(wr * 64 + fr, fq * 8), boff = lds_byte(wc * 32 + fr, fq * 8);
#define PG8_SA(b, h) (((b) * 2 + (h)) * HTB)
#define PG8_SB(b, h) ((4 + (b) * 2 + (h)) * HTB)
#define PG8_STAGE(bufoff, gbase, OFF, h) do { _Pragma("unroll") for (int _i = 0; _i < 2; ++_i) \
        __builtin_amdgcn_global_load_lds((const unsigned*)((const char*)(gbase) + (OFF)[h][_i]), (LAS unsigned*)(lds + (bufoff) + ldsw + _i * 8192), 16, 0, 0); } while (0)
#define PG8_LDA(dst, b, h) do { _Pragma("unroll") for (int m = 0; m < 4; ++m) _Pragma("unroll") for (int k = 0; k < 2; ++k) dst[m][k] = *(const LAS bf16x8*)(lds + PG8_SA(b, h) + aoff + m * 2048 + k * 1024); } while (0)
#define PG8_LDB(dst, b, h) do { _Pragma("unroll") for (int n = 0; n < 2; ++n) _Pragma("unroll") for (int k = 0; k < 2; ++k) dst[n][k] = *(const LAS bf16x8*)(lds + PG8_SB(b, h) + boff + n * 2048 + k * 1024); } while (0)
#define PG8_MMA(ai, bj, At, Bt) do { __builtin_amdgcn_s_setprio(1); _Pragma("unroll") for (int m = 0; m < 4; ++m) _Pragma("unroll") for (int n = 0; n < 2; ++n) _Pragma("unroll") for (int k = 0; k < 2; ++k) \
        acc[ai][bj][m][n] = __builtin_amdgcn_mfma_f32_16x16x32_bf16(Bt[n][k], At[m][k], acc[ai][bj][m][n], 0, 0, 0); __builtin_amdgcn_s_setprio(0); } while (0)
#define PG8_WAIT_V(n) asm volatile("s_waitcnt vmcnt(" #n ")" ::: "memory")
#define PG8_WAIT_L(n) asm volatile("s_waitcnt lgkmcnt(" #n ")" ::: "memory")
#define PG8_BAR __builtin_amdgcn_s_barrier()
#define PG8_SCHED __builtin_amdgcn_sched_barrier(0)
#define PG8_AOFF(dst, u) do { if constexpr (GATHER) { _Pragma("unroll") for (int _h = 0; _h < 2; ++_h) _Pragma("unroll") for (int _i = 0; _i < 2; ++_i) { \
            const int _r = _h * HALF + RA[_i]; const int _t = (_r < (u).gcount) ? (u).glist[_r] : 0; dst[_h][_i] = (unsigned)(_t * K + CA[_i]) * 2u; } \
            asm volatile("" : "+v"(dst[0][0]), "+v"(dst[0][1]), "+v"(dst[1][0]), "+v"(dst[1][1])); } \
        else { _Pragma("unroll") for (int _h = 0; _h < 2; ++_h) _Pragma("unroll") for (int _i = 0; _i < 2; ++_i) dst[_h][_i] = (unsigned)(RA[_i] * K + CA[_i]) * 2u + _h * hstep; } } while (0)
    Unit cur, nxt; int ui = 0;
    if (!S.next(0, cur)) return;
    f32x4 acc[2][2][4][2];
#pragma unroll
    for (int a = 0; a < 2; ++a)
#pragma unroll
        for (int b = 0; b < 2; ++b)
#pragma unroll
            for (int m = 0; m < 4; ++m)
#pragma unroll
                for (int n = 0; n < 2; ++n) acc[a][b][m][n] = (f32x4){0.f, 0.f, 0.f, 0.f};
    bf16x8 At[4][2], B0[2][2], B1[2][2];
    unsigned oc[2][2], on[2][2];
    PG8_AOFF(oc, cur);
    const char* cA = GATHER ? (const char*)Abase : cur.a; const char* cB = cur.b;
    PG8_STAGE(PG8_SB(0, 0), cB, voffB2, 0); PG8_STAGE(PG8_SB(0, 1), cB, voffB2, 1); PG8_STAGE(PG8_SA(0, 0), cA, oc, 0); PG8_STAGE(PG8_SA(0, 1), cA, oc, 1);
    if (wr == 1) PG8_BAR;
    PG8_WAIT_V(2); PG8_BAR;
    PG8_STAGE(PG8_SB(1, 0), cB + kstep, voffB2, 0); PG8_STAGE(PG8_SA(1, 0), cA + kstep, oc, 0); PG8_STAGE(PG8_SB(1, 1), cB + kstep, voffB2, 1);
    PG8_WAIT_V(6); PG8_BAR;
    for (;;) {
        const bool has_next = S.next(ui + 1, nxt);
        const char* nA; const char* nB;
        if (has_next) { nA = GATHER ? (const char*)Abase : nxt.a; nB = nxt.b; PG8_AOFF(on, nxt); }
        else { nA = cA; nB = cB;
#pragma unroll
            for (int h = 0; h < 2; ++h)
#pragma unroll
                for (int i = 0; i < 2; ++i) on[h][i] = oc[h][i]; }
        for (int t = 0; t < nt; t += 2) {
            const bool last = (t == nt - 2);
            const char* a1 = cA + (size_t)(t + 1) * kstep;
            const char* a2 = last ? nA : cA + (size_t)(t + 2) * kstep; const char* b2 = last ? nB : cB + (size_t)(t + 2) * kstep;
            const char* a3 = a2 + kstep; const char* b3 = b2 + kstep;
            unsigned o2[2][2];
#pragma unroll
            for (int h = 0; h < 2; ++h)
#pragma unroll
                for (int i = 0; i < 2; ++i) o2[h][i] = last ? on[h][i] : oc[h][i];
            PG8_LDB(B0, 0, 0); PG8_LDB(B1, 0, 1); PG8_SCHED; PG8_LDA(At, 0, 0); PG8_STAGE(PG8_SA(1, 1), a1, oc, 1);
            PG8_WAIT_V(8); PG8_WAIT_L(0); PG8_BAR; PG8_MMA(0, 0, At, B0); PG8_MMA(0, 1, At, B1); PG8_BAR; PG8_SCHED;
            PG8_LDA(At, 0, 1); PG8_STAGE(PG8_SB(0, 0), b2, voffB2, 0); PG8_STAGE(PG8_SB(0, 1), b2, voffB2, 1); PG8_STAGE(PG8_SA(0, 0), a2, o2, 0);
            PG8_WAIT_V(8); PG8_WAIT_L(0); PG8_BAR; PG8_MMA(1, 0, At, B0); PG8_MMA(1, 1, At, B1); PG8_BAR; PG8_SCHED;
            PG8_LDB(B0, 1, 0); PG8_LDB(B1, 1, 1); PG8_SCHED; PG8_LDA(At, 1, 0); PG8_STAGE(PG8_SA(0, 1), a2, o2, 1);
            PG8_WAIT_V(8); PG8_WAIT_L(0); PG8_BAR; PG8_MMA(0, 0, At, B0); PG8_MMA(0, 1, At, B1); PG8_BAR; PG8_SCHED;
            PG8_LDA(At, 1, 1); PG8_STAGE(PG8_SB(1, 0), b3, voffB2, 0); PG8_STAGE(PG8_SB(1, 1), b3, voffB2, 1); PG8_STAGE(PG8_SA(1, 0), a3, o2, 0);
            PG8_WAIT_V(8); PG8_WAIT_L(0); PG8_BAR; PG8_MMA(1, 0, At, B0); PG8_MMA(1, 1, At, B1); PG8_BAR; PG8_SCHED;
        }
        if (wr == 0) PG8_BAR;
        E(acc, cur, wr, wc, fr, fq);
        if (!has_next) break;
#pragma unroll
        for (int a = 0; a < 2; ++a)
#pragma unroll
            for (int b = 0; b < 2; ++b)
#pragma unroll
                for (int m = 0; m < 4; ++m)
#pragma unroll
                    for (int n = 0; n < 2; ++n) acc[a][b][m][n] = (f32x4){0.f, 0.f, 0.f, 0.f};
        cur = nxt; cA = nA; cB = nB; ++ui;
#pragma unroll
        for (int h = 0; h < 2; ++h)
#pragma unroll
            for (int i = 0; i < 2; ++i) oc[h][i] = on[h][i];
        if (wr == 1) PG8_BAR;
    }
    PG8_WAIT_V(0);
    PG8_BAR;
#undef PG8_SA
#undef PG8_SB
#undef PG8_STAGE
#undef PG8_LDA
#undef PG8_LDB
#undef PG8_MMA
#undef PG8_WAIT_V
#undef PG8_WAIT_L
#undef PG8_BAR
#undef PG8_SCHED
#undef PG8_AOFF
}


struct EpiQKV {
    static constexpr bool PERM = true;
    bf16_t* ZB; const LAS float* gqk;
    __device__ __forceinline__ void operator()(const f32x4 (&acc)[2][2][4][2], const Unit& u, int wr, int wc, int fr, int fq) const {
        const int type = u.pn >> 1;
        f32x4 g[2][2];
        if (type == 0) {
#pragma unroll
            for (int bj = 0; bj < 2; ++bj)
#pragma unroll
                for (int n = 0; n < 2; ++n) g[bj][n] = *(const LAS f32x4*)(gqk + 32 * bj + 8 * fq + 4 * n);
        }
#pragma unroll
        for (int ai = 0; ai < 2; ++ai)
#pragma unroll
            for (int m = 0; m < 4; ++m) {
                const int row = u.pm * BM + ai * HALF + wr * 64 + m * 16 + fr;
                f32x4 v[2][2];
#pragma unroll
                for (int bj = 0; bj < 2; ++bj)
#pragma unroll
                    for (int n = 0; n < 2; ++n) v[bj][n] = acc[ai][bj][m][n];
                if (type < 2) {
                    float ss = 0.f;
#pragma unroll
                    for (int bj = 0; bj < 2; ++bj)
#pragma unroll
                        for (int n = 0; n < 2; ++n) ss += (v[bj][n][0] * v[bj][n][0] + v[bj][n][1] * v[bj][n][1]) + (v[bj][n][2] * v[bj][n][2] + v[bj][n][3] * v[bj][n][3]);
                    ss += __shfl_xor(ss, 16); ss += __shfl_xor(ss, 32);
                    const float rstd = rsqrtf(ss * (1.0f / 64.0f) + 1e-6f);
#pragma unroll
                    for (int bj = 0; bj < 2; ++bj)
#pragma unroll
                        for (int n = 0; n < 2; ++n) { v[bj][n] = v[bj][n] * rstd; if (type == 0) v[bj][n] = v[bj][n] * g[bj][n]; }
                }
                bf16_t* rowp = ZB + (size_t)row * 2560 + u.pn * BM + wc * 64 + 8 * fq;
#pragma unroll
                for (int bj = 0; bj < 2; ++bj) { u32x4 w; w.x = cvt_pk_bf16(v[bj][0][0], v[bj][0][1]); w.y = cvt_pk_bf16(v[bj][0][2], v[bj][0][3]); w.z = cvt_pk_bf16(v[bj][1][0], v[bj][1][1]); w.w = cvt_pk_bf16(v[bj][1][2], v[bj][1][3]);
                    *(u32x4*)(rowp + 32 * bj) = w; }
            }
    }
};
struct EpiRes {
    static constexpr bool PERM = false;
    const float* base; float* out; int ldc;
    __device__ __forceinline__ void operator()(const f32x4 (&acc)[2][2][4][2], const Unit& u, int wr, int wc, int fr, int fq) const {
        const int row0 = u.pm * BM + wr * 64 + fr, col0 = u.pn * BM + wc * 32 + 4 * fq;
#pragma unroll
        for (int ai = 0; ai < 2; ++ai)
#pragma unroll
            for (int m = 0; m < 4; ++m) { const size_t off = (size_t)(row0 + ai * HALF + m * 16) * ldc + col0;
#pragma unroll
                for (int bj = 0; bj < 2; ++bj)
#pragma unroll
                    for (int n = 0; n < 2; ++n) { const f32x4 bs = *(const f32x4*)(base + off + bj * HALF + n * 16); *(f32x4*)(out + off + bj * HALF + n * 16) = bs + acc[ai][bj][m][n]; }
                asm volatile("" ::: "memory"); }
    }
};
struct EpiSwiGLU {
    static constexpr bool PERM = true;
    bf16_t* ACT;
    __device__ __forceinline__ void operator()(const f32x4 (&acc)[2][2][4][2], const Unit& u, int wr, int wc, int fr, int fq) const {
#pragma unroll
        for (int ai = 0; ai < 2; ++ai)
#pragma unroll
            for (int m = 0; m < 4; ++m) {
                const int row = u.pm * BM + ai * HALF + wr * 64 + m * 16 + fr;
                float o[8];
#pragma unroll
                for (int n = 0; n < 2; ++n)
#pragma unroll
                    for (int j = 0; j < 4; ++j) { const float gv = acc[ai][0][m][n][j], uv = acc[ai][1][m][n][j];
                        o[n * 4 + j] = gv * __builtin_amdgcn_rcpf(1.0f + __builtin_amdgcn_exp2f(-gv * LOG2E)) * uv; }
                u32x4 w; w.x = cvt_pk_bf16(o[0], o[1]); w.y = cvt_pk_bf16(o[2], o[3]); w.z = cvt_pk_bf16(o[4], o[5]); w.w = cvt_pk_bf16(o[6], o[7]);
                *(u32x4*)(ACT + (size_t)row * 512 + u.pn * 128 + wc * 32 + 8 * fq) = w;
            }
    }
};
struct EpiBf16 {
    static constexpr bool PERM = true;
    bf16_t* O; int ldc;
    __device__ __forceinline__ void operator()(const f32x4 (&acc)[2][2][4][2], const Unit& u, int wr, int wc, int fr, int fq) const {
        const int row0 = u.pm * BM + wr * 64 + fr, col0 = u.pn * BM + wc * 32 + 8 * fq;
#pragma unroll
        for (int ai = 0; ai < 2; ++ai)
#pragma unroll
            for (int m = 0; m < 4; ++m) { bf16_t* rowp = O + (size_t)(row0 + ai * HALF + m * 16) * ldc + col0;
#pragma unroll
                for (int bj = 0; bj < 2; ++bj) { const f32x4 v0 = acc[ai][bj][m][0], v1 = acc[ai][bj][m][1];
                    u32x4 w; w.x = cvt_pk_bf16(v0[0], v0[1]); w.y = cvt_pk_bf16(v0[2], v0[3]); w.z = cvt_pk_bf16(v1[0], v1[1]); w.w = cvt_pk_bf16(v1[2], v1[3]);
                    *(u32x4*)(rowp + bj * HALF) = w; } }
    }
};
}

struct Params { const float* in[24]; float* out; unsigned char* ws; };
#define LDS_WAIT() asm volatile("s_waitcnt lgkmcnt(0)" ::: "memory")
constexpr int NTHR = 512, NWAVE = 8;

__device__ __forceinline__ void tr_item(const float* W, int K, int N, bf16_t* WT, int drow, LAS float* scr, int k0, int n0, int lane, const float* gain) {
#pragma unroll 8
    for (int i = 0; i < 32; ++i) { const int kk = 2 * i + (lane >> 5); float v = W[(size_t)(k0 + kk) * N + n0 + (lane & 31)]; if (gain) v *= gain[k0 + kk]; scr[kk * 33 + (lane & 31)] = v; }
    LDS_WAIT(); asm volatile("" ::: "memory");
    const int c = lane & 7;
#pragma unroll
    for (int j = 0; j < 4; ++j) { const int n = (lane >> 3) + 8 * j; const LAS float* s = scr + (8 * c) * 33 + n;
        u32x4 o; o.x = cvt_pk_bf16(s[0 * 33], s[1 * 33]); o.y = cvt_pk_bf16(s[2 * 33], s[3 * 33]); o.z = cvt_pk_bf16(s[4 * 33], s[5 * 33]); o.w = cvt_pk_bf16(s[6 * 33], s[7 * 33]);
        *(u32x4*)(WT + (size_t)(drow + n) * K + k0 + 8 * c) = o; }
    LDS_WAIT(); asm volatile("" ::: "memory");
}
__device__ __forceinline__ int t5_bucket_d(int dist) {
    if (dist < 16) return dist;
    int lb = 16 + (int)(logf((float)dist / 16.f) / logf(128.f) * 16.f);
    return lb < 31 ? lb : 31;
}
__device__ __forceinline__ void ph_prologue(const Params& p, LAS unsigned char* lds, int which) {
    const int tid = threadIdx.x, lane = tid & 63, wave = tid >> 6;
    LAS float* scr = (LAS float*)(lds + wave * 8704);
    const int gw = blockIdx.x * NWAVE + wave, NGW = gridDim.x * NWAVE;
    constexpr int I_IN = 16 * 80, I_OUT = 16 * 32, I_G = 16 * 16, I_D = 8 * 32, I_E = 2 * I_G + I_D;
    if (which & 1) {
        constexpr int PER_L = I_IN + I_OUT;
        for (int it = gw; it < DEPTH * PER_L; it += NGW) {
            const int l = it / PER_L; int r = it % PER_L;
            if (r < I_IN) { const int kb = r / 80, nb = r % 80, n0 = nb * 32, o = n0 & 255; const int drow = (n0 & ~255) + 128 * ((o >> 5) & 1) + 32 * ((o >> 6) & 3);
                tr_item(p.in[3] + (size_t)l * D * DIN, D, DIN, (bf16_t*)(p.ws + WS_WIN) + (size_t)l * DIN * D, drow, scr, kb * 64, n0, lane, p.in[2] + l * D); }
            else { r -= I_IN; const int kb = r / 32, nb = r % 32;
                tr_item(p.in[15] + (size_t)l * D * D, D, D, (bf16_t*)(p.ws + WS_WOUT) + (size_t)l * D * D, nb * 32, scr, kb * 64, nb * 32, lane, kb < 8 ? p.in[13] + l * DA : p.in[14] + l * DR - DA); }
        }
        const int gt = blockIdx.x * NTHR + tid, NGT = gridDim.x * NTHR;
        float* BT = (float*)(p.ws + WS_BT);
        for (int i = gt; i < 3 * 8 * 192; i += NGT) { const int br = i / (8 * 192), h = (i / 192) % 8, j = i % 192; const int dil = br == 0 ? 1 : br == 1 ? 4 : 16;
            const int steps = (190 - j) - 31; float v = -1e30f; if (j < 191 && steps >= 0 && steps <= 128) v = p.in[1][t5_bucket_d(steps * dil) * NH + h] * LOG2E; BT[i] = v; }
        float* GQK = (float*)(p.ws + WS_GQK);
        for (int i = gt; i < DEPTH * 64; i += NGT) GQK[i] = p.in[4][i] * p.in[5][i] * 0.125f * LOG2E;
        float* SPL = (float*)(p.ws + WS_SPL);
        for (int i = gt; i < DEPTH * DR; i += NGT) { const float lm = -p.in[12][i]; SPL[i] = 8.f * LOG2E * (fmaxf(lm, 0.f) + log1pf(expf(-fabsf(lm)))); }
        float* RT = (float*)(p.ws + WS_RT);
        for (int i = gt; i < DEPTH * D * 36; i += NGT) { const int l = i / (D * 36), k = (i / 36) % D, j = i % 36;
            RT[i] = p.in[16][l * D + k] * (j < 4 ? p.in[17][(l * D + k) * 4 + j] : p.in[19][(l * D + k) * 32 + j - 4]); }
        bf16_t* WAT = (bf16_t*)(p.ws + WS_WAT);
        for (int i = gt; i < DEPTH * 2 * 8 * 4096; i += NGT) { const int l = i / (2 * 8 * 4096), wh = (i / (8 * 4096)) & 1, g = (i / 4096) & 7, j = (i / 64) & 63, ii = i & 63;
            const float v = (wh ? p.in[10] : p.in[8])[((size_t)(l * 8 + g) * 64 + ii) * 64 + j]; WAT[i] = (bf16_t)(cvt_pk_bf16(v, 0.f) & 0xffffu); }
    }
    if (which & 2) {
        for (int it = gw; it < DEPTH * NE * I_E; it += NGW) {
            const int le = it / I_E; int r = it % I_E;
            const int l = le / NE;
            if (r < 2 * I_G) { const int up = r >= I_G; if (up) r -= I_G; const int kb = r / 16, nb = r % 16, n0 = nb * 32; const int drow = 256 * (n0 >> 7) + 128 * up + (n0 & 127);
                tr_item((up ? p.in[22] : p.in[21]) + (size_t)le * D * DE, D, DE, (bf16_t*)(p.ws + WS_WGU) + (size_t)le * D * D, drow, scr, kb * 64, n0, lane, p.in[16] + l * D); }
            else { r -= 2 * I_G; const int kb = r / 32, nb = r % 32;
                tr_item(p.in[23] + (size_t)le * DE * D, DE, D, (bf16_t*)(p.ws + WS_WD) + (size_t)le * D * DE, nb * 32, scr, kb * 64, nb * 32, lane, nullptr); }
        }
    }
}

__device__ __forceinline__ void build_tiles(const int* counts, LAS int* tab) {
    const int tid = threadIdx.x;
    if (tid < NE) tab[tid] = counts[tid];
    __syncthreads();
    if (tid == 0) { int run = 0;
        for (int e = 0; e < NE; ++e) { tab[32 + e] = run; const int nt = (tab[e] + 255) >> 8;
            for (int t = 0; t < nt; ++t) { tab[128 + run + t] = e; tab[288 + run + t] = t * 256; } run += nt; }
        tab[32 + NE] = run; tab[66] = run; }
    __syncthreads();
}

__device__ __forceinline__ void ph_norm(const Params& p, LAS unsigned char* lds, const float* src, float* dst, int mode, const int* counts, bool donorm) {
    const int tid = threadIdx.x, lane = tid & 63, wave = tid >> 6;
    LAS int* tab = (LAS int*)(lds + LDS_TAB);
    if (mode) build_tiles(counts, tab);
    const int* eid = (const int*)(p.ws + WS_TOK); const int* rank = eid + M * 2; const float* gate = (const float*)(rank + M * 2);
    const bf16_t* Y = (const bf16_t*)(p.ws + WS_Y); bf16_t* HN = (bf16_t*)(p.ws + WS_HN);
    for (int row = blockIdx.x * NWAVE + wave; row < M; row += gridDim.x * NWAVE) {
        const f32x4* xr = (const f32x4*)(src + (size_t)row * D) + lane;
        f32x4 v[4];
#pragma unroll
        for (int j = 0; j < 4; ++j) v[j] = xr[64 * j];
        if (mode) {
            const int e0 = eid[row * 2], e1 = eid[row * 2 + 1]; const float g0 = gate[row * 2], g1 = gate[row * 2 + 1];
            const int s0 = tab[32 + e0] * 256 + rank[row * 2], s1 = tab[32 + e1] * 256 + rank[row * 2 + 1];
            const u32x2* y0 = (const u32x2*)(Y + (size_t)s0 * D) + lane; const u32x2* y1 = (const u32x2*)(Y + (size_t)s1 * D) + lane;
#pragma unroll
            for (int j = 0; j < 4; ++j) { const u32x2 a = y0[64 * j], b = y1[64 * j];
                v[j][0] += g0 * bf_lo(a.x) + g1 * bf_lo(b.x); v[j][1] += g0 * bf_hi(a.x) + g1 * bf_hi(b.x);
                v[j][2] += g0 * bf_lo(a.y) + g1 * bf_lo(b.y); v[j][3] += g0 * bf_hi(a.y) + g1 * bf_hi(b.y); }
            f32x4* xo = (f32x4*)(dst + (size_t)row * D) + lane;
#pragma unroll
            for (int j = 0; j < 4; ++j) xo[64 * j] = v[j];
        }
        if (donorm) {
            float s = 0.f;
#pragma unroll
            for (int j = 0; j < 4; ++j) s += (v[j][0] * v[j][0] + v[j][1] * v[j][1]) + (v[j][2] * v[j][2] + v[j][3] * v[j][3]);
            s = wave_sum(s);
            const float rstd = rsqrtf(s * (1.0f / D) + EPS);
            u32x2* o = (u32x2*)(HN + (size_t)row * D) + lane;
#pragma unroll
            for (int j = 0; j < 4; ++j) { u32x2 w; w.x = cvt_pk_bf16(v[j][0] * rstd, v[j][1] * rstd); w.y = cvt_pk_bf16(v[j][2] * rstd, v[j][3] * rstd); o[64 * j] = w; }
        }
    }
}

__device__ __forceinline__ void ph_win(const Params& p, LAS unsigned char* lds, int l) {
    LAS float* gq = (LAS float*)(lds + LDS_TAB + 4096);
    if (threadIdx.x < 64) gq[threadIdx.x] = ((const float*)(p.ws + WS_GQK))[l * 64 + threadIdx.x];
    __syncthreads();
    pg8::StaticOrder S; S.init((const bf16_t*)(p.ws + WS_HN), (const bf16_t*)(p.ws + WS_WIN) + (size_t)l * DIN * D, M, DIN, D, gridDim.x, blockIdx.x);
    pg8::EpiQKV E{(bf16_t*)(p.ws + WS_ZB), gq};
    pg8::gemm_phase<pg8::EpiQKV, pg8::StaticOrder, false>(lds + LDS_STAGE, nullptr, D, S, E);
}
__device__ __forceinline__ void ph_wout(const Params& p, LAS unsigned char* lds, int l, const float* base, float* out) {
    pg8::StaticOrder S; S.init((const bf16_t*)(p.ws + WS_MIX), (const bf16_t*)(p.ws + WS_WOUT) + (size_t)l * D * D, M, D, D, gridDim.x, blockIdx.x);
    pg8::EpiRes E{base, out, D};
    pg8::gemm_phase<pg8::EpiRes, pg8::StaticOrder, false>(lds + LDS_STAGE, nullptr, D, S, E);
}

__device__ __forceinline__ void ph_router(const Params& p, LAS unsigned char* lds, int l, const float* X) {
    const int tid = threadIdx.x, lane = tid & 63, wave = tid >> 6;
    LAS float* RTl = (LAS float*)lds;
    LAS int* hist = (LAS int*)(lds + 147456); LAS int* base = hist + 32;
    LAS int* t_e = hist + 64; LAS int* t_lr = t_e + 128; LAS float* t_g = (LAS float*)(t_lr + 128);
    const float* RT = (const float*)(p.ws + WS_RT) + (size_t)l * D * 36;
    for (int i = tid; i < D * 36 / 4; i += NTHR) ((LAS f32x4*)RTl)[i] = ((const f32x4*)RT)[i];
    int* counts = (int*)(p.ws + WS_CNT) + l * NE;
    int* eid = (int*)(p.ws + WS_TOK); int* rank = eid + M * 2; float* gate = (float*)(rank + M * 2);
    int* list = (int*)(p.ws + WS_LIST); bf16_t* HN = (bf16_t*)(p.ws + WS_HN);
    const float* bg = p.in[18] + l * NG; const float* be = p.in[20] + l * NE;
    for (int grp = blockIdx.x; grp < M / 64; grp += gridDim.x) {
        __syncthreads();
        if (tid < 32) hist[tid] = 0;
        __syncthreads();
        for (int ti = 0; ti < 8; ++ti) {
            const int tl = wave * 8 + ti, tok = grp * 64 + tl;
            const f32x4* xr = (const f32x4*)(X + (size_t)tok * D) + lane;
            f32x4 v[4]; float s = 0.f;
#pragma unroll
            for (int j = 0; j < 4; ++j) { v[j] = xr[64 * j]; s += (v[j][0] * v[j][0] + v[j][1] * v[j][1]) + (v[j][2] * v[j][2] + v[j][3] * v[j][3]); }
            s = wave_sum(s);
            const float rstd = rsqrtf(s * (1.0f / D) + EPS);
            u32x2* o = (u32x2*)(HN + (size_t)tok * D) + lane;
#pragma unroll
            for (int j = 0; j < 4; ++j) { u32x2 w; w.x = cvt_pk_bf16(v[j][0] * rstd, v[j][1] * rstd); w.y = cvt_pk_bf16(v[j][2] * rstd, v[j][3] * rstd); o[64 * j] = w; }
            float acc[36];
#pragma unroll
            for (int j = 0; j < 36; ++j) acc[j] = 0.f;
            const float* xs = X + (size_t)tok * D + lane;
#pragma unroll 4
            for (int i = 0; i < 16; ++i) { const float xv = xs[64 * i] * rstd; const LAS f32x4* rr = (const LAS f32x4*)(RTl + (lane + 64 * i) * 36);
#pragma unroll
                for (int q = 0; q < 9; ++q) { const f32x4 w = rr[q]; acc[4 * q] += xv * w[0]; acc[4 * q + 1] += xv * w[1]; acc[4 * q + 2] += xv * w[2]; acc[4 * q + 3] += xv * w[3]; } }
#pragma unroll
            for (int j = 0; j < 36; ++j) acc[j] = wave_sum(acc[j]);
            float gl[4];
#pragma unroll
            for (int j = 0; j < 4; ++j) gl[j] = acc[j] + bg[j];
            int gs = 0; float gm = gl[0];
#pragma unroll
            for (int j = 1; j < 4; ++j) if (gl[j] > gm) { gm = gl[j]; gs = j; }
            float den = 0.f;
#pragma unroll
            for (int j = 0; j < 4; ++j) den += expf(gl[j] - gm);
            const float gw = 1.f / den;
            float el[8];
#pragma unroll
            for (int j = 0; j < 8; ++j) el[j] = (gs == 0 ? acc[4 + j] : gs == 1 ? acc[12 + j] : gs == 2 ? acc[20 + j] : acc[28 + j]) + be[gs * 8 + j];
            int i0 = 0; float m0 = el[0];
#pragma unroll
            for (int j = 1; j < 8; ++j) if (el[j] > m0) { m0 = el[j]; i0 = j; }
            int i1 = -1; float m1 = -3.0e38f;
#pragma unroll
            for (int j = 0; j < 8; ++j) if (j != i0 && el[j] > m1) { m1 = el[j]; i1 = j; }
            const float e1 = expf(m1 - m0); const float p0 = 1.f / (1.f + e1), p1 = e1 / (1.f + e1);
            const int ex0 = gs * 8 + i0, ex1 = gs * 8 + i1;
            if (lane == 0) { t_e[tl * 2] = ex0; t_e[tl * 2 + 1] = ex1; t_g[tl * 2] = gw * p0; t_g[tl * 2 + 1] = gw * p1;
                t_lr[tl * 2] = __hip_atomic_fetch_add(hist + ex0, 1, __ATOMIC_RELAXED, __HIP_MEMORY_SCOPE_WORKGROUP); t_lr[tl * 2 + 1] = __hip_atomic_fetch_add(hist + ex1, 1, __ATOMIC_RELAXED, __HIP_MEMORY_SCOPE_WORKGROUP); }
        }
        __syncthreads();
        if (tid < 32) { const int hcount = hist[tid]; base[tid] = hcount > 0 ? atomicAdd(&counts[tid], hcount) : 0; }
        __syncthreads();
        if (tid < 128) { const int tok = grp * 64 + (tid >> 1); const int e = t_e[tid]; const int r = base[e] + t_lr[tid];
            eid[tok * 2 + (tid & 1)] = e; rank[tok * 2 + (tid & 1)] = r; gate[tok * 2 + (tid & 1)] = t_g[tid]; list[(size_t)e * M + r] = tok; }
    }
}
__device__ __forceinline__ void ph_gateup(const Params& p, LAS unsigned char* lds, int l) {
    LAS int* tab = (LAS int*)(lds + LDS_TAB);
    build_tiles((const int*)(p.ws + WS_CNT) + l * NE, tab);
    pg8::MoeOrder S; S.G = gridDim.x; S.c = blockIdx.x; S.ntiles = tab[66]; S.tile_e = tab + 128; S.tile_r0 = tab + 288; S.cnt = tab;
    S.A = nullptr; S.tA = 0; S.W = (const char*)((const bf16_t*)(p.ws + WS_WGU) + (size_t)l * NE * D * D); S.estride = (size_t)D * D * 2; S.tB = (size_t)256 * D * 2;
    S.list = (const int*)(p.ws + WS_LIST); S.Mrows = M;
    pg8::EpiSwiGLU E{(bf16_t*)(p.ws + WS_ACT)};
    pg8::gemm_phase<pg8::EpiSwiGLU, pg8::MoeOrder, true>(lds + LDS_STAGE, (const bf16_t*)(p.ws + WS_HN), D, S, E);
}
__device__ __forceinline__ void ph_down(const Params& p, LAS unsigned char* lds, int l) {
    LAS int* tab = (LAS int*)(lds + LDS_TAB);
    build_tiles((const int*)(p.ws + WS_CNT) + l * NE, tab);
    pg8::MoeOrder S; S.G = gridDim.x; S.c = blockIdx.x; S.ntiles = tab[66]; S.tile_e = tab + 128; S.tile_r0 = tab + 288; S.cnt = tab;
    S.A = (const char*)(p.ws + WS_ACT); S.tA = (size_t)256 * DE * 2; S.W = (const char*)((const bf16_t*)(p.ws + WS_WD) + (size_t)l * NE * D * DE); S.estride = (size_t)D * DE * 2; S.tB = (size_t)256 * DE * 2;
    S.list = (const int*)(p.ws + WS_LIST); S.Mrows = M;
    pg8::EpiBf16 E{(bf16_t*)(p.ws + WS_Y), D};
    pg8::gemm_phase<pg8::EpiBf16, pg8::MoeOrder, false>(lds + LDS_STAGE, nullptr, DE, S, E);
}

#define TRREAD(dst, addr, off) asm volatile("ds_read_b64_tr_b16 %0, %1 offset:%2" : "=&v"(dst) : "v"(addr), "i"(off) : "memory")
__device__ __forceinline__ void attn_item(const Params& p, LAS unsigned char* lds, int item) {
    const int tid = threadIdx.x, lane = tid & 63, w = __builtin_amdgcn_readfirstlane(tid >> 6), hh = lane >> 5, ql = lane & 31;
    const int br = item >> 9, rem = item & 511, b = rem >> 8, h = (rem >> 5) & 7, j = rem & 31;
    const int dsh = br * 2, dil = 1 << dsh, nblk = 32 >> dsh, r = j / nblk, blk = j % nblk, i0 = blk * 256;
    const bf16_t* ZB = (const bf16_t*)(p.ws + WS_ZB);
    LAS unsigned char* Kl = lds; LAS unsigned char* Vl = lds + 49152; LAS float* Tl = (LAS float*)(lds + 98304);
    __syncthreads();
#pragma unroll
    for (int jj = 0; jj < 6; ++jj) {
        const int idx = tid + 512 * jj, key = idx >> 3, ch = idx & 7, sub = i0 - 128 + key;
        u32x4 kv = {0u, 0u, 0u, 0u}, vv = {0u, 0u, 0u, 0u};
        if (sub >= 0) { const bf16_t* rp = ZB + (size_t)(b * SEQ + sub * dil + r) * DIN + h * HD + ch * 8; kv = *(const u32x4*)(rp + DA); vv = *(const u32x4*)(rp + 2 * DA); }
        *(LAS u32x4*)(Kl + key * 128 + ((ch ^ ((key >> 1) & 7)) << 4)) = kv;
        *(LAS u32x4*)(Vl + ((key >> 2) * 2 + (ch >> 2)) * 256 + (key & 3) * 64 + (ch & 3) * 16) = vv;
    }
    if (tid < 192) Tl[tid] = ((const float*)(p.ws + WS_BT))[(br * 8 + h) * 192 + tid];
    const int qsub = i0 + 32 * w + ql; const size_t qtok = (size_t)(b * SEQ + qsub * dil + r);
    bf16x8 qf[4];
#pragma unroll
    for (int ks = 0; ks < 4; ++ks) qf[ks] = *(const bf16x8*)(ZB + qtok * DIN + h * HD + 16 * ks + 8 * hh);
    __syncthreads();
    const int sw = (ql >> 1) & 7;
    int koff[4];
#pragma unroll
    for (int ks = 0; ks < 4; ++ks) koff[ks] = ((2 * ks + hh) ^ sw) << 4;
    const LAS unsigned char* kbase = Kl + (32 * w + ql) * 128;
    f32x16 S[5];
#pragma unroll
    for (int kb = 0; kb < 5; ++kb) {
        S[kb] = (f32x16){0.f, 0.f, 0.f, 0.f, 0.f, 0.f, 0.f, 0.f, 0.f, 0.f, 0.f, 0.f, 0.f, 0.f, 0.f, 0.f};
#pragma unroll
        for (int ks = 0; ks < 4; ++ks) { const bf16x8 kf = *(const LAS bf16x8*)(kbase + kb * 4096 + koff[ks]);
            S[kb] = __builtin_amdgcn_mfma_f32_32x32x16_bf16(kf, qf[ks], S[kb], 0, 0, 0); }
    }
    const LAS float* tl = Tl + (31 - ql + 4 * hh);
    const int thr = 128 - i0 - 32 * w;
    float mx = -3.0e38f;
#pragma unroll
    for (int kb = 0; kb < 5; ++kb)
#pragma unroll
        for (int rr = 0; rr < 16; ++rr) { const int c = 32 * kb + (rr & 3) + 8 * (rr >> 2); float s = S[kb][rr] + tl[c];
            if (thr > 0) s = (c + 4 * hh < thr) ? -1e30f : s;
            S[kb][rr] = s; mx = fmaxf(mx, s); }
    mx = fmaxf(mx, __shfl_xor(mx, 32));
    float ls = 0.f;
#pragma unroll
    for (int kb = 0; kb < 5; ++kb)
#pragma unroll
        for (int rr = 0; rr < 16; ++rr) { const float e = __builtin_amdgcn_exp2f(S[kb][rr] - mx); S[kb][rr] = e; ls += e; }
    ls += __shfl_xor(ls, 32);
    f32x16 O[2];
    O[0] = (f32x16){0.f, 0.f, 0.f, 0.f, 0.f, 0.f, 0.f, 0.f, 0.f, 0.f, 0.f, 0.f, 0.f, 0.f, 0.f, 0.f}; O[1] = O[0];
    const unsigned vaddr = (unsigned)(size_t)(Vl) + (unsigned)(w * 4096 + hh * 512 + ((lane >> 2) & 3) * 64 + ((lane >> 4) & 1) * 32 + (lane & 3) * 8);
#pragma unroll
    for (int kb = 0; kb < 5; ++kb) {
        s16x4 v0[2][2], v1[2][2];
        TRREAD(v0[0][0], vaddr, (8 * kb + 0) * 512 + 0);   TRREAD(v1[0][0], vaddr, (8 * kb + 2) * 512 + 0);
        TRREAD(v0[0][1], vaddr, (8 * kb + 0) * 512 + 256); TRREAD(v1[0][1], vaddr, (8 * kb + 2) * 512 + 256);
        TRREAD(v0[1][0], vaddr, (8 * kb + 4) * 512 + 0);   TRREAD(v1[1][0], vaddr, (8 * kb + 6) * 512 + 0);
        TRREAD(v0[1][1], vaddr, (8 * kb + 4) * 512 + 256); TRREAD(v1[1][1], vaddr, (8 * kb + 6) * 512 + 256);
        asm volatile("s_waitcnt lgkmcnt(0)" ::: "memory"); __builtin_amdgcn_sched_barrier(0);
#pragma unroll
        for (int s2 = 0; s2 < 2; ++s2) {
            u32x4 pw; pw.x = cvt_pk_bf16(S[kb][8 * s2 + 0], S[kb][8 * s2 + 1]); pw.y = cvt_pk_bf16(S[kb][8 * s2 + 2], S[kb][8 * s2 + 3]);
            pw.z = cvt_pk_bf16(S[kb][8 * s2 + 4], S[kb][8 * s2 + 5]); pw.w = cvt_pk_bf16(S[kb][8 * s2 + 6], S[kb][8 * s2 + 7]);
            const bf16x8 pb = __builtin_bit_cast(bf16x8, pw);
#pragma unroll
            for (int db = 0; db < 2; ++db) { const bf16x8 va = (bf16x8){v0[s2][db][0], v0[s2][db][1], v0[s2][db][2], v0[s2][db][3], v1[s2][db][0], v1[s2][db][1], v1[s2][db][2], v1[s2][db][3]};
                O[db] = __builtin_amdgcn_mfma_f32_32x32x16_bf16(va, pb, O[db], 0, 0, 0); }
        }
    }
    const float inv = 1.0f / ls;
    bf16_t* ob = (bf16_t*)(p.ws + WS_OB) + ((size_t)br * M + qtok) * DA + h * HD;
#pragma unroll
    for (int db = 0; db < 2; ++db)
#pragma unroll
        for (int rg = 0; rg < 4; ++rg) { u32x2 o; o.x = cvt_pk_bf16(O[db][4 * rg] * inv, O[db][4 * rg + 1] * inv); o.y = cvt_pk_bf16(O[db][4 * rg + 2] * inv, O[db][4 * rg + 3] * inv);
            *(u32x2*)(ob + 32 * db + 8 * rg + 4 * hh) = o; }
    if (hh == 0) ((float*)(p.ws + WS_LSE))[((size_t)br * M + qtok) * NH + h] = mx + __builtin_amdgcn_logf(ls);
}

__device__ __forceinline__ float sigm(float x) { return __builtin_amdgcn_rcpf(1.0f + __builtin_amdgcn_exp2f(-x * LOG2E)); }
template <bool FINAL>
__device__ __forceinline__ void rnn_unit(const Params& p, LAS unsigned char* lds, int l, int unit) {
    const int tid = threadIdx.x, lane = tid & 63, g = __builtin_amdgcn_readfirstlane(tid >> 6), hh = lane >> 5, ql = lane & 31;
    const int b = unit >> 7, chunk = unit & 127, t0 = chunk * 64;
    const bf16_t* ZB = (const bf16_t*)(p.ws + WS_ZB);
    LAS float* ut = (LAS float*)(lds + g * 17408); LAS float* at = ut + 32 * 68;
    LAS float* part = (LAS float*)(lds + 139264);
    float* AGG = (float*)(p.ws + WS_AGG);
    const int c = g * 64 + lane;
    const float* cw = p.in[6] + l * 4 * DR; const float w0 = cw[c], w1 = cw[DR + c], w2 = cw[2 * DR + c], w3 = cw[3 * DR + c], cbv = p.in[7][l * DR + c];
    float bav[2], bxv[2], splv[2];
#pragma unroll
    for (int nb = 0; nb < 2; ++nb) { const int cd = g * 64 + 32 * nb + ql; bav[nb] = p.in[9][l * DR + cd]; bxv[nb] = p.in[11][l * DR + cd]; splv[nb] = ((const float*)(p.ws + WS_SPL))[l * DR + cd]; }
    bf16x8 Wa[2][4], Wx[2][4];
    { const bf16_t* wat = (const bf16_t*)(p.ws + WS_WAT) + (size_t)((l * 2) * 8 + g) * 4096;
#pragma unroll
      for (int nb = 0; nb < 2; ++nb)
#pragma unroll
          for (int ks = 0; ks < 4; ++ks) { const int off = (32 * nb + ql) * 64 + 16 * ks + 8 * hh; Wa[nb][ks] = *(const bf16x8*)(wat + off); Wx[nb][ks] = *(const bf16x8*)(wat + 8 * 4096 + off); } }
    float hst = 0.f, Ap = 1.f;
    if (FINAL) {
        const float* ag = AGG + (size_t)(b * 128) * 1024 + c;
        int cc = 0;
        for (; cc + 8 <= chunk; cc += 8) { float A[8], H[8];
#pragma unroll
            for (int q = 0; q < 8; ++q) { A[q] = ag[(size_t)(cc + q) * 1024]; H[q] = ag[(size_t)(cc + q) * 1024 + 512]; }
#pragma unroll
            for (int q = 0; q < 8; ++q) hst = A[q] * hst + H[q]; }
        for (; cc < chunk; ++cc) { const float A = ag[(size_t)cc * 1024], H = ag[(size_t)cc * 1024 + 512]; hst = A * hst + H; }
    }
    const size_t tokb = (size_t)b * SEQ + t0;
    float xm3 = 0.f, xm2 = 0.f, xm1 = 0.f;
    if (t0 > 0) { xm3 = bf2f(ZB[(tokb - 3) * DIN + 1536 + c]); xm2 = bf2f(ZB[(tokb - 2) * DIN + 1536 + c]); xm1 = bf2f(ZB[(tokb - 1) * DIN + 1536 + c]); }
    __syncthreads();
#pragma unroll 1
    for (int hf = 0; hf < 2; ++hf) {
        const size_t tk0 = tokb + 32 * hf;
#pragma unroll 8
        for (int tt = 0; tt < 32; ++tt) { const float xv = bf2f(ZB[(tk0 + tt) * DIN + 1536 + c]); ut[tt * 68 + lane] = cbv + w0 * xm3 + w1 * xm2 + w2 * xm1 + w3 * xv; xm3 = xm2; xm2 = xm1; xm1 = xv; }
        asm volatile("s_waitcnt lgkmcnt(0)" ::: "memory");
        bf16x8 Af[4];
#pragma unroll
        for (int ks = 0; ks < 4; ++ks) { const LAS f32x4* s = (const LAS f32x4*)(ut + ql * 68 + 16 * ks + 8 * hh); const f32x4 x0 = s[0], x1 = s[1];
            u32x4 pw; pw.x = cvt_pk_bf16(x0[0], x0[1]); pw.y = cvt_pk_bf16(x0[2], x0[3]); pw.z = cvt_pk_bf16(x1[0], x1[1]); pw.w = cvt_pk_bf16(x1[2], x1[3]); Af[ks] = __builtin_bit_cast(bf16x8, pw); }
        f32x16 Dr[2], Dx[2];
#pragma unroll
        for (int nb = 0; nb < 2; ++nb) { Dr[nb] = (f32x16){0.f, 0.f, 0.f, 0.f, 0.f, 0.f, 0.f, 0.f, 0.f, 0.f, 0.f, 0.f, 0.f, 0.f, 0.f, 0.f}; Dx[nb] = Dr[nb];
#pragma unroll
            for (int ks = 0; ks < 4; ++ks) { Dr[nb] = __builtin_amdgcn_mfma_f32_32x32x16_bf16(Af[ks], Wa[nb][ks], Dr[nb], 0, 0, 0); Dx[nb] = __builtin_amdgcn_mfma_f32_32x32x16_bf16(Af[ks], Wx[nb][ks], Dx[nb], 0, 0, 0); } }
#pragma unroll
        for (int nb = 0; nb < 2; ++nb)
#pragma unroll
            for (int rr = 0; rr < 16; ++rr) { const int row = (rr & 3) + 8 * (rr >> 2) + 4 * hh; const int o = row * 68 + 32 * nb + ql;
                const float rs = sigm(Dr[nb][rr] + bav[nb]), is = sigm(Dx[nb][rr] + bxv[nb]);
                const float a = __builtin_amdgcn_exp2f(-splv[nb] * rs); const float uv = ut[o];
                at[o] = a; ut[o] = __builtin_amdgcn_sqrtf(fmaxf(1.0f - a * a, 0.f)) * (is * uv); }
        asm volatile("s_waitcnt lgkmcnt(0)" ::: "memory");
        if (!FINAL) {
#pragma unroll 8
            for (int tt = 0; tt < 32; ++tt) { const float a = at[tt * 68 + lane], d = ut[tt * 68 + lane]; hst = a * hst + d; Ap *= a; }
        } else {
#pragma unroll 8
            for (int tt = 0; tt < 32; ++tt) { const float a = at[tt * 68 + lane], d = ut[tt * 68 + lane]; hst = a * hst + d;
                const float gv = bf2f(ZB[(tk0 + tt) * DIN + 2048 + c]); const float y2 = 1.5957691216057308f * (gv + 0.044715f * gv * gv * gv);
                at[tt * 68 + lane] = hst * gv * sigm(y2); }
            asm volatile("s_waitcnt lgkmcnt(0)" ::: "memory");
            f32x4 ov[8]; float ss = 0.f;
#pragma unroll
            for (int q = 0; q < 8; ++q) { ov[q] = *(const LAS f32x4*)(at + ql * 68 + 32 * hh + 4 * q); ss += (ov[q][0] * ov[q][0] + ov[q][1] * ov[q][1]) + (ov[q][2] * ov[q][2] + ov[q][3] * ov[q][3]); }
            ss += __shfl_xor(ss, 32);
            if (hh == 0) part[(hf * 32 + ql) * 8 + g] = ss;
            __syncthreads();
            const LAS f32x4* pp = (const LAS f32x4*)(part + (hf * 32 + ql) * 8); const f32x4 p0 = pp[0], p1 = pp[1];
            const float rstd = rsqrtf(((p0[0] + p0[1]) + (p0[2] + p0[3]) + (p1[0] + p1[1]) + (p1[2] + p1[3])) * (1.0f / DR) + EPS);
            bf16_t* mo = (bf16_t*)(p.ws + WS_MIX) + (tk0 + ql) * D + DA + g * 64 + 32 * hh;
#pragma unroll
            for (int q = 0; q < 4; ++q) { u32x4 wv; wv.x = cvt_pk_bf16(ov[2 * q][0] * rstd, ov[2 * q][1] * rstd); wv.y = cvt_pk_bf16(ov[2 * q][2] * rstd, ov[2 * q][3] * rstd);
                wv.z = cvt_pk_bf16(ov[2 * q + 1][0] * rstd, ov[2 * q + 1][1] * rstd); wv.w = cvt_pk_bf16(ov[2 * q + 1][2] * rstd, ov[2 * q + 1][3] * rstd); *(u32x4*)(mo + 8 * q) = wv; }
        }
    }
    if (!FINAL) { float* ag = AGG + (size_t)(b * 128 + chunk) * 1024 + c; ag[0] = Ap; ag[512] = hst; }
}

__device__ __forceinline__ void attn_merge_unit(const Params& p, int unit) {
    const int tid = threadIdx.x, lane = tid & 63, w = tid >> 6;
    const bf16_t* OB = (const bf16_t*)(p.ws + WS_OB); const float* LSE = (const float*)(p.ws + WS_LSE);
    for (int ti = 0; ti < 8; ++ti) {
        const size_t tok = (size_t)unit * 64 + w * 8 + ti;
        float ls[3]; u32x4 ov[3];
#pragma unroll
        for (int br = 0; br < 3; ++br) { ls[br] = LSE[((size_t)br * M + tok) * NH + (lane >> 3)]; ov[br] = *(const u32x4*)(OB + ((size_t)br * M + tok) * DA + 8 * lane); }
        const float mx = fmaxf(ls[0], fmaxf(ls[1], ls[2]));
        float wb[3];
#pragma unroll
        for (int br = 0; br < 3; ++br) wb[br] = __builtin_amdgcn_exp2f(ls[br] - mx);
        const float wi = 1.0f / (wb[0] + wb[1] + wb[2]);
        float o[8];
#pragma unroll
        for (int q = 0; q < 4; ++q) { float lo = 0.f, hi = 0.f;
#pragma unroll
            for (int br = 0; br < 3; ++br) { lo += wb[br] * bf_lo(ov[br][q]); hi += wb[br] * bf_hi(ov[br][q]); }
            o[2 * q] = lo * wi; o[2 * q + 1] = hi * wi; }
        float ss = 0.f;
#pragma unroll
        for (int q = 0; q < 8; ++q) ss += o[q] * o[q];
        ss = wave_sum(ss);
        const float rstd = rsqrtf(ss * (1.0f / DA) + EPS);
        u32x4 wv; wv.x = cvt_pk_bf16(o[0] * rstd, o[1] * rstd); wv.y = cvt_pk_bf16(o[2] * rstd, o[3] * rstd); wv.z = cvt_pk_bf16(o[4] * rstd, o[5] * rstd); wv.w = cvt_pk_bf16(o[6] * rstd, o[7] * rstd);
        *(u32x4*)((bf16_t*)(p.ws + WS_MIX) + tok * D + 8 * lane) = wv;
    }
}
__device__ __forceinline__ void ph_mix1(const Params& p, LAS unsigned char* lds, int l) {
    for (int it = blockIdx.x; it < 1536 + 256; it += gridDim.x) { if (it < 1536) attn_item(p, lds, it); else rnn_unit<false>(p, lds, l, it - 1536); }
}
__device__ __forceinline__ void ph_mix2(const Params& p, LAS unsigned char* lds, int l) {
    for (int u = blockIdx.x; u < 256; u += gridDim.x) { rnn_unit<true>(p, lds, l, u); attn_merge_unit(p, u); }
}

#define DYN_LDS extern __shared__ __attribute__((aligned(16))) unsigned char smem_[]; LAS unsigned char* lds = (LAS unsigned char*)smem_
__global__ void __launch_bounds__(512, 2) k_prologue(Params p, int which) { DYN_LDS; ph_prologue(p, lds, which); }
__global__ void __launch_bounds__(512, 2) k_norm(Params p, const float* src, float* dst, int mode, const int* counts, int donorm) { DYN_LDS; ph_norm(p, lds, src, dst, mode, counts, donorm != 0); }
__global__ void __launch_bounds__(512, 2) k_win(Params p, int l) { DYN_LDS; ph_win(p, lds, l); }
__global__ void __launch_bounds__(512, 2) k_wout(Params p, int l, const float* base, float* out) { DYN_LDS; ph_wout(p, lds, l, base, out); }

__global__ void __launch_bounds__(512, 2) k_router2(Params p, int l, const float* X) { DYN_LDS; ph_router(p, lds, l, X); }
__global__ void __launch_bounds__(512, 2) k_gateup(Params p, int l) { DYN_LDS; ph_gateup(p, lds, l); }
__global__ void __launch_bounds__(512, 2) k_down(Params p, int l) { DYN_LDS; ph_down(p, lds, l); }
__global__ void __launch_bounds__(512, 2) k_mix1(Params p, int l) { DYN_LDS; ph_mix1(p, lds, l); }
__global__ void __launch_bounds__(512, 2) k_mix2(Params p, int l) { DYN_LDS; ph_mix2(p, lds, l); }
__global__ void k_zb_to_zf(const bf16_t* ZB, float* Zf, const float* kn) {
    const size_t i = (size_t)blockIdx.x * blockDim.x + threadIdx.x; if (i >= (size_t)M * DIN) return;
    const int c = (int)(i % DIN); float v = bf2f(ZB[i]);
    if (c < DA) v = v / (kn[c & 63] * LOG2E); else if (c < 2 * DA) v = v * kn[c & 63];
    Zf[i] = v;
}
__global__ void k_rmsnorm_bf16(const float* x, int ldx, bf16_t* out, int ldo, int W, int rows) {
    const int row = blockIdx.x * (blockDim.x / 64) + (threadIdx.x >> 6), lane = threadIdx.x & 63;
    if (row >= rows) return;
    const float* xr = x + (size_t)row * ldx; float s = 0.f;
    for (int i = lane; i < W; i += 64) { const float v = xr[i]; s += v * v; }
    s = wave_sum(s);
    const float r = rsqrtf(s / W + EPS);
    for (int i = lane; i < W; i += 64) out[(size_t)row * ldo + i] = (bf16_t)(cvt_pk_bf16(xr[i] * r, 0.f) & 0xffffu);
}
}

#ifndef DEBUG_NAIVE_ATTN
#define DEBUG_NAIVE_ATTN 0
#endif
#ifndef DEBUG_NAIVE_RNN
#define DEBUG_NAIVE_RNN 0
#endif

extern "C" void kernel_launch(void* const* d_in, const int* in_sizes, int n_in, void* d_out, int out_size, void* d_ws, size_t ws_size, hipStream_t stream) {
    static int inited = 0;
    if (!inited) {
        inited = 1;
        const void* ks[] = {(const void*)k_prologue, (const void*)k_norm, (const void*)k_win, (const void*)k_wout, (const void*)k_mix1, (const void*)k_mix2, (const void*)k_router2, (const void*)k_gateup, (const void*)k_down};
        for (const void* k : ks) (void)hipFuncSetAttribute(k, hipFuncAttributeMaxDynamicSharedMemorySize, LDS_BYTES);
        if (ws_size < 1024 * MiB) fprintf(stderr, "kernel_launch: ws_size %zu smaller than expected\n", ws_size);
    }
    const float* x_in = (const float*)d_in[0]; const float* rel = (const float*)d_in[1];
    float* X = (float*)d_out;
    unsigned char* ws = (unsigned char*)d_ws;
    Params p{}; for (int i = 0; i < 24; ++i) p.in[i] = (const float*)d_in[i]; p.out = X; p.ws = ws;
    float* Z = (float*)(ws + 736 * MiB); float* ATT = (float*)(ws + 896 * MiB); float* RN = (float*)(ws + 928 * MiB);
    float* U = (float*)(ws + 616 * MiB); float* Aa = (float*)(ws + 656 * MiB); float* Dv = (float*)(ws + 688 * MiB);
    int* counts = (int*)(ws + WS_CNT);
    bf16_t* ZB = (bf16_t*)(ws + WS_ZB); bf16_t* MIX = (bf16_t*)(ws + WS_MIX);
    (void)hipMemsetAsync(ws + WS_CTL, 0, CTL_ZERO, stream);
    k_prologue<<<256, 512, LDS_BYTES, stream>>>(p, 3);
    k_norm<<<256, 512, LDS_BYTES, stream>>>(p, x_in, X, 0, nullptr, 1);
    for (int l = 0; l < DEPTH; ++l) {
        k_win<<<256, 512, LDS_BYTES, stream>>>(p, l);
        k_mix1<<<256, 512, LDS_BYTES, stream>>>(p, l);
        k_mix2<<<256, 512, LDS_BYTES, stream>>>(p, l);
#if DEBUG_NAIVE_ATTN || DEBUG_NAIVE_RNN
        k_zb_to_zf<<<(unsigned)(((size_t)M * DIN) / 256), 256, 0, stream>>>(ZB, Z, (const float*)d_in[5] + l * HD);
#endif
#if DEBUG_NAIVE_ATTN
        k_attn<<<M * NH / 4, 256, 0, stream>>>(Z, rel, ATT);
        k_rmsnorm_bf16<<<M / 4, 256, 0, stream>>>(ATT, DA, MIX, D, DA, M);
#endif
#if DEBUG_NAIVE_RNN
        k_conv<<<(M * DR) / 256, 256, 0, stream>>>(Z, (const float*)d_in[6] + l * 4 * DR, (const float*)d_in[7] + l * DR, U);
        k_gates<<<(M * DR) / 256, 256, 0, stream>>>(U, (const float*)d_in[8] + l * 8 * 64 * 64, (const float*)d_in[9] + l * DR, (const float*)d_in[10] + l * 8 * 64 * 64, (const float*)d_in[11] + l * DR, (const float*)d_in[12] + l * DR, Aa, Dv);
        k_scan<<<(BATCH * DR) / 64, 64, 0, stream>>>(Aa, Dv, Z, RN);
        k_rmsnorm_bf16<<<M / 4, 256, 0, stream>>>(RN, DR, MIX + DA, D, DR, M);
#endif
        k_wout<<<256, 512, LDS_BYTES, stream>>>(p, l, l == 0 ? x_in : X, X);
        k_router2<<<256, 512, LDS_BYTES, stream>>>(p, l, X);
        k_gateup<<<256, 512, LDS_BYTES, stream>>>(p, l);
        k_down<<<256, 512, LDS_BYTES, stream>>>(p, l);
        k_norm<<<256, 512, LDS_BYTES, stream>>>(p, X, X, 1, counts + l * NE, l < DEPTH - 1 ? 1 : 0);
    }
}
```

```cpp
#include <hip/hip_runtime.h>
#include <cstdio>
#include <cstdint>
#include <cmath>

namespace {
constexpr int BATCH = 2, SEQ = 8192, M = BATCH * SEQ, D = 1024, DEPTH = 4;
constexpr int NH = 8, HD = 64, DA = 512, DR = 512, DIN = 2560;
constexpr int NE = 32, EPG = 8, NG = 4, DE = 512;
constexpr float EPS = 1e-6f;

__device__ __forceinline__ float wave_sum(float v) {
#pragma unroll
    for (int o = 1; o < 64; o <<= 1) v += __shfl_xor(v, o);
    return v;
}

#define LAS __attribute__((address_space(3)))
typedef unsigned short bf16_t;
typedef short bf16x8 __attribute__((ext_vector_type(8)));
typedef short s16x4 __attribute__((ext_vector_type(4)));
typedef float f32x4 __attribute__((ext_vector_type(4)));
typedef float f32x16 __attribute__((ext_vector_type(16)));
typedef unsigned u32x4 __attribute__((ext_vector_type(4)));
typedef unsigned u32x2 __attribute__((ext_vector_type(2)));
__device__ __forceinline__ unsigned cvt_pk_bf16(float lo, float hi) { unsigned r; asm volatile("v_cvt_pk_bf16_f32 %0, %1, %2" : "=v"(r) : "v"(lo), "v"(hi)); return r; }
__device__ __forceinline__ float bf_lo(unsigned w) { return __uint_as_float(w << 16); }
__device__ __forceinline__ float bf_hi(unsigned w) { return __uint_as_float(w & 0xffff0000u); }
__device__ __forceinline__ float bf2f(bf16_t v) { return __uint_as_float(((unsigned)v) << 16); }

__device__ __forceinline__ int opaque_tid() { int t = threadIdx.x; asm volatile("" : "+v"(t)); return t; }
__device__ __forceinline__ unsigned char* opaque_ptr(unsigned char* w) { asm volatile("" : "+s"(w)); return w; }
constexpr float LOG2E = 1.4426950408889634f;
constexpr size_t MiB = 1ull << 20;
constexpr size_t WS_CTL = 0, CTL_ZERO = 128 * 1024;
constexpr size_t WS_CNT = 64 * 1024;
constexpr size_t WS_BT = 1 * MiB;
constexpr size_t WS_GQK = 1 * MiB + 64 * 1024;
constexpr size_t WS_SPL = 1 * MiB + 128 * 1024;
constexpr size_t WS_RT = 2 * MiB;
constexpr size_t WS_WAT = 3 * MiB;
constexpr size_t WS_WIN = 4 * MiB;
constexpr size_t WS_WOUT = 24 * MiB;
constexpr size_t WS_WGU = 32 * MiB;
constexpr size_t WS_WD = 288 * MiB;
constexpr size_t WS_HN = 416 * MiB;
constexpr size_t WS_ZB = 448 * MiB;
constexpr size_t WS_OB = 528 * MiB;
constexpr size_t WS_LSE = 576 * MiB;
constexpr size_t WS_AGG = 578 * MiB;
constexpr size_t WS_MIX = 580 * MiB;
constexpr size_t WS_TOK = 612 * MiB;
constexpr size_t WS_LIST = 613 * MiB;
constexpr size_t WS_ACT = 616 * MiB;
constexpr size_t WS_Y = 656 * MiB;
constexpr size_t WS_END = 736 * MiB;
constexpr int MAXTILES = 160;
constexpr int LDS_BYTES = 160 * 1024;
constexpr int LDS_STAGE = 0;
constexpr int LDS_TAB = 131072;
constexpr int LDS_MISC = LDS_BYTES - 256;

namespace pg8 {
constexpr int BM = 256, BK = 64, HALF = 128, HTB = HALF * BK * 2, STAGE_BYTES = 8 * HTB, NXCD = 8, WGM = 8;
__host__ __device__ __forceinline__ int lds_byte(int r, int c) { const int st = (r >> 4) * 2 + (c >> 5), rr = r & 15, cc = c & 31, ob = rr * 64 + cc * 2; return st * 1024 + (ob ^ (((ob >> 9) & 1) << 5)); }
__host__ __device__ __forceinline__ void stage_rc(int b, int& R, int& C) { const int st = b / 1024, sb = b % 1024, swz = sb ^ (((sb >> 9) & 1) << 5); R = (st >> 1) * 16 + swz / 64; C = (st & 1) * 32 + (swz % 64) / 2; }
__host__ __device__ __forceinline__ int perm32(int rho) { const int n = rho >> 4, i = rho & 15; return 8 * (i >> 2) + 4 * n + (i & 3); }

struct Unit { int pm, pn; const char* a; const char* b; const int* glist; int gcount; };

struct StaticOrder {
    int nM, nN, nwg, G, c; const char* A; const char* Bt; size_t tA, tB;
    __device__ void init(const bf16_t* A_, const bf16_t* Bt_, int M_, int N_, int K_, int G_, int c_) { nM = M_ / BM; nN = N_ / BM; nwg = nM * nN; G = G_; c = c_; A = (const char*)A_; Bt = (const char*)Bt_; tA = (size_t)BM * K_ * 2; tB = tA; }
    __device__ bool next(int i, Unit& u) const {
        const long L = (long)i * G + c; if (L >= nwg) return false;
        int wgid = (int)L; { const int q = nwg / NXCD, r = nwg % NXCD, xcd = wgid % NXCD, off = wgid / NXCD; wgid = (xcd < r ? xcd * (q + 1) : r * (q + 1) + (xcd - r) * q) + off; }
        const int nig = WGM * nN, gid = wgid / nig, fm = gid * WGM, gsz = (nM - fm) < WGM ? (nM - fm) : WGM;
        u.pm = fm + ((wgid % nig) % gsz); u.pn = (wgid % nig) / gsz; u.a = A + (size_t)u.pm * tA; u.b = Bt + (size_t)u.pn * tB; u.glist = nullptr; u.gcount = 0; return true;
    }
};
struct MoeOrder {
    int G, c, ntiles; const LAS int* tile_e; const LAS int* tile_r0; const LAS int* cnt;
    const char* A; size_t tA; const char* W; size_t estride, tB; const int* list; int Mrows;
    __device__ bool next(int i, Unit& u) const {
        const int L = i * G + c; if (L >= ntiles * 4) return false;
        const int gt = L >> 2, e = __builtin_amdgcn_readfirstlane(tile_e[gt]), r0 = __builtin_amdgcn_readfirstlane(tile_r0[gt]);
        u.pm = gt; u.pn = L & 3; u.a = A + (size_t)gt * tA; u.b = W + (size_t)e * estride + (size_t)u.pn * tB;
        u.glist = list + (size_t)e * Mrows + r0; u.gcount = __builtin_amdgcn_readfirstlane(cnt[e]) - r0; return true;
    }
};

template <class Epi, class Sched, bool GATHER>
__device__ __forceinline__ void gemm_phase(LAS unsigned char* lds, const bf16_t* Abase, int K, const Sched& S, const Epi& E) {
    const int tid = opaque_tid(), wid = __builtin_amdgcn_readfirstlane(tid >> 6), lane = tid & 63, wr = wid >> 2, wc = wid & 3, fr = lane & 15, fq = lane >> 4;
    const int nt = K / BK;
    const size_t kstep = (size_t)(BK * 2);
    const unsigned hstep = (unsigned)HALF * K * 2;
    unsigned voffB[2]; int RA[2], CA[2];
#pragma unroll
    for (int i = 0; i < 2; ++i) { int R, C; stage_rc(tid * 16 + i * 8192, R, C); const int Rb = Epi::PERM ? ((R & ~31) + perm32(R & 31)) : R;
        RA[i] = R; CA[i] = C; voffB[i] = (unsigned)(Rb * K + C) * 2u; }
    unsigned voffB2[2][2];
#pragma unroll
    for (int h = 0; h < 2; ++h)
#pragma unroll
        for (int i = 0; i < 2; ++i) voffB2[h][i] = voffB[i] + h * hstep;
    const unsigned ldsw = (unsigned)wid * 1024u;
    const int aoff = lds_byte(wr * 64 + fr, fq * 8), boff = lds_byte(wc * 32 + fr, fq * 8);
#define PG8_SA(b, h) (((b) * 2 + (h)) * HTB)
#define PG8_SB(b, h) ((4 + (b) * 2 + (h)) * HTB)
#define PG8_STAGE(bufoff, gbase, OFF, h) do { _Pragma("unroll") for (int _i = 0; _i < 2; ++_i) \
        __builtin_amdgcn_global_load_lds((const unsigned*)((const char*)(gbase) + (OFF)[h][_i]), (LAS unsigned*)(lds + (bufoff) + ldsw + _i * 8192), 16, 0, 0); } while (0)
#define PG8_LDA(dst, b, h) do { _Pragma("unroll") for (int m = 0; m < 4; ++m) _Pragma("unroll") for (int k = 0; k < 2; ++k) dst[m][k] = *(const LAS bf16x8*)(lds + PG8_SA(b, h) + aoff + m * 2048 + k * 1024); } while (0)
#define PG8_LDB(dst, b, h) do { _Pragma("unroll") for (int n = 0; n < 2; ++n) _Pragma("unroll") for (int k = 0; k < 2; ++k) dst[n][k] = *(const LAS bf16x8*)(lds + PG8_SB(b, h) + boff + n * 2048 + k * 1024); } while (0)
#define PG8_MMA(ai, bj, At, Bt) do { __builtin_amdgcn_s_setprio(1); _Pragma("unroll") for (int m = 0; m < 4; ++m) _Pragma("unroll") for (int n = 0; n < 2; ++n) _Pragma("unroll") for (int k = 0; k < 2; ++k) \
        acc[ai][bj][m][n] = __builtin_amdgcn_mfma_f32_16x16x32_bf16(Bt[n][k], At[m][k], acc[ai][bj][m][n], 0, 0, 0); __builtin_amdgcn_s_setprio(0); } while (0)
#define PG8_WAIT_V(n) asm volatile("s_waitcnt vmcnt(" #n ")" ::: "memory")
#define PG8_WAIT_L(n) asm volatile("s_waitcnt lgkmcnt(" #n ")" ::: "memory")
#define PG8_BAR __builtin_amdgcn_s_barrier()
#define PG8_SCHED __builtin_amdgcn_sched_barrier(0)
#define PG8_AOFF(dst, u) do { if constexpr (GATHER) { _Pragma("unroll") for (int _h = 0; _h < 2; ++_h) _Pragma("unroll") for (int _i = 0; _i < 2; ++_i) { \
            const int _r = _h * HALF + RA[_i]; const int _t = (_r < (u).gcount) ? (u).glist[_r] : 0; dst[_h][_i] = (unsigned)(_t * K + CA[_i]) * 2u; } \
            asm volatile("" : "+v"(dst[0][0]), "+v"(dst[0][1]), "+v"(dst[1][0]), "+v"(dst[1][1])); } \
        else { _Pragma("unroll") for (int _h = 0; _h < 2; ++_h) _Pragma("unroll") for (int _i = 0; _i < 2; ++_i) dst[_h][_i] = (unsigned)(RA[_i] * K + CA[_i]) * 2u + _h * hstep; } } while (0)
    Unit cur, nxt; int ui = 0;
    if (!S.next(0, cur)) return;
    f32x4 acc[2][2][4][2];
#pragma unroll
    for (int a = 0; a < 2; ++a)
#pragma unroll
        for (int b = 0; b < 2; ++b)
#pragma unroll
            for (int m = 0; m < 4; ++m)
#pragma unroll
                for (int n = 0; n < 2; ++n) acc[a][b][m][n] = (f32x4){0.f, 0.f, 0.f, 0.f};
    bf16x8 At[4][2], B0[2][2], B1[2][2];
    unsigned oc[2][2], on[2][2];
    PG8_AOFF(oc, cur);
    const char* cA = GATHER ? (const char*)Abase : cur.a; const char* cB = cur.b;
    PG8_STAGE(PG8_SB(0, 0), cB, voffB2, 0); PG8_STAGE(PG8_SB(0, 1), cB, voffB2, 1); PG8_STAGE(PG8_SA(0, 0), cA, oc, 0); PG8_STAGE(PG8_SA(0, 1), cA, oc, 1);
    if (wr == 1) PG8_BAR;
    PG8_WAIT_V(2); PG8_BAR;
    PG8_STAGE(PG8_SB(1, 0), cB + kstep, voffB2, 0); PG8_STAGE(PG8_SA(1, 0), cA + kstep, oc, 0); PG8_STAGE(PG8_SB(1, 1), cB + kstep, voffB2, 1);
    PG8_WAIT_V(6); PG8_BAR;
    for (;;) {
        const bool has_next = S.next(ui + 1, nxt);
        const char* nA; const char* nB;
        if (has_next) { nA = GATHER ? (const char*)Abase : nxt.a; nB = nxt.b; PG8_AOFF(on, nxt); }
        else { nA = cA; nB = cB;
#pragma unroll
            for (int h = 0; h < 2; ++h)
#pragma unroll
                for (int i = 0; i < 2; ++i) on[h][i] = oc[h][i]; }
        for (int t = 0; t < nt; t += 2) {
            const bool last = (t == nt - 2);
            const char* a1 = cA + (size_t)(t + 1) * kstep;
            const char* a2 = last ? nA : cA + (size_t)(t + 2) * kstep; const char* b2 = last ? nB : cB + (size_t)(t + 2) * kstep;
            const char* a3 = a2 + kstep; const char* b3 = b2 + kstep;
            unsigned o2[2][2];
#pragma unroll
            for (int h = 0; h < 2; ++h)
#pragma unroll
                for (int i = 0; i < 2; ++i) o2[h][i] = last ? on[h][i] : oc[h][i];
            PG8_LDB(B0, 0, 0); PG8_LDB(B1, 0, 1); PG8_SCHED; PG8_LDA(At, 0, 0); PG8_STAGE(PG8_SA(1, 1), a1, oc, 1);
            PG8_WAIT_V(8); PG8_WAIT_L(0); PG8_BAR; PG8_MMA(0, 0, At, B0); PG8_MMA(0, 1, At, B1); PG8_BAR; PG8_SCHED;
            PG8_LDA(At, 0, 1); PG8_STAGE(PG8_SB(0, 0), b2, voffB2, 0); PG8_STAGE(PG8_SB(0, 1), b2, voffB2, 1); PG8_STAGE(PG8_SA(0, 0), a2, o2, 0);
            PG8_WAIT_V(8); PG8_WAIT_L(0); PG8_BAR; PG8_MMA(1, 0, At, B0); PG8_MMA(1, 1, At, B1); PG8_BAR; PG8_SCHED;
            PG8_LDB(B0, 1, 0); PG8_LDB(B1, 1, 1); PG8_SCHED; PG8_LDA(At, 1, 0); PG8_STAGE(PG8_SA(0, 1), a2, o2, 1);
            PG8_WAIT_V(8); PG8_WAIT_L(0); PG8_BAR; PG8_MMA(0, 0, At, B0); PG8_MMA(0, 1, At, B1); PG8_BAR; PG8_SCHED;
            PG8_LDA(At, 1, 1); PG8_STAGE(PG8_SB(1, 0), b3, voffB2, 0); PG8_STAGE(PG8_SB(1, 1), b3, voffB2, 1); PG8_STAGE(PG8_SA(1, 0), a3, o2, 0);
            PG8_WAIT_V(8); PG8_WAIT_L(0); PG8_BAR; PG8_MMA(1, 0, At, B0); PG8_MMA(1, 1, At, B1); PG8_BAR; PG8_SCHED;
        }
        if (wr == 0) PG8_BAR;
        E(acc, cur, wr, wc, fr, fq);
        if (!has_next) break;
#pragma unroll
        for (int a = 0; a < 2; ++a)
#pragma unroll
            for (int b = 0; b < 2; ++b)
#pragma unroll
                for (int m = 0; m < 4; ++m)
#pragma unroll
                    for (int n = 0; n < 2; ++n) acc[a][b][m][n] = (f32x4){0.f, 0.f, 0.f, 0.f};
        cur = nxt; cA = nA; cB = nB; ++ui;
#pragma unroll
        for (int h = 0; h < 2; ++h)
#pragma unroll
            for (int i = 0; i < 2; ++i) oc[h][i] = on[h][i];
        if (wr == 1) PG8_BAR;
    }
    PG8_WAIT_V(0);
    PG8_BAR;
#undef PG8_SA
#undef PG8_SB
#undef PG8_STAGE
#undef PG8_LDA
#undef PG8_LDB
#undef PG8_MMA
#undef PG8_WAIT_V
#undef PG8_WAIT_L
#undef PG8_BAR
#undef PG8_SCHED
#undef PG8_AOFF
}


struct EpiQKV {
    static constexpr bool PERM = true;
    bf16_t* ZB; const LAS float* gqk;
    __device__ __forceinline__ void operator()(const f32x4 (&acc)[2][2][4][2], const Unit& u, int wr, int wc, int fr, int fq) const {
        const int type = u.pn >> 1;
        f32x4 g[2][2];
        if (type == 0) {
#pragma unroll
            for (int bj = 0; bj < 2; ++bj)
#pragma unroll
                for (int n = 0; n < 2; ++n) g[bj][n] = *(const LAS f32x4*)(gqk + 32 * bj + 8 * fq + 4 * n);
        }
#pragma unroll
        for (int ai = 0; ai < 2; ++ai)
#pragma unroll
            for (int m = 0; m < 4; ++m) {
                const int row = u.pm * BM + ai * HALF + wr * 64 + m * 16 + fr;
                f32x4 v[2][2];
#pragma unroll
                for (int bj = 0; bj < 2; ++bj)
#pragma unroll
                    for (int n = 0; n < 2; ++n) v[bj][n] = acc[ai][bj][m][n];
                if (type < 2) {
                    float ss = 0.f;
#pragma unroll
                    for (int bj = 0; bj < 2; ++bj)
#pragma unroll
                        for (int n = 0; n < 2; ++n) ss += (v[bj][n][0] * v[bj][n][0] + v[bj][n][1] * v[bj][n][1]) + (v[bj][n][2] * v[bj][n][2] + v[bj][n][3] * v[bj][n][3]);
                    ss += __shfl_xor(ss, 16); ss += __shfl_xor(ss, 32);
                    const float rstd = rsqrtf(ss * (1.0f / 64.0f) + 1e-6f);
#pragma unroll
                    for (int bj = 0; bj < 2; ++bj)
#pragma unroll
                        for (int n = 0; n < 2; ++n) { v[bj][n] = v[bj][n] * rstd; if (type == 0) v[bj][n] = v[bj][n] * g[bj][n]; }
                }
                bf16_t* rowp = ZB + (size_t)row * 2560 + u.pn * BM + wc * 64 + 8 * fq;
#pragma unroll
                for (int bj = 0; bj < 2; ++bj) { u32x4 w; w.x = cvt_pk_bf16(v[bj][0][0], v[bj][0][1]); w.y = cvt_pk_bf16(v[bj][0][2], v[bj][0][3]); w.z = cvt_pk_bf16(v[bj][1][0], v[bj][1][1]); w.w = cvt_pk_bf16(v[bj][1][2], v[bj][1][3]);
                    *(u32x4*)(rowp + 32 * bj) = w; }
            }
    }
};
struct EpiRes {
    static constexpr bool PERM = false;
    const float* base; float* out; int ldc;
    __device__ __forceinline__ void operator()(const f32x4 (&acc)[2][2][4][2], const Unit& u, int wr, int wc, int fr, int fq) const {
        const int row0 = u.pm * BM + wr * 64 + fr, col0 = u.pn * BM + wc * 32 + 4 * fq;
#pragma unroll
        for (int ai = 0; ai < 2; ++ai)
#pragma unroll
            for (int m = 0; m < 4; ++m) { const size_t off = (size_t)(row0 + ai * HALF + m * 16) * ldc + col0;
#pragma unroll
                for (int bj = 0; bj < 2; ++bj)
#pragma unroll
                    for (int n = 0; n < 2; ++n) { const f32x4 bs = *(const f32x4*)(base + off + bj * HALF + n * 16); *(f32x4*)(out + off + bj * HALF + n * 16) = bs + acc[ai][bj][m][n]; }
                asm volatile("" ::: "memory"); }
    }
};
struct EpiSwiGLU {
    static constexpr bool PERM = true;
    bf16_t* ACT;
    __device__ __forceinline__ void operator()(const f32x4 (&acc)[2][2][4][2], const Unit& u, int wr, int wc, int fr, int fq) const {
#pragma unroll
        for (int ai = 0; ai < 2; ++ai)
#pragma unroll
            for (int m = 0; m < 4; ++m) {
                const int row = u.pm * BM + ai * HALF + wr * 64 + m * 16 + fr;
                float o[8];
#pragma unroll
                for (int n = 0; n < 2; ++n)
#pragma unroll
                    for (int j = 0; j < 4; ++j) { const float gv = acc[ai][0][m][n][j], uv = acc[ai][1][m][n][j];
                        o[n * 4 + j] = gv * __builtin_amdgcn_rcpf(1.0f + __builtin_amdgcn_exp2f(-gv * LOG2E)) * uv; }
                u32x4 w; w.x = cvt_pk_bf16(o[0], o[1]); w.y = cvt_pk_bf16(o[2], o[3]); w.z = cvt_pk_bf16(o[4], o[5]); w.w = cvt_pk_bf16(o[6], o[7]);
                *(u32x4*)(ACT + (size_t)row * 512 + u.pn * 128 + wc * 32 + 8 * fq) = w;
            }
    }
};
struct EpiBf16 {
    static constexpr bool PERM = true;
    bf16_t* O; int ldc;
    __device__ __forceinline__ void operator()(const f32x4 (&acc)[2][2][4][2], const Unit& u, int wr, int wc, int fr, int fq) const {
        const int row0 = u.pm * BM + wr * 64 + fr, col0 = u.pn * BM + wc * 32 + 8 * fq;
#pragma unroll
        for (int ai = 0; ai < 2; ++ai)
#pragma unroll
            for (int m = 0; m < 4; ++m) { bf16_t* rowp = O + (size_t)(row0 + ai * HALF + m * 16) * ldc + col0;
#pragma unroll
                for (int bj = 0; bj < 2; ++bj) { const f32x4 v0 = acc[ai][bj][m][0], v1 = acc[ai][bj][m][1];
                    u32x4 w; w.x = cvt_pk_bf16(v0[0], v0[1]); w.y = cvt_pk_bf16(v0[2], v0[3]); w.z = cvt_pk_bf16(v1[0], v1[1]); w.w = cvt_pk_bf16(v1[2], v1[3]);
                    *(u32x4*)(rowp + bj * HALF) = w; } }
    }
};
}

struct Params { const float* in[24]; float* out; unsigned char* ws; };
#define LDS_WAIT() asm volatile("s_waitcnt lgkmcnt(0)" ::: "memory")
constexpr int NTHR = 512, NWAVE = 8;

__device__ __forceinline__ void tr_item(const float* W, int K, int N, bf16_t* WT, int drow, LAS float* scr, int k0, int n0, int lane, const float* gain) {
#pragma unroll 8
    for (int i = 0; i < 32; ++i) { const int kk = 2 * i + (lane >> 5); float v = W[(size_t)(k0 + kk) * N + n0 + (lane & 31)]; if (gain) v *= gain[k0 + kk]; scr[kk * 33 + (lane & 31)] = v; }
    LDS_WAIT(); asm volatile("" ::: "memory");
    const int c = lane & 7;
#pragma unroll
    for (int j = 0; j < 4; ++j) { const int n = (lane >> 3) + 8 * j; const LAS float* s = scr + (8 * c) * 33 + n;
        u32x4 o; o.x = cvt_pk_bf16(s[0 * 33], s[1 * 33]); o.y = cvt_pk_bf16(s[2 * 33], s[3 * 33]); o.z = cvt_pk_bf16(s[4 * 33], s[5 * 33]); o.w = cvt_pk_bf16(s[6 * 33], s[7 * 33]);
        *(u32x4*)(WT + (size_t)(drow + n) * K + k0 + 8 * c) = o; }
    LDS_WAIT(); asm volatile("" ::: "memory");
}
__device__ __forceinline__ int t5_bucket_d(int dist) {
    if (dist < 16) return dist;
    int lb = 16 + (int)(logf((float)dist / 16.f) / logf(128.f) * 16.f);
    return lb < 31 ? lb : 31;
}
__device__ __forceinline__ void ph_prologue(const Params& p, LAS unsigned char* lds, int which) {
    unsigned char* const ws_ = opaque_ptr(p.ws);
    const int tid = opaque_tid(), lane = tid & 63, wave = tid >> 6;
    LAS float* scr = (LAS float*)(lds + wave * 8704);
    const int gw = blockIdx.x * NWAVE + wave, NGW = gridDim.x * NWAVE;
    constexpr int I_IN = 16 * 80, I_OUT = 16 * 32, I_G = 16 * 16, I_D = 8 * 32, I_E = 2 * I_G + I_D;
    if (which & 1) {
        constexpr int PER_L = I_IN + I_OUT;
        for (int it = gw; it < DEPTH * PER_L; it += NGW) {
            const int l = it / PER_L; int r = it % PER_L;
            if (r < I_IN) { const int kb = r / 80, nb = r % 80, n0 = nb * 32, o = n0 & 255; const int drow = (n0 & ~255) + 128 * ((o >> 5) & 1) + 32 * ((o >> 6) & 3);
                tr_item(p.in[3] + (size_t)l * D * DIN, D, DIN, (bf16_t*)(ws_ + WS_WIN) + (size_t)l * DIN * D, drow, scr, kb * 64, n0, lane, p.in[2] + l * D); }
            else { r -= I_IN; const int kb = r / 32, nb = r % 32;
                tr_item(p.in[15] + (size_t)l * D * D, D, D, (bf16_t*)(ws_ + WS_WOUT) + (size_t)l * D * D, nb * 32, scr, kb * 64, nb * 32, lane, kb < 8 ? p.in[13] + l * DA : p.in[14] + l * DR - DA); }
        }
        const int gt = blockIdx.x * NTHR + tid, NGT = gridDim.x * NTHR;
        float* BT = (float*)(ws_ + WS_BT);
        for (int i = gt; i < 3 * 8 * 192; i += NGT) { const int br = i / (8 * 192), h = (i / 192) % 8, j = i % 192; const int dil = br == 0 ? 1 : br == 1 ? 4 : 16;
            const int steps = (190 - j) - 31; float v = -1e30f; if (j < 191 && steps >= 0 && steps <= 128) v = p.in[1][t5_bucket_d(steps * dil) * NH + h] * LOG2E; BT[i] = v; }
        float* GQK = (float*)(ws_ + WS_GQK);
        for (int i = gt; i < DEPTH * 64; i += NGT) GQK[i] = p.in[4][i] * p.in[5][i] * 0.125f * LOG2E;
        float* SPL = (float*)(ws_ + WS_SPL);
        for (int i = gt; i < DEPTH * DR; i += NGT) { const float lm = -p.in[12][i]; SPL[i] = 8.f * LOG2E * (fmaxf(lm, 0.f) + log1pf(expf(-fabsf(lm)))); }
        float* RT = (float*)(ws_ + WS_RT);
        for (int i = gt; i < DEPTH * D * 36; i += NGT) { const int l = i / (D * 36), k = (i / 36) % D, j = i % 36;
            RT[i] = p.in[16][l * D + k] * (j < 4 ? p.in[17][(l * D + k) * 4 + j] : p.in[19][(l * D + k) * 32 + j - 4]); }
        bf16_t* WAT = (bf16_t*)(ws_ + WS_WAT);
        for (int i = gt; i < DEPTH * 2 * 8 * 4096; i += NGT) { const int l = i / (2 * 8 * 4096), wh = (i / (8 * 4096)) & 1, g = (i / 4096) & 7, j = (i / 64) & 63, ii = i & 63;
            const float v = (wh ? p.in[10] : p.in[8])[((size_t)(l * 8 + g) * 64 + ii) * 64 + j]; WAT[i] = (bf16_t)(cvt_pk_bf16(v, 0.f) & 0xffffu); }
    }
    if (which & 2) {
        for (int it = gw; it < DEPTH * NE * I_E; it += NGW) {
            const int le = it / I_E; int r = it % I_E;
            const int l = le / NE;
            if (r < 2 * I_G) { const int up = r >= I_G; if (up) r -= I_G; const int kb = r / 16, nb = r % 16, n0 = nb * 32; const int drow = 256 * (n0 >> 7) + 128 * up + (n0 & 127);
                tr_item((up ? p.in[22] : p.in[21]) + (size_t)le * D * DE, D, DE, (bf16_t*)(ws_ + WS_WGU) + (size_t)le * D * D, drow, scr, kb * 64, n0, lane, p.in[16] + l * D); }
            else { r -= 2 * I_G; const int kb = r / 32, nb = r % 32;
                tr_item(p.in[23] + (size_t)le * DE * D, DE, D, (bf16_t*)(ws_ + WS_WD) + (size_t)le * D * DE, nb * 32, scr, kb * 64, nb * 32, lane, nullptr); }
        }
    }
}

__device__ __forceinline__ void build_tiles(const int* counts, LAS int* tab) {
    const int tid = opaque_tid();
    __syncthreads();
    if (tid < 64) {
        const int cnt = tid < NE ? counts[tid] : 0; const int nt = (cnt + 255) >> 8;
        int incl = nt;
#pragma unroll
        for (int o = 1; o < 32; o <<= 1) { const int v = __shfl_up(incl, o); if (tid >= o) incl += v; }
        const int excl = incl - nt;
        if (tid < NE) { tab[tid] = cnt; tab[32 + tid] = excl;
#pragma unroll 1
            for (int t = 0; t < nt; ++t) { tab[128 + excl + t] = tid; tab[288 + excl + t] = t * 256; } }
        if (tid == NE - 1) { tab[32 + NE] = incl; tab[66] = incl; }
    }
    __syncthreads();
}

__device__ __forceinline__ void ph_norm(const Params& p, LAS unsigned char* lds, const float* src, float* dst, int mode, const int* counts, bool donorm) {
    unsigned char* const ws_ = opaque_ptr(p.ws);
    const int tid = opaque_tid(), lane = tid & 63, wave = tid >> 6;
    LAS int* tab = (LAS int*)(lds + LDS_TAB);
    if (mode) build_tiles(counts, tab);
    const int* eid = (const int*)(ws_ + WS_TOK); const int* rank = eid + M * 2; const float* gate = (const float*)(rank + M * 2);
    const bf16_t* Y = (const bf16_t*)(ws_ + WS_Y); bf16_t* HN = (bf16_t*)(ws_ + WS_HN);
    for (int row = blockIdx.x * NWAVE + wave; row < M; row += gridDim.x * NWAVE) {
        const f32x4* xr = (const f32x4*)(src + (size_t)row * D) + lane;
        f32x4 v[4];
#pragma unroll
        for (int j = 0; j < 4; ++j) v[j] = xr[64 * j];
        if (mode) {
            const int e0 = eid[row * 2], e1 = eid[row * 2 + 1]; const float g0 = gate[row * 2], g1 = gate[row * 2 + 1];
            const int s0 = tab[32 + e0] * 256 + rank[row * 2], s1 = tab[32 + e1] * 256 + rank[row * 2 + 1];
            const u32x2* y0 = (const u32x2*)(Y + (size_t)s0 * D) + lane; const u32x2* y1 = (const u32x2*)(Y + (size_t)s1 * D) + lane;
#pragma unroll
            for (int j = 0; j < 4; ++j) { const u32x2 a = y0[64 * j], b = y1[64 * j];
                v[j][0] += g0 * bf_lo(a.x) + g1 * bf_lo(b.x); v[j][1] += g0 * bf_hi(a.x) + g1 * bf_hi(b.x);
                v[j][2] += g0 * bf_lo(a.y) + g1 * bf_lo(b.y); v[j][3] += g0 * bf_hi(a.y) + g1 * bf_hi(b.y); }
            f32x4* xo = (f32x4*)(dst + (size_t)row * D) + lane;
#pragma unroll
            for (int j = 0; j < 4; ++j) xo[64 * j] = v[j];
        }
        if (donorm) {
            float s = 0.f;
#pragma unroll
            for (int j = 0; j < 4; ++j) s += (v[j][0] * v[j][0] + v[j][1] * v[j][1]) + (v[j][2] * v[j][2] + v[j][3] * v[j][3]);
            s = wave_sum(s);
            const float rstd = rsqrtf(s * (1.0f / D) + EPS);
            u32x2* o = (u32x2*)(HN + (size_t)row * D) + lane;
#pragma unroll
            for (int j = 0; j < 4; ++j) { u32x2 w; w.x = cvt_pk_bf16(v[j][0] * rstd, v[j][1] * rstd); w.y = cvt_pk_bf16(v[j][2] * rstd, v[j][3] * rstd); o[64 * j] = w; }
        }
    }
}

__device__ __forceinline__ void ph_win(const Params& p, LAS unsigned char* lds, int l) {
    unsigned char* const ws_ = opaque_ptr(p.ws);
    LAS float* gq = (LAS float*)(lds + LDS_TAB + 4096);
    { const int t_ = opaque_tid(); if (t_ < 64) gq[t_] = ((const float*)(ws_ + WS_GQK))[l * 64 + t_]; }
    __syncthreads();
    pg8::StaticOrder S; S.init((const bf16_t*)(ws_ + WS_HN), (const bf16_t*)(ws_ + WS_WIN) + (size_t)l * DIN * D, M, DIN, D, gridDim.x, blockIdx.x);
    pg8::EpiQKV E{(bf16_t*)(ws_ + WS_ZB), gq};
    pg8::gemm_phase<pg8::EpiQKV, pg8::StaticOrder, false>(lds + LDS_STAGE, nullptr, D, S, E);
}
__device__ __forceinline__ void ph_wout(const Params& p, LAS unsigned char* lds, int l, const float* base, float* out) {
    unsigned char* const ws_ = opaque_ptr(p.ws);
    pg8::StaticOrder S; S.init((const bf16_t*)(ws_ + WS_MIX), (const bf16_t*)(ws_ + WS_WOUT) + (size_t)l * D * D, M, D, D, gridDim.x, blockIdx.x);
    pg8::EpiRes E{base, out, D};
    pg8::gemm_phase<pg8::EpiRes, pg8::StaticOrder, false>(lds + LDS_STAGE, nullptr, D, S, E);
}

__device__ __forceinline__ void ph_router(const Params& p, LAS unsigned char* lds, int l, const float* X) {
    unsigned char* const ws_ = opaque_ptr(p.ws);
    const int tid = opaque_tid(), lane = tid & 63, wave = tid >> 6;
    LAS float* RTl = (LAS float*)lds;
    LAS int* hist = (LAS int*)(lds + 147456); LAS int* base = hist + 32;
    LAS int* t_e = hist + 64; LAS int* t_lr = t_e + 128; LAS float* t_g = (LAS float*)(t_lr + 128);
    const float* RT = (const float*)(ws_ + WS_RT) + (size_t)l * D * 36;
    for (int i = tid; i < D * 36 / 4; i += NTHR) ((LAS f32x4*)RTl)[i] = ((const f32x4*)RT)[i];
    int* counts = (int*)(ws_ + WS_CNT) + l * NE;
    int* eid = (int*)(ws_ + WS_TOK); int* rank = eid + M * 2; float* gate = (float*)(rank + M * 2);
    int* list = (int*)(ws_ + WS_LIST); bf16_t* HN = (bf16_t*)(ws_ + WS_HN);
    const float* bg = p.in[18] + l * NG; const float* be = p.in[20] + l * NE;
    for (int grp = blockIdx.x; grp < M / 64; grp += gridDim.x) {
        __syncthreads();
        if (tid < 32) hist[tid] = 0;
        __syncthreads();
        for (int ti = 0; ti < 8; ++ti) {
            const int tl = wave * 8 + ti, tok = grp * 64 + tl;
            const f32x4* xr = (const f32x4*)(X + (size_t)tok * D) + lane;
            f32x4 v[4]; float s = 0.f;
#pragma unroll
            for (int j = 0; j < 4; ++j) { v[j] = xr[64 * j]; s += (v[j][0] * v[j][0] + v[j][1] * v[j][1]) + (v[j][2] * v[j][2] + v[j][3] * v[j][3]); }
            s = wave_sum(s);
            const float rstd = rsqrtf(s * (1.0f / D) + EPS);
            u32x2* o = (u32x2*)(HN + (size_t)tok * D) + lane;
#pragma unroll
            for (int j = 0; j < 4; ++j) { u32x2 w; w.x = cvt_pk_bf16(v[j][0] * rstd, v[j][1] * rstd); w.y = cvt_pk_bf16(v[j][2] * rstd, v[j][3] * rstd); o[64 * j] = w; }
            float acc[36];
#pragma unroll
            for (int j = 0; j < 36; ++j) acc[j] = 0.f;
            const float* xs = X + (size_t)tok * D + lane;
#pragma unroll 4
            for (int i = 0; i < 16; ++i) { const float xv = xs[64 * i] * rstd; const LAS f32x4* rr = (const LAS f32x4*)(RTl + (lane + 64 * i) * 36);
#pragma unroll
                for (int q = 0; q < 9; ++q) { const f32x4 w = rr[q]; acc[4 * q] += xv * w[0]; acc[4 * q + 1] += xv * w[1]; acc[4 * q + 2] += xv * w[2]; acc[4 * q + 3] += xv * w[3]; } }
#pragma unroll
            for (int j = 0; j < 36; ++j) acc[j] = wave_sum(acc[j]);
            float gl[4];
#pragma unroll
            for (int j = 0; j < 4; ++j) gl[j] = acc[j] + bg[j];
            int gs = 0; float gm = gl[0];
#pragma unroll
            for (int j = 1; j < 4; ++j) if (gl[j] > gm) { gm = gl[j]; gs = j; }
            float den = 0.f;
#pragma unroll
            for (int j = 0; j < 4; ++j) den += expf(gl[j] - gm);
            const float gw = 1.f / den;
            float el[8];
#pragma unroll
            for (int j = 0; j < 8; ++j) el[j] = (gs == 0 ? acc[4 + j] : gs == 1 ? acc[12 + j] : gs == 2 ? acc[20 + j] : acc[28 + j]) + be[gs * 8 + j];
            int i0 = 0; float m0 = el[0];
#pragma unroll
            for (int j = 1; j < 8; ++j) if (el[j] > m0) { m0 = el[j]; i0 = j; }
            int i1 = -1; float m1 = -3.0e38f;
#pragma unroll
            for (int j = 0; j < 8; ++j) if (j != i0 && el[j] > m1) { m1 = el[j]; i1 = j; }
            const float e1 = expf(m1 - m0); const float p0 = 1.f / (1.f + e1), p1 = e1 / (1.f + e1);
            const int ex0 = gs * 8 + i0, ex1 = gs * 8 + i1;
            if (lane == 0) { t_e[tl * 2] = ex0; t_e[tl * 2 + 1] = ex1; t_g[tl * 2] = gw * p0; t_g[tl * 2 + 1] = gw * p1;
                t_lr[tl * 2] = __hip_atomic_fetch_add(hist + ex0, 1, __ATOMIC_RELAXED, __HIP_MEMORY_SCOPE_WORKGROUP); t_lr[tl * 2 + 1] = __hip_atomic_fetch_add(hist + ex1, 1, __ATOMIC_RELAXED, __HIP_MEMORY_SCOPE_WORKGROUP); }
        }
        __syncthreads();
        if (tid < 32) { const int hcount = hist[tid]; base[tid] = hcount > 0 ? atomicAdd(&counts[tid], hcount) : 0; }
        __syncthreads();
        if (tid < 128) { const int tok = grp * 64 + (tid >> 1); const int e = t_e[tid]; const int r = base[e] + t_lr[tid];
            eid[tok * 2 + (tid & 1)] = e; rank[tok * 2 + (tid & 1)] = r; gate[tok * 2 + (tid & 1)] = t_g[tid]; list[(size_t)e * M + r] = tok; }
    }
}
__device__ __forceinline__ void ph_gateup(const Params& p, LAS unsigned char* lds, int l) {
    unsigned char* const ws_ = opaque_ptr(p.ws);
    LAS int* tab = (LAS int*)(lds + LDS_TAB);
    build_tiles((const int*)(ws_ + WS_CNT) + l * NE, tab);
    pg8::MoeOrder S; S.G = gridDim.x; S.c = blockIdx.x; S.ntiles = __builtin_amdgcn_readfirstlane(tab[66]); S.tile_e = tab + 128; S.tile_r0 = tab + 288; S.cnt = tab;
    S.A = nullptr; S.tA = 0; S.W = (const char*)((const bf16_t*)(ws_ + WS_WGU) + (size_t)l * NE * D * D); S.estride = (size_t)D * D * 2; S.tB = (size_t)256 * D * 2;
    S.list = (const int*)(ws_ + WS_LIST); S.Mrows = M;
    pg8::EpiSwiGLU E{(bf16_t*)(ws_ + WS_ACT)};
    pg8::gemm_phase<pg8::EpiSwiGLU, pg8::MoeOrder, true>(lds + LDS_STAGE, (const bf16_t*)(ws_ + WS_HN), D, S, E);
}
__device__ __forceinline__ void ph_down(const Params& p, LAS unsigned char* lds, int l) {
    unsigned char* const ws_ = opaque_ptr(p.ws);
    LAS int* tab = (LAS int*)(lds + LDS_TAB);
    build_tiles((const int*)(ws_ + WS_CNT) + l * NE, tab);
    pg8::MoeOrder S; S.G = gridDim.x; S.c = blockIdx.x; S.ntiles = __builtin_amdgcn_readfirstlane(tab[66]); S.tile_e = tab + 128; S.tile_r0 = tab + 288; S.cnt = tab;
    S.A = (const char*)(ws_ + WS_ACT); S.tA = (size_t)256 * DE * 2; S.W = (const char*)((const bf16_t*)(ws_ + WS_WD) + (size_t)l * NE * D * DE); S.estride = (size_t)D * DE * 2; S.tB = (size_t)256 * DE * 2;
    S.list = (const int*)(ws_ + WS_LIST); S.Mrows = M;
    pg8::EpiBf16 E{(bf16_t*)(ws_ + WS_Y), D};
    pg8::gemm_phase<pg8::EpiBf16, pg8::MoeOrder, false>(lds + LDS_STAGE, nullptr, DE, S, E);
}

#define TRREAD(dst, addr, off) asm volatile("ds_read_b64_tr_b16 %0, %1 offset:%2" : "=&v"(dst) : "v"(addr), "i"(off) : "memory")
__device__ __forceinline__ void attn_item(const Params& p, LAS unsigned char* lds, int item) {
    unsigned char* const ws_ = opaque_ptr(p.ws);
    const int tid = opaque_tid(), lane = tid & 63, w = __builtin_amdgcn_readfirstlane(tid >> 6), hh = lane >> 5, ql = lane & 31;
    const int br = item >> 9, rem = item & 511, b = rem >> 8, h = (rem >> 5) & 7, j = rem & 31;
    const int dsh = br * 2, dil = 1 << dsh, nblk = 32 >> dsh, r = j / nblk, blk = j % nblk, i0 = blk * 256;
    const bf16_t* ZB = (const bf16_t*)(ws_ + WS_ZB);
    LAS unsigned char* Kl = lds; LAS unsigned char* Vl = lds + 49152; LAS float* Tl = (LAS float*)(lds + 98304);
    __syncthreads();
#pragma unroll
    for (int jj = 0; jj < 6; ++jj) {
        const int idx = tid + 512 * jj, key = idx >> 3, ch = idx & 7, sub = i0 - 128 + key;
        u32x4 kv = {0u, 0u, 0u, 0u}, vv = {0u, 0u, 0u, 0u};
        if (sub >= 0) { const bf16_t* rp = ZB + (size_t)(b * SEQ + sub * dil + r) * DIN + h * HD + ch * 8; kv = *(const u32x4*)(rp + DA); vv = *(const u32x4*)(rp + 2 * DA); }
        *(LAS u32x4*)(Kl + key * 128 + ((ch ^ ((key >> 1) & 7)) << 4)) = kv;
        *(LAS u32x4*)(Vl + ((key >> 2) * 2 + (ch >> 2)) * 256 + (key & 3) * 64 + (ch & 3) * 16) = vv;
    }
    if (tid < 192) Tl[tid] = ((const float*)(ws_ + WS_BT))[(br * 8 + h) * 192 + tid];
    const int qsub = i0 + 32 * w + ql; const size_t qtok = (size_t)(b * SEQ + qsub * dil + r);
    bf16x8 qf[4];
#pragma unroll
    for (int ks = 0; ks < 4; ++ks) qf[ks] = *(const bf16x8*)(ZB + qtok * DIN + h * HD + 16 * ks + 8 * hh);
    __syncthreads();
    const int sw = (ql >> 1) & 7;
    int koff[4];
#pragma unroll
    for (int ks = 0; ks < 4; ++ks) koff[ks] = ((2 * ks + hh) ^ sw) << 4;
    const LAS unsigned char* kbase = Kl + (32 * w + ql) * 128;
    f32x16 S[5];
#pragma unroll
    for (int kb = 0; kb < 5; ++kb) {
        S[kb] = (f32x16){0.f, 0.f, 0.f, 0.f, 0.f, 0.f, 0.f, 0.f, 0.f, 0.f, 0.f, 0.f, 0.f, 0.f, 0.f, 0.f};
#pragma unroll
        for (int ks = 0; ks < 4; ++ks) { const bf16x8 kf = *(const LAS bf16x8*)(kbase + kb * 4096 + koff[ks]);
            S[kb] = __builtin_amdgcn_mfma_f32_32x32x16_bf16(kf, qf[ks], S[kb], 0, 0, 0); }
    }
    const LAS float* tl = Tl + (31 - ql + 4 * hh);
    const int thr = 128 - i0 - 32 * w;
    float mx = -3.0e38f;
#pragma unroll
    for (int kb = 0; kb < 5; ++kb)
#pragma unroll
        for (int rr = 0; rr < 16; ++rr) { const int c = 32 * kb + (rr & 3) + 8 * (rr >> 2); float s = S[kb][rr] + tl[c];
            if (thr > 0) s = (c + 4 * hh < thr) ? -1e30f : s;
            S[kb][rr] = s; mx = fmaxf(mx, s); }
    mx = fmaxf(mx, __shfl_xor(mx, 32));
    float ls = 0.f;
#pragma unroll
    for (int kb = 0; kb < 5; ++kb)
#pragma unroll
        for (int rr = 0; rr < 16; ++rr) { const float e = __builtin_amdgcn_exp2f(S[kb][rr] - mx); S[kb][rr] = e; ls += e; }
    ls += __shfl_xor(ls, 32);
    f32x16 O[2];
    O[0] = (f32x16){0.f, 0.f, 0.f, 0.f, 0.f, 0.f, 0.f, 0.f, 0.f, 0.f, 0.f, 0.f, 0.f, 0.f, 0.f, 0.f}; O[1] = O[0];
    const unsigned vaddr = (unsigned)(size_t)(Vl) + (unsigned)(w * 4096 + hh * 512 + ((lane >> 2) & 3) * 64 + ((lane >> 4) & 1) * 32 + (lane & 3) * 8);
#pragma unroll
    for (int kb = 0; kb < 5; ++kb) {
        s16x4 v0[2][2], v1[2][2];
        TRREAD(v0[0][0], vaddr, (8 * kb + 0) * 512 + 0);   TRREAD(v1[0][0], vaddr, (8 * kb + 2) * 512 + 0);
        TRREAD(v0[0][1], vaddr, (8 * kb + 0) * 512 + 256); TRREAD(v1[0][1], vaddr, (8 * kb + 2) * 512 + 256);
        TRREAD(v0[1][0], vaddr, (8 * kb + 4) * 512 + 0);   TRREAD(v1[1][0], vaddr, (8 * kb + 6) * 512 + 0);
        TRREAD(v0[1][1], vaddr, (8 * kb + 4) * 512 + 256); TRREAD(v1[1][1], vaddr, (8 * kb + 6) * 512 + 256);
        asm volatile("s_waitcnt lgkmcnt(0)" ::: "memory"); __builtin_amdgcn_sched_barrier(0);
#pragma unroll
        for (int s2 = 0; s2 < 2; ++s2) {
            u32x4 pw; pw.x = cvt_pk_bf16(S[kb][8 * s2 + 0], S[kb][8 * s2 + 1]); pw.y = cvt_pk_bf16(S[kb][8 * s2 + 2], S[kb][8 * s2 + 3]);
            pw.z = cvt_pk_bf16(S[kb][8 * s2 + 4], S[kb][8 * s2 + 5]); pw.w = cvt_pk_bf16(S[kb][8 * s2 + 6], S[kb][8 * s2 + 7]);
            const bf16x8 pb = __builtin_bit_cast(bf16x8, pw);
#pragma unroll
            for (int db = 0; db < 2; ++db) { const bf16x8 va = (bf16x8){v0[s2][db][0], v0[s2][db][1], v0[s2][db][2], v0[s2][db][3], v1[s2][db][0], v1[s2][db][1], v1[s2][db][2], v1[s2][db][3]};
                O[db] = __builtin_amdgcn_mfma_f32_32x32x16_bf16(va, pb, O[db], 0, 0, 0); }
        }
    }
    const float inv = 1.0f / ls;
    bf16_t* ob = (bf16_t*)(ws_ + WS_OB) + ((size_t)br * M + qtok) * DA + h * HD;
#pragma unroll
    for (int db = 0; db < 2; ++db)
#pragma unroll
        for (int rg = 0; rg < 4; ++rg) { u32x2 o; o.x = cvt_pk_bf16(O[db][4 * rg] * inv, O[db][4 * rg + 1] * inv); o.y = cvt_pk_bf16(O[db][4 * rg + 2] * inv, O[db][4 * rg + 3] * inv);
            *(u32x2*)(ob + 32 * db + 8 * rg + 4 * hh) = o; }
    if (hh == 0) ((float*)(ws_ + WS_LSE))[((size_t)br * M + qtok) * NH + h] = mx + __builtin_amdgcn_logf(ls);
}

__device__ __forceinline__ float sigm(float x) { return __builtin_amdgcn_rcpf(1.0f + __builtin_amdgcn_exp2f(-x * LOG2E)); }
template <bool FINAL>
__device__ __forceinline__ void rnn_unit(const Params& p, LAS unsigned char* lds, int l, int unit) {
    unsigned char* const ws_ = opaque_ptr(p.ws);
    const int tid = opaque_tid(), lane = tid & 63, g = __builtin_amdgcn_readfirstlane(tid >> 6), hh = lane >> 5, ql = lane & 31;
    const int b = unit >> 7, chunk = unit & 127, t0 = chunk * 64;
    const bf16_t* ZB = (const bf16_t*)(ws_ + WS_ZB);
    LAS float* ut = (LAS float*)(lds + g * 17408); LAS float* at = ut + 32 * 68;
    LAS float* part = (LAS float*)(lds + 139264);
    float* AGG = (float*)(ws_ + WS_AGG);
    const int c = g * 64 + lane;
    const float* cw = p.in[6] + l * 4 * DR; const float w0 = cw[c], w1 = cw[DR + c], w2 = cw[2 * DR + c], w3 = cw[3 * DR + c], cbv = p.in[7][l * DR + c];
    float bav[2], bxv[2], splv[2];
#pragma unroll
    for (int nb = 0; nb < 2; ++nb) { const int cd = g * 64 + 32 * nb + ql; bav[nb] = p.in[9][l * DR + cd]; bxv[nb] = p.in[11][l * DR + cd]; splv[nb] = ((const float*)(ws_ + WS_SPL))[l * DR + cd]; }
    bf16x8 Wa[2][4], Wx[2][4];
    { const bf16_t* wat = (const bf16_t*)(ws_ + WS_WAT) + (size_t)((l * 2) * 8 + g) * 4096;
#pragma unroll
      for (int nb = 0; nb < 2; ++nb)
#pragma unroll
          for (int ks = 0; ks < 4; ++ks) { const int off = (32 * nb + ql) * 64 + 16 * ks + 8 * hh; Wa[nb][ks] = *(const bf16x8*)(wat + off); Wx[nb][ks] = *(const bf16x8*)(wat + 8 * 4096 + off); } }
    float hst = 0.f, Ap = 1.f;
    if (FINAL) {
        const float* ag = AGG + (size_t)(b * 128) * 1024 + c;
        int cc = 0;
        for (; cc + 8 <= chunk; cc += 8) { float A[8], H[8];
#pragma unroll
            for (int q = 0; q < 8; ++q) { A[q] = ag[(size_t)(cc + q) * 1024]; H[q] = ag[(size_t)(cc + q) * 1024 + 512]; }
#pragma unroll
            for (int q = 0; q < 8; ++q) hst = A[q] * hst + H[q]; }
        for (; cc < chunk; ++cc) { const float A = ag[(size_t)cc * 1024], H = ag[(size_t)cc * 1024 + 512]; hst = A * hst + H; }
    }
    const size_t tokb = (size_t)b * SEQ + t0;
    float xm3 = 0.f, xm2 = 0.f, xm1 = 0.f;
    if (t0 > 0) { xm3 = bf2f(ZB[(tokb - 3) * DIN + 1536 + c]); xm2 = bf2f(ZB[(tokb - 2) * DIN + 1536 + c]); xm1 = bf2f(ZB[(tokb - 1) * DIN + 1536 + c]); }
    __syncthreads();
#pragma unroll 1
    for (int hf = 0; hf < 2; ++hf) {
        const size_t tk0 = tokb + 32 * hf;
#pragma unroll 8
        for (int tt = 0; tt < 32; ++tt) { const float xv = bf2f(ZB[(tk0 + tt) * DIN + 1536 + c]); ut[tt * 68 + lane] = cbv + w0 * xm3 + w1 * xm2 + w2 * xm1 + w3 * xv; xm3 = xm2; xm2 = xm1; xm1 = xv; }
        asm volatile("s_waitcnt lgkmcnt(0)" ::: "memory");
        bf16x8 Af[4];
#pragma unroll
        for (int ks = 0; ks < 4; ++ks) { const LAS f32x4* s = (const LAS f32x4*)(ut + ql * 68 + 16 * ks + 8 * hh); const f32x4 x0 = s[0], x1 = s[1];
            u32x4 pw; pw.x = cvt_pk_bf16(x0[0], x0[1]); pw.y = cvt_pk_bf16(x0[2], x0[3]); pw.z = cvt_pk_bf16(x1[0], x1[1]); pw.w = cvt_pk_bf16(x1[2], x1[3]); Af[ks] = __builtin_bit_cast(bf16x8, pw); }
        f32x16 Dr[2], Dx[2];
#pragma unroll
        for (int nb = 0; nb < 2; ++nb) { Dr[nb] = (f32x16){0.f, 0.f, 0.f, 0.f, 0.f, 0.f, 0.f, 0.f, 0.f, 0.f, 0.f, 0.f, 0.f, 0.f, 0.f, 0.f}; Dx[nb] = Dr[nb];
#pragma unroll
            for (int ks = 0; ks < 4; ++ks) { Dr[nb] = __builtin_amdgcn_mfma_f32_32x32x16_bf16(Af[ks], Wa[nb][ks], Dr[nb], 0, 0, 0); Dx[nb] = __builtin_amdgcn_mfma_f32_32x32x16_bf16(Af[ks], Wx[nb][ks], Dx[nb], 0, 0, 0); } }
#pragma unroll
        for (int nb = 0; nb < 2; ++nb)
#pragma unroll
            for (int rr = 0; rr < 16; ++rr) { const int row = (rr & 3) + 8 * (rr >> 2) + 4 * hh; const int o = row * 68 + 32 * nb + ql;
                const float rs = sigm(Dr[nb][rr] + bav[nb]), is = sigm(Dx[nb][rr] + bxv[nb]);
                const float a = __builtin_amdgcn_exp2f(-splv[nb] * rs); const float uv = ut[o];
                at[o] = a; ut[o] = __builtin_amdgcn_sqrtf(fmaxf(1.0f - a * a, 0.f)) * (is * uv); }
        asm volatile("s_waitcnt lgkmcnt(0)" ::: "memory");
        if (!FINAL) {
#pragma unroll 8
            for (int tt = 0; tt < 32; ++tt) { const float a = at[tt * 68 + lane], d = ut[tt * 68 + lane]; hst = a * hst + d; Ap *= a; }
        } else {
#pragma unroll 8
            for (int tt = 0; tt < 32; ++tt) { const float a = at[tt * 68 + lane], d = ut[tt * 68 + lane]; hst = a * hst + d;
                const float gv = bf2f(ZB[(tk0 + tt) * DIN + 2048 + c]); const float y2 = 1.5957691216057308f * (gv + 0.044715f * gv * gv * gv);
                at[tt * 68 + lane] = hst * gv * sigm(y2); }
            asm volatile("s_waitcnt lgkmcnt(0)" ::: "memory");
            f32x4 ov[8]; float ss = 0.f;
#pragma unroll
            for (int q = 0; q < 8; ++q) { ov[q] = *(const LAS f32x4*)(at + ql * 68 + 32 * hh + 4 * q); ss += (ov[q][0] * ov[q][0] + ov[q][1] * ov[q][1]) + (ov[q][2] * ov[q][2] + ov[q][3] * ov[q][3]); }
            ss += __shfl_xor(ss, 32);
            if (hh == 0) part[(hf * 32 + ql) * 8 + g] = ss;
            __syncthreads();
            const LAS f32x4* pp = (const LAS f32x4*)(part + (hf * 32 + ql) * 8); const f32x4 p0 = pp[0], p1 = pp[1];
            const float rstd = rsqrtf(((p0[0] + p0[1]) + (p0[2] + p0[3]) + (p1[0] + p1[1]) + (p1[2] + p1[3])) * (1.0f / DR) + EPS);
            bf16_t* mo = (bf16_t*)(ws_ + WS_MIX) + (tk0 + ql) * D + DA + g * 64 + 32 * hh;
#pragma unroll
            for (int q = 0; q < 4; ++q) { u32x4 wv; wv.x = cvt_pk_bf16(ov[2 * q][0] * rstd, ov[2 * q][1] * rstd); wv.y = cvt_pk_bf16(ov[2 * q][2] * rstd, ov[2 * q][3] * rstd);
                wv.z = cvt_pk_bf16(ov[2 * q + 1][0] * rstd, ov[2 * q + 1][1] * rstd); wv.w = cvt_pk_bf16(ov[2 * q + 1][2] * rstd, ov[2 * q + 1][3] * rstd); *(u32x4*)(mo + 8 * q) = wv; }
        }
    }
    if (!FINAL) { float* ag = AGG + (size_t)(b * 128 + chunk) * 1024 + c; ag[0] = Ap; ag[512] = hst; }
}

__device__ __forceinline__ void attn_merge_unit(const Params& p, int unit) {
    unsigned char* const ws_ = opaque_ptr(p.ws);
    const int tid = opaque_tid(), lane = tid & 63, w = tid >> 6;
    const bf16_t* OB = (const bf16_t*)(ws_ + WS_OB); const float* LSE = (const float*)(ws_ + WS_LSE);
    for (int ti = 0; ti < 8; ++ti) {
        const size_t tok = (size_t)unit * 64 + w * 8 + ti;
        float ls[3]; u32x4 ov[3];
#pragma unroll
        for (int br = 0; br < 3; ++br) { ls[br] = LSE[((size_t)br * M + tok) * NH + (lane >> 3)]; ov[br] = *(const u32x4*)(OB + ((size_t)br * M + tok) * DA + 8 * lane); }
        const float mx = fmaxf(ls[0], fmaxf(ls[1], ls[2]));
        float wb[3];
#pragma unroll
        for (int br = 0; br < 3; ++br) wb[br] = __builtin_amdgcn_exp2f(ls[br] - mx);
        const float wi = 1.0f / (wb[0] + wb[1] + wb[2]);
        float o[8];
#pragma unroll
        for (int q = 0; q < 4; ++q) { float lo = 0.f, hi = 0.f;
#pragma unroll
            for (int br = 0; br < 3; ++br) { lo += wb[br] * bf_lo(ov[br][q]); hi += wb[br] * bf_hi(ov[br][q]); }
            o[2 * q] = lo * wi; o[2 * q + 1] = hi * wi; }
        float ss = 0.f;
#pragma unroll
        for (int q = 0; q < 8; ++q) ss += o[q] * o[q];
        ss = wave_sum(ss);
        const float rstd = rsqrtf(ss * (1.0f / DA) + EPS);
        u32x4 wv; wv.x = cvt_pk_bf16(o[0] * rstd, o[1] * rstd); wv.y = cvt_pk_bf16(o[2] * rstd, o[3] * rstd); wv.z = cvt_pk_bf16(o[4] * rstd, o[5] * rstd); wv.w = cvt_pk_bf16(o[6] * rstd, o[7] * rstd);
        *(u32x4*)((bf16_t*)(ws_ + WS_MIX) + tok * D + 8 * lane) = wv;
    }
}
__device__ __forceinline__ void ph_mix1(const Params& p, LAS unsigned char* lds, int l) {
    for (int it = blockIdx.x; it < 1536 + 256; it += gridDim.x) { if (it < 1536) attn_item(p, lds, it); else rnn_unit<false>(p, lds, l, it - 1536); }
}
__device__ __forceinline__ void ph_mix2(const Params& p, LAS unsigned char* lds, int l) {
    for (int u = blockIdx.x; u < 256; u += gridDim.x) { rnn_unit<true>(p, lds, l, u); attn_merge_unit(p, u); }
}
#define DYN_LDS extern __shared__ __attribute__((aligned(16))) unsigned char smem_[]; LAS unsigned char* lds = (LAS unsigned char*)smem_

#define XB_TMO      128
#define XB_XCNT(j)  (256  + 64 * (j))
#define XB_XSUB(j)  (1280 + 64 * (j))
#define XB_XGEN(j)  (2304 + 64 * (j))
#define XB_TOP      3328
#define XB_TOPGEN   3392
#define XCD_BAR_WORDS 3456
#define XB_SPIN_CAP (1u << 18)
__device__ __forceinline__ unsigned xb_ld(unsigned* p)              { return __hip_atomic_load(p, __ATOMIC_RELAXED, __HIP_MEMORY_SCOPE_AGENT); }
__device__ __forceinline__ unsigned xb_add(unsigned* p, unsigned v) { return __hip_atomic_fetch_add(p, v, __ATOMIC_RELAXED, __HIP_MEMORY_SCOPE_AGENT); }
__device__ __forceinline__ unsigned xb_xcc_id() { return (unsigned)__builtin_amdgcn_s_getreg((3 << 11) | 20) & 0xFu; }
#define XB_SPIN(cond, bar) do { unsigned _sp = 0; while (cond) { __builtin_amdgcn_s_sleep(1); \
    if ((++_sp & 255u) == 0u) { if (xb_ld(&(bar)[XB_TMO])) break; if (_sp > XB_SPIN_CAP) { atomicAdd(&(bar)[XB_TMO], 1u); break; } } } } while (0)
struct XcdBarrier { unsigned* bar; unsigned x; volatile LAS unsigned* st; };
__device__ __forceinline__ XcdBarrier xcd_barrier_post(unsigned* bar, volatile LAS unsigned* st) {
    XcdBarrier b; b.bar = bar; b.x = xb_xcc_id(); b.st = st;
    if (threadIdx.x == 0) (void)xb_add(&bar[XB_XCNT(b.x)], 1u);
    return b;
}
__device__ __forceinline__ void xcd_barrier_complete(unsigned* bar, unsigned x, unsigned& nloc, unsigned& nx) {
    const unsigned G = gridDim.x * gridDim.y * gridDim.z;
    unsigned sum, cnt, mine, sp = 0u;
    for (;;) {
        sum = 0u; cnt = 0u; mine = 0u;
#pragma unroll
        for (unsigned j = 0; j < 16; ++j) { const unsigned c = xb_ld(&bar[XB_XCNT(j)]); sum += c; cnt += (c > 0u) ? 1u : 0u; mine = (j == x) ? c : mine; }
        if (sum == G) break;
        __builtin_amdgcn_s_sleep(1);
        if ((++sp & 255u) == 0u) { if (xb_ld(&bar[XB_TMO])) break; if (sp > XB_SPIN_CAP) { atomicAdd(&bar[XB_TMO], 1u); break; } }
    }
    nloc = mine > 0u ? mine : 1u; nx = cnt > 0u ? cnt : 1u;
}
__device__ __forceinline__ void xcd_barrier(const XcdBarrier& b) {
    asm volatile("s_waitcnt vmcnt(0)" ::: "memory");
    __syncthreads();
    if (opaque_tid() == 0) {
        unsigned* bar = b.bar; asm volatile("" : "+s"(bar));
        const unsigned bx = xb_xcc_id();
        __builtin_amdgcn_s_waitcnt(0);
        unsigned nloc = b.st[0], nx = b.st[1];
        if (nloc == 0u) { xcd_barrier_complete(bar, bx, nloc, nx); b.st[0] = nloc; b.st[1] = nx; }
        const unsigned old = xb_add(&bar[XB_XSUB(bx)], 1u);
        const unsigned gen = old / nloc;
        if (old + 1u == (gen + 1u) * nloc) {
            __builtin_amdgcn_fence(__ATOMIC_RELEASE, "agent");
            asm volatile("s_waitcnt vmcnt(0)" ::: "memory");
            const unsigned og = xb_add(&bar[XB_TOP], 1u);
            const unsigned tg = og / nx;
            if (og + 1u == (tg + 1u) * nx) xb_add(&bar[XB_TOPGEN], 1u);
            else XB_SPIN(xb_ld(&bar[XB_TOPGEN]) == tg, bar);
            __builtin_amdgcn_fence(__ATOMIC_ACQUIRE, "agent");
            xb_add(&bar[XB_XGEN(bx)], 1u);
            asm volatile("s_waitcnt vmcnt(0)" ::: "memory");
        } else {
            XB_SPIN(xb_ld(&bar[XB_XGEN(bx)]) == gen, bar);
            __builtin_amdgcn_fence(__ATOMIC_ACQUIRE, "agent");
            asm volatile("s_waitcnt vmcnt(0)" ::: "memory");
        }
    }
    __syncthreads();
}

__global__ void __launch_bounds__(512, 2) k_fused(Params p) {
    DYN_LDS;
    if (threadIdx.x < 64) ((LAS unsigned*)(lds + LDS_MISC))[threadIdx.x] = 0u;
    __syncthreads();
    XcdBarrier bar = xcd_barrier_post((unsigned*)(p.ws + WS_CTL), (volatile LAS unsigned*)(lds + LDS_MISC));
    const float* x_in = p.in[0]; float* X = p.out;
    const int* counts = (const int*)(p.ws + WS_CNT);
    ph_prologue(p, lds, 3);
    ph_norm(p, lds, x_in, X, 0, nullptr, true);
    xcd_barrier(bar);
    for (int l = 0; l < DEPTH; ++l) {
        ph_win(p, lds, l);                               xcd_barrier(bar);
        ph_mix1(p, lds, l);                              xcd_barrier(bar);
        ph_mix2(p, lds, l);                              xcd_barrier(bar);
        ph_wout(p, lds, l, l == 0 ? x_in : X, X);        xcd_barrier(bar);
        ph_router(p, lds, l, X);                         xcd_barrier(bar);
        ph_gateup(p, lds, l);                            xcd_barrier(bar);
        ph_down(p, lds, l);                              xcd_barrier(bar);
        ph_norm(p, lds, X, X, 1, counts + l * NE, l < DEPTH - 1);
        if (l < DEPTH - 1) xcd_barrier(bar);
    }
}
}

extern "C" void kernel_launch(void* const* d_in, const int* in_sizes, int n_in, void* d_out, int out_size, void* d_ws, size_t ws_size, hipStream_t stream) {
    static int grid = 0;
    if (!grid) {
        (void)hipFuncSetAttribute((const void*)k_fused, hipFuncAttributeMaxDynamicSharedMemorySize, LDS_BYTES);
        int dev = 0, cus = 0, per_cu = 0;
        (void)hipGetDevice(&dev); (void)hipDeviceGetAttribute(&cus, hipDeviceAttributeMultiprocessorCount, dev);
        (void)hipOccupancyMaxActiveBlocksPerMultiprocessor(&per_cu, (const void*)k_fused, 512, LDS_BYTES);
        if (per_cu < 1) fprintf(stderr, "kernel_launch: occupancy query reports %d blocks per CU\n", per_cu);
        (void)hipGetLastError();
        grid = cus > 0 ? cus : 256;
        if (ws_size < WS_END) fprintf(stderr, "kernel_launch: ws_size %zu smaller than expected\n", ws_size);
    }
    Params p{}; for (int i = 0; i < 24; ++i) p.in[i] = (const float*)d_in[i]; p.out = (float*)d_out; p.ws = (unsigned char*)d_ws;
    (void)hipMemsetAsync((unsigned char*)d_ws + WS_CTL, 0, CTL_ZERO, stream);
    k_fused<<<grid, 512, LDS_BYTES, stream>>>(p);
}
```

```cpp
#include <hip/hip_runtime.h>
#include <cstdio>
#include <cstdint>
#include <cmath>

namespace {
constexpr int BATCH = 2, SEQ = 8192, M = BATCH * SEQ, D = 1024, DEPTH = 4;
constexpr int NH = 8, HD = 64, DA = 512, DR = 512, DIN = 2560;
constexpr int NE = 32, EPG = 8, NG = 4, DE = 512;
constexpr float EPS = 1e-6f;

__device__ __forceinline__ float wave_sum(float v) {
#pragma unroll
    for (int o = 1; o < 64; o <<= 1) v += __shfl_xor(v, o);
    return v;
}

#define LAS __attribute__((address_space(3)))
typedef unsigned short bf16_t;
typedef short bf16x8 __attribute__((ext_vector_type(8)));
typedef short s16x4 __attribute__((ext_vector_type(4)));
typedef float f32x4 __attribute__((ext_vector_type(4)));
typedef float f32x16 __attribute__((ext_vector_type(16)));
typedef unsigned u32x4 __attribute__((ext_vector_type(4)));
typedef unsigned u32x2 __attribute__((ext_vector_type(2)));
__device__ __forceinline__ unsigned cvt_pk_bf16(float lo, float hi) { unsigned r; asm volatile("v_cvt_pk_bf16_f32 %0, %1, %2" : "=v"(r) : "v"(lo), "v"(hi)); return r; }
__device__ __forceinline__ float bf_lo(unsigned w) { return __uint_as_float(w << 16); }
__device__ __forceinline__ float bf_hi(unsigned w) { return __uint_as_float(w & 0xffff0000u); }
__device__ __forceinline__ float bf2f(bf16_t v) { return __uint_as_float(((unsigned)v) << 16); }

__device__ __forceinline__ int opaque_tid() { int t = threadIdx.x; asm volatile("" : "+v"(t)); return t; }
__device__ __forceinline__ unsigned char* opaque_ptr(unsigned char* w) { size_t z = 0; asm volatile("" : "+s"(z)); return w + z; }
__device__ __forceinline__ int opaque_bid() { int b = blockIdx.x; asm volatile("" : "+s"(b)); return b; }
__device__ __forceinline__ int xcd_unit(int c) { return gridDim.x == 256 ? 32 * (c & 7) + (c >> 3) : c; }
constexpr float LOG2E = 1.4426950408889634f;
constexpr size_t MiB = 1ull << 20;
constexpr size_t WS_CTL = 0, CTL_ZERO = 128 * 1024;
constexpr size_t WS_TCNT = 16 * 1024;
constexpr size_t WS_CONV = 60 * 1024;
constexpr size_t WS_CNT = 64 * 1024;
constexpr int CNT_STRIDE = 64;
constexpr size_t WS_BT = 1 * MiB;
constexpr size_t WS_BND = 1 * MiB + 32 * 1024;
constexpr size_t WS_GQK = 1 * MiB + 64 * 1024;
constexpr size_t WS_SPL = 1 * MiB + 128 * 1024;
constexpr size_t WS_RTT = 2 * MiB;
constexpr size_t WS_WAT = 3 * MiB;
constexpr size_t WS_WIN = 4 * MiB;
constexpr size_t WS_WOUT = 24 * MiB;
constexpr size_t WS_WGU = 32 * MiB;
constexpr size_t WS_WD = 288 * MiB;
constexpr size_t WS_HN = 416 * MiB;
constexpr size_t WS_ZB = 448 * MiB;
constexpr size_t WS_OB = 528 * MiB;
constexpr size_t WS_LSE = 576 * MiB;
constexpr size_t WS_AGG = 578 * MiB;
constexpr size_t WS_MIX = 580 * MiB;
constexpr size_t WS_TOK = 612 * MiB;
constexpr size_t WS_LIST = 613 * MiB;
constexpr size_t WS_ACT = 616 * MiB;
constexpr size_t WS_Y = 656 * MiB;
constexpr size_t WS_AD = 736 * MiB;
constexpr size_t WS_END = 768 * MiB;
constexpr int MAXTILES = 160;
constexpr int LDS_BYTES = 160 * 1024;
constexpr int LDS_STAGE = 0;
constexpr int LDS_TAB = 131072;
constexpr int LDS_MISC = LDS_BYTES - 256;

#ifndef SUBPROBE
#define SUBPROBE 0
#endif
#if SUBPROBE
#define SP_DECL unsigned long long sp_t0_ = 0
#define SP_BEGIN() sp_t0_ = __builtin_amdgcn_s_memrealtime()
#define SP_SYNC() __syncthreads()
#define SP_END(id) do { if (SUBPROBE == (id) && threadIdx.x == 0) { volatile LAS unsigned* w_ = (volatile LAS unsigned*)(lds + LDS_MISC + 64); *w_ = *w_ + (unsigned)(__builtin_amdgcn_s_memrealtime() - sp_t0_); } } while (0)
#else
#define SP_DECL do {} while (0)
#define SP_SYNC() do {} while (0)
#define SP_BEGIN() do {} while (0)
#define SP_END(id) do {} while (0)
#endif
namespace pg8 {
constexpr int BM = 256, BK = 64, HALF = 128, HTB = HALF * BK * 2, STAGE_BYTES = 8 * HTB, NXCD = 8, WGM = 8;
__host__ __device__ __forceinline__ int lds_byte(int r, int c) { const int st = (r >> 4) * 2 + (c >> 5), rr = r & 15, cc = c & 31, ob = rr * 64 + cc * 2; return st * 1024 + (ob ^ (((ob >> 9) & 1) << 5)); }
__host__ __device__ __forceinline__ void stage_rc(int b, int& R, int& C) { const int st = b / 1024, sb = b % 1024, swz = sb ^ (((sb >> 9) & 1) << 5); R = (st >> 1) * 16 + swz / 64; C = (st & 1) * 32 + (swz % 64) / 2; }
__host__ __device__ __forceinline__ int perm32(int rho) { const int n = rho >> 4, i = rho & 15; return 8 * (i >> 2) + 4 * n + (i & 3); }

struct Unit { int pm, pn; const char* a; const char* b; const int* glist; int gcount; };

struct StaticOrder {
    int nM, nN, nwg, G, c; const char* A; const char* Bt; size_t tA, tB;
    __device__ void init(const bf16_t* A_, const bf16_t* Bt_, int M_, int N_, int K_, int G_, int c_) { nM = M_ / BM; nN = N_ / BM; nwg = nM * nN; G = G_; c = c_; A = (const char*)A_; Bt = (const char*)Bt_; tA = (size_t)BM * K_ * 2; tB = tA; }
    __device__ bool next(int i, Unit& u) const {
        const long L = (long)i * G + c; if (L >= nwg) return false;
        int wgid = (int)L; { const int q = nwg / NXCD, r = nwg % NXCD, xcd = wgid % NXCD, off = wgid / NXCD; wgid = (xcd < r ? xcd * (q + 1) : r * (q + 1) + (xcd - r) * q) + off; }
        const int nig = WGM * nN, gid = wgid / nig, fm = gid * WGM, gsz = (nM - fm) < WGM ? (nM - fm) : WGM;
        u.pm = fm + ((wgid % nig) % gsz); u.pn = (wgid % nig) / gsz; u.a = A + (size_t)u.pm * tA; u.b = Bt + (size_t)u.pn * tB; u.glist = nullptr; u.gcount = 0; return true;
    }    __device__ __forceinline__ void a_ready(const Unit&, int) const {}
    __device__ __forceinline__ void done(const Unit&, int) const {}
};
struct MoeOrder {
    int G, c, ntiles; const LAS int* tile_e; const LAS int* tile_r0; const LAS int* cnt;
    const char* A; size_t tA; const char* W; size_t estride, tB; const int* list; int Mrows;
    __device__ bool next(int i, Unit& u) const {
        const int L = i * G + c; if (L >= ntiles * 4) return false;
        const int gt = L >> 2, e = __builtin_amdgcn_readfirstlane(tile_e[gt]), r0 = __builtin_amdgcn_readfirstlane(tile_r0[gt]);
        u.pm = gt; u.pn = L & 3; u.a = A + (size_t)gt * tA; u.b = W + (size_t)e * estride + (size_t)u.pn * tB;
        u.glist = list + (size_t)e * Mrows + r0; u.gcount = __builtin_amdgcn_readfirstlane(cnt[e]) - r0; return true;
    }
    unsigned* pub; unsigned* wait; unsigned need; unsigned* tmo;
    __device__ __forceinline__ void done(const Unit& u, int lane) const {
        if (pub) { asm volatile("s_waitcnt vmcnt(0)" ::: "memory");
            if (lane == 0) __hip_atomic_fetch_add(pub + 16 * u.pm, 1u, __ATOMIC_RELAXED, __HIP_MEMORY_SCOPE_AGENT); }
    }
    __device__ __forceinline__ void a_ready(const Unit& u, int tid) const {
        if (!wait) return;
        if (tid < 64) {
            const unsigned long long t0 = __builtin_amdgcn_s_memrealtime(); unsigned polls = 0;
            while ((unsigned)__builtin_amdgcn_readfirstlane(__hip_atomic_load(wait + 16 * u.pm, __ATOMIC_RELAXED, __HIP_MEMORY_SCOPE_AGENT)) < need) {
                if ((++polls & 255u) == 0u && __builtin_amdgcn_readfirstlane(__hip_atomic_load(tmo, __ATOMIC_RELAXED, __HIP_MEMORY_SCOPE_AGENT)) != 0u) break;
                if (__builtin_amdgcn_s_memrealtime() - t0 > 2000000ull) { if (tid == 0) __hip_atomic_store(tmo, 1u, __ATOMIC_RELAXED, __HIP_MEMORY_SCOPE_AGENT); break; }
                __builtin_amdgcn_s_sleep(2); }
            __builtin_amdgcn_fence(__ATOMIC_ACQUIRE, "agent");
            asm volatile("s_waitcnt vmcnt(0)" ::: "memory");
        }
        asm volatile("" ::: "memory"); __builtin_amdgcn_s_barrier(); asm volatile("" ::: "memory");
    }
};

typedef int i32x8 __attribute__((ext_vector_type(8)));
typedef int i32x4 __attribute__((ext_vector_type(4)));
template <class Epi, class Sched, bool GATHER, bool FP8 = false, int SCW = 0x7f7f7f7f, int SCX = 0x7f7f7f7f, bool IDENT = false, int KSH = 0  >
__device__ __forceinline__ void gemm_phase(LAS unsigned char* lds, const void* Abase, int KB, const Sched& S, const Epi& E) {
    const int tid = opaque_tid(), wid = __builtin_amdgcn_readfirstlane(tid >> 6), lane = tid & 63, wr = wid >> 2, wc = wid & 3, fr = lane & 15, fq = lane >> 4;
    asm volatile("" : "+s"(KB));
    const int nt = KB / 128;
    const size_t kstep = (size_t)(BK * 2);
    const unsigned hstep = (unsigned)HALF * KB;
    unsigned voffB[2]; int RA[2], CA[2];
#pragma unroll
    for (int i = 0; i < 2; ++i) { int R, C; stage_rc(tid * 16 + i * 8192, R, C); const int Rb = Epi::PERM ? ((R & ~31) + perm32(R & 31)) : R;
        RA[i] = R; CA[i] = C; voffB[i] = (unsigned)(Rb * KB + C * 2); }
    const unsigned ldsw = (unsigned)wid * 1024u;
    const int aoff = lds_byte(wr * 64 + fr, fq * 8), boff = lds_byte(wc * 32 + fr, fq * 8);
#define PG8_SA(b, h) (((b) * 2 + (h)) * HTB)
#define PG8_SB(b, h) ((4 + (b) * 2 + (h)) * HTB)
#define PG8_GLDS(src, dstoff) __builtin_amdgcn_global_load_lds((const unsigned*)(src), (LAS unsigned*)(lds + (dstoff)), 16, 0, 0)
#define PG8_STAGE_B(bufoff, gbase, h) do { _Pragma("unroll") for (int _i = 0; _i < 2; ++_i) PG8_GLDS((const char*)(gbase) + (size_t)((h) * hstep) + voffB[_i], (bufoff) + ldsw + _i * 8192); } while (0)
#define PG8_STAGE_A(bufoff, gbase, h) do { _Pragma("unroll") for (int _i = 0; _i < 2; ++_i) { \
        if constexpr (GATHER) PG8_GLDS((const char*)(gbase) + oc[h][_i], (bufoff) + ldsw + _i * 8192); \
        else PG8_GLDS((const char*)(gbase) + (size_t)((h) * hstep) + oc[0][_i], (bufoff) + ldsw + _i * 8192); } } while (0)
#define PG8_LDA(dst, b, h) do { _Pragma("unroll") for (int m = 0; m < 4; ++m) _Pragma("unroll") for (int k = 0; k < 2; ++k) dst[m][k] = *(const LAS bf16x8*)(lds + PG8_SA(b, h) + aoff + m * 2048 + k * 1024); } while (0)
#define PG8_LDB(dst, b, h) do { _Pragma("unroll") for (int n = 0; n < 2; ++n) _Pragma("unroll") for (int k = 0; k < 2; ++k) dst[n][k] = *(const LAS bf16x8*)(lds + PG8_SB(b, h) + boff + n * 2048 + k * 1024); } while (0)
#define PG8_CAT(x) __builtin_shufflevector(__builtin_bit_cast(i32x4, (x)[0]), __builtin_bit_cast(i32x4, (x)[1]), 0, 1, 2, 3, 4, 5, 6, 7)
#define PG8_MMA(ai, bj, At, Bt) do { if ((ai) == 1 ? skipB : skipA) break; __builtin_amdgcn_s_setprio(1); \
        if constexpr (FP8) { _Pragma("unroll") for (int m = 0; m < 4; ++m) _Pragma("unroll") for (int n = 0; n < 2; ++n) \
            acc[ai][bj][m][n] = __builtin_amdgcn_mfma_scale_f32_16x16x128_f8f6f4(PG8_CAT(Bt[n]), PG8_CAT(At[m]), acc[ai][bj][m][n], 0, 0, 0, SCW, 0, SCX); } \
        else { _Pragma("unroll") for (int m = 0; m < 4; ++m) _Pragma("unroll") for (int n = 0; n < 2; ++n) _Pragma("unroll") for (int k = 0; k < 2; ++k) \
            acc[ai][bj][m][n] = __builtin_amdgcn_mfma_f32_16x16x32_bf16(Bt[n][k], At[m][k], acc[ai][bj][m][n], 0, 0, 0); } \
        __builtin_amdgcn_s_setprio(0); } while (0)
#define PG8_WAIT_V(n) asm volatile("s_waitcnt vmcnt(" #n ")" ::: "memory")
#define PG8_WAIT_L(n) asm volatile("s_waitcnt lgkmcnt(" #n ")" ::: "memory")
#define PG8_BAR __builtin_amdgcn_s_barrier()
#define PG8_SCHED __builtin_amdgcn_sched_barrier(0)
#define PG8_AOFF(dst, u) do { if constexpr (GATHER) { _Pragma("unroll") for (int _h = 0; _h < 2; ++_h) _Pragma("unroll") for (int _i = 0; _i < 2; ++_i) { \
            const int _r = _h * HALF + RA[_i]; const int _t = IDENT ? ((u).pm * BM + _r) : ((_r < (u).gcount) ? (u).glist[_r] : 0); dst[_h][_i] = ((unsigned)_t << KSH) + (unsigned)(CA[_i] * 2); } \
            asm volatile("" : "+v"(dst[0][0]), "+v"(dst[0][1]), "+v"(dst[1][0]), "+v"(dst[1][1])); } \
        else { _Pragma("unroll") for (int _h = 0; _h < 2; ++_h) _Pragma("unroll") for (int _i = 0; _i < 2; ++_i) dst[_h][_i] = (unsigned)(RA[_i] * KB + CA[_i] * 2); } } while (0)
    Unit cur, nxt; int ui = 0;
    if (!S.next(0, cur)) return;
    f32x4 acc[2][2][4][2];
#pragma unroll
    for (int a = 0; a < 2; ++a)
#pragma unroll
        for (int b = 0; b < 2; ++b)
#pragma unroll
            for (int m = 0; m < 4; ++m)
#pragma unroll
                for (int n = 0; n < 2; ++n) acc[a][b][m][n] = (f32x4){0.f, 0.f, 0.f, 0.f};
    bf16x8 At[4][2], B0[2][2], B1[2][2];
    unsigned oc[2][2], on[2][2];
    bool skipB = GATHER && cur.gcount <= 128, skipA = GATHER && cur.gcount <= 64 && wr == 1;
    S.a_ready(cur, tid);
    PG8_AOFF(oc, cur);
    const char* cA = GATHER ? (const char*)Abase : cur.a; const char* cB = cur.b;
    PG8_STAGE_B(PG8_SB(0, 0), cB, 0); PG8_STAGE_B(PG8_SB(0, 1), cB, 1); PG8_STAGE_A(PG8_SA(0, 0), cA, 0); PG8_STAGE_A(PG8_SA(0, 1), cA, 1);
    if (wr == 1) PG8_BAR;
    PG8_WAIT_V(2); PG8_BAR;
    PG8_STAGE_B(PG8_SB(1, 0), cB + kstep, 0); PG8_STAGE_A(PG8_SA(1, 0), cA + kstep, 0); PG8_STAGE_B(PG8_SB(1, 1), cB + kstep, 1);
    PG8_WAIT_V(6); PG8_BAR;
    for (;;) {
        const bool has_next = S.next(ui + 1, nxt);
        const char* nA; const char* nB;
        if (has_next) { nA = GATHER ? (const char*)Abase : nxt.a; nB = nxt.b; if constexpr (GATHER) PG8_AOFF(on, nxt); }
        else { nA = cA; nB = cB;
            if constexpr (GATHER) {
#pragma unroll
                for (int h = 0; h < 2; ++h)
#pragma unroll
                    for (int i = 0; i < 2; ++i) on[h][i] = oc[h][i]; } }
#pragma unroll 1
        for (int t = 0; t < nt; t += 2) {
            const bool last = (t == nt - 2);
            if (last && has_next) S.a_ready(nxt, tid);
            const char* a1 = cA + (size_t)(t + 1) * kstep;
            const char* a2 = last ? nA : cA + (size_t)(t + 2) * kstep; const char* b2 = last ? nB : cB + (size_t)(t + 2) * kstep;
            const char* a3 = a2 + kstep; const char* b3 = b2 + kstep;
            PG8_LDB(B0, 0, 0); PG8_LDB(B1, 0, 1); PG8_SCHED; PG8_LDA(At, 0, 0); PG8_STAGE_A(PG8_SA(1, 1), a1, 1);
            if constexpr (GATHER) { if (last) {
#pragma unroll
                for (int h = 0; h < 2; ++h)
#pragma unroll
                    for (int i = 0; i < 2; ++i) oc[h][i] = on[h][i]; } }
            PG8_WAIT_V(8); PG8_WAIT_L(0); PG8_BAR; PG8_MMA(0, 0, At, B0); PG8_MMA(0, 1, At, B1); PG8_BAR; PG8_SCHED;
            PG8_LDA(At, 0, 1); PG8_STAGE_B(PG8_SB(0, 0), b2, 0); PG8_STAGE_B(PG8_SB(0, 1), b2, 1); PG8_STAGE_A(PG8_SA(0, 0), a2, 0);
            PG8_WAIT_V(8); PG8_WAIT_L(0); PG8_BAR; PG8_MMA(1, 0, At, B0); PG8_MMA(1, 1, At, B1); PG8_BAR; PG8_SCHED;
            PG8_LDB(B0, 1, 0); PG8_LDB(B1, 1, 1); PG8_SCHED; PG8_LDA(At, 1, 0); PG8_STAGE_A(PG8_SA(0, 1), a2, 1);
            PG8_WAIT_V(8); PG8_WAIT_L(0); PG8_BAR; PG8_MMA(0, 0, At, B0); PG8_MMA(0, 1, At, B1); PG8_BAR; PG8_SCHED;
            PG8_LDA(At, 1, 1); PG8_STAGE_B(PG8_SB(1, 0), b3, 0); PG8_STAGE_B(PG8_SB(1, 1), b3, 1); PG8_STAGE_A(PG8_SA(1, 0), a3, 0);
            PG8_WAIT_V(8); PG8_WAIT_L(0); PG8_BAR; PG8_MMA(1, 0, At, B0); PG8_MMA(1, 1, At, B1); PG8_BAR; PG8_SCHED;
        }
        if (wr == 0) PG8_BAR;
        E(acc, cur, wr, wc, fr, fq); S.done(cur, lane);
        if (!has_next) break;
#pragma unroll
        for (int a = 0; a < 2; ++a)
#pragma unroll
            for (int b = 0; b < 2; ++b)
#pragma unroll
                for (int m = 0; m < 4; ++m)
#pragma unroll
                    for (int n = 0; n < 2; ++n) acc[a][b][m][n] = (f32x4){0.f, 0.f, 0.f, 0.f};
        cur = nxt; cA = nA; cB = nB; ++ui;
        skipB = GATHER && cur.gcount <= 128; skipA = GATHER && cur.gcount <= 64 && wr == 1;
        if (wr == 1) PG8_BAR;
    }
    PG8_WAIT_V(0);
    PG8_BAR;
#undef PG8_SA
#undef PG8_SB
#undef PG8_STAGE_A
#undef PG8_STAGE_B
#undef PG8_GLDS
#undef PG8_LDA
#undef PG8_LDB
#undef PG8_MMA
#undef PG8_CAT
#undef PG8_WAIT_V
#undef PG8_WAIT_L
#undef PG8_BAR
#undef PG8_SCHED
#undef PG8_AOFF
}


struct EpiQKV {
    static constexpr bool PERM = true;
    bf16_t* ZB; const LAS float* gqk;
    __device__ __forceinline__ void operator()(const f32x4 (&acc)[2][2][4][2], const Unit& u, int wr, int wc, int fr, int fq) const {
        const int type = u.pn >> 1;
        f32x4 g[2][2];
        if (type == 0) {
#pragma unroll
            for (int bj = 0; bj < 2; ++bj)
#pragma unroll
                for (int n = 0; n < 2; ++n) g[bj][n] = *(const LAS f32x4*)(gqk + 32 * bj + 8 * fq + 4 * n);
        }
#pragma unroll
        for (int ai = 0; ai < 2; ++ai)
#pragma unroll
            for (int m = 0; m < 4; ++m) {
                const int row = u.pm * BM + ai * HALF + wr * 64 + m * 16 + fr;
                f32x4 v[2][2];
#pragma unroll
                for (int bj = 0; bj < 2; ++bj)
#pragma unroll
                    for (int n = 0; n < 2; ++n) v[bj][n] = acc[ai][bj][m][n];
                if (type < 2) {
                    float ss = 0.f;
#pragma unroll
                    for (int bj = 0; bj < 2; ++bj)
#pragma unroll
                        for (int n = 0; n < 2; ++n) ss += (v[bj][n][0] * v[bj][n][0] + v[bj][n][1] * v[bj][n][1]) + (v[bj][n][2] * v[bj][n][2] + v[bj][n][3] * v[bj][n][3]);
                    ss += __shfl_xor(ss, 16); ss += __shfl_xor(ss, 32);
                    const float rstd = rsqrtf(ss * (1.0f / 64.0f) + 1e-6f);
#pragma unroll
                    for (int bj = 0; bj < 2; ++bj)
#pragma unroll
                        for (int n = 0; n < 2; ++n) { v[bj][n] = v[bj][n] * rstd; if (type == 0) v[bj][n] = v[bj][n] * g[bj][n]; }
                }
                bf16_t* rowp = ZB + (size_t)row * 2560 + u.pn * BM + wc * 64 + 8 * fq;
#pragma unroll
                for (int bj = 0; bj < 2; ++bj) { u32x4 w; w.x = cvt_pk_bf16(v[bj][0][0], v[bj][0][1]); w.y = cvt_pk_bf16(v[bj][0][2], v[bj][0][3]); w.z = cvt_pk_bf16(v[bj][1][0], v[bj][1][1]); w.w = cvt_pk_bf16(v[bj][1][2], v[bj][1][3]);
                    *(u32x4*)(rowp + 32 * bj) = w; }
            }
    }
};
struct EpiRes {
    static constexpr bool PERM = false;
    const float* base; float* out; int ldc;
    __device__ __forceinline__ void operator()(const f32x4 (&acc)[2][2][4][2], const Unit& u, int wr, int wc, int fr, int fq) const {
        const int row0 = u.pm * BM + wr * 64 + fr, col0 = u.pn * BM + wc * 32 + 4 * fq;
#pragma unroll
        for (int ai = 0; ai < 2; ++ai)
#pragma unroll
            for (int m = 0; m < 4; ++m) { const size_t off = (size_t)(row0 + ai * HALF + m * 16) * ldc + col0;
#pragma unroll
                for (int bj = 0; bj < 2; ++bj)
#pragma unroll
                    for (int n = 0; n < 2; ++n) { const f32x4 bs = *(const f32x4*)(base + off + bj * HALF + n * 16); *(f32x4*)(out + off + bj * HALF + n * 16) = bs + acc[ai][bj][m][n]; }
                asm volatile("" ::: "memory"); }
    }
};
struct EpiSwiGLU {
    static constexpr bool PERM = true;
    bf16_t* ACT;
    __device__ __forceinline__ void operator()(const f32x4 (&acc)[2][2][4][2], const Unit& u, int wr, int wc, int fr, int fq) const {
#pragma unroll
        for (int ai = 0; ai < 2; ++ai)
#pragma unroll
            for (int m = 0; m < 4; ++m) {
                const int row = u.pm * BM + ai * HALF + wr * 64 + m * 16 + fr;
                float o[8];
#pragma unroll
                for (int n = 0; n < 2; ++n)
#pragma unroll
                    for (int j = 0; j < 4; ++j) { const float gv = acc[ai][0][m][n][j], uv = acc[ai][1][m][n][j];
                        o[n * 4 + j] = gv * __builtin_amdgcn_rcpf(1.0f + __builtin_amdgcn_exp2f(-gv * LOG2E)) * uv; }
                u32x4 w; w.x = cvt_pk_bf16(o[0], o[1]); w.y = cvt_pk_bf16(o[2], o[3]); w.z = cvt_pk_bf16(o[4], o[5]); w.w = cvt_pk_bf16(o[6], o[7]);
                *(u32x4*)(ACT + (size_t)row * 512 + u.pn * 128 + wc * 32 + 8 * fq) = w;
            }
    }
};
struct EpiSwiGLU8 {
    static constexpr bool PERM = true;
    unsigned char* ACT;
    __device__ __forceinline__ void operator()(const f32x4 (&acc)[2][2][4][2], const Unit& u, int wr, int wc, int fr, int fq) const {
#pragma unroll
        for (int ai = 0; ai < 2; ++ai)
#pragma unroll
            for (int m = 0; m < 4; ++m) {
                const int row = u.pm * BM + ai * HALF + wr * 64 + m * 16 + fr;
                float o[8];
#pragma unroll
                for (int n = 0; n < 2; ++n)
#pragma unroll
                    for (int j = 0; j < 4; ++j) { const float gv = acc[ai][0][m][n][j], uv = acc[ai][1][m][n][j];
                        o[n * 4 + j] = __builtin_amdgcn_fmed3f(8.0f * gv * __builtin_amdgcn_rcpf(1.0f + __builtin_amdgcn_exp2f(-gv * LOG2E)) * uv, -448.0f, 448.0f); }
                int w0 = 0, w1 = 0;
                w0 = __builtin_amdgcn_cvt_pk_fp8_f32(o[0], o[1], w0, false); w0 = __builtin_amdgcn_cvt_pk_fp8_f32(o[2], o[3], w0, true);
                w1 = __builtin_amdgcn_cvt_pk_fp8_f32(o[4], o[5], w1, false); w1 = __builtin_amdgcn_cvt_pk_fp8_f32(o[6], o[7], w1, true);
                *(u32x2*)(ACT + (size_t)row * 512 + u.pn * 128 + wc * 32 + 8 * fq) = (u32x2){(unsigned)w0, (unsigned)w1};
            }
    }
};
struct EpiBf16 {
    static constexpr bool PERM = true;
    bf16_t* O; int ldc;
    __device__ __forceinline__ void operator()(const f32x4 (&acc)[2][2][4][2], const Unit& u, int wr, int wc, int fr, int fq) const {
        const int row0 = u.pm * BM + wr * 64 + fr, col0 = u.pn * BM + wc * 32 + 8 * fq;
#pragma unroll
        for (int ai = 0; ai < 2; ++ai)
#pragma unroll
            for (int m = 0; m < 4; ++m) { bf16_t* rowp = O + (size_t)(row0 + ai * HALF + m * 16) * ldc + col0;
#pragma unroll
                for (int bj = 0; bj < 2; ++bj) { const f32x4 v0 = acc[ai][bj][m][0], v1 = acc[ai][bj][m][1];
                    u32x4 w; w.x = cvt_pk_bf16(v0[0], v0[1]); w.y = cvt_pk_bf16(v0[2], v0[3]); w.z = cvt_pk_bf16(v1[0], v1[1]); w.w = cvt_pk_bf16(v1[2], v1[3]);
                    *(u32x4*)(rowp + bj * HALF) = w; } }
    }
};
}

struct Params { const float* in[24]; float* out; unsigned char* ws; };
#define LDS_WAIT() asm volatile("s_waitcnt lgkmcnt(0)" ::: "memory")
constexpr int NTHR = 512, NWAVE = 8;

struct TrItem { const float* W; int K, N; bf16_t* WT; int drow, k0, n0; const float* gain; int f8; };
__device__ __forceinline__ void tr_load(const TrItem& t, int lane, f32x4 (&v)[8], float (&g)[8]) {
    const int r8 = lane >> 3, ch = lane & 7;
#pragma unroll
    for (int i = 0; i < 8; ++i) v[i] = *(const f32x4*)(t.W + (size_t)(t.k0 + 8 * r8 + i) * t.N + t.n0 + 4 * ch);
    if (t.gain) { const f32x4 g0 = *(const f32x4*)(t.gain + t.k0 + 8 * r8), g1 = *(const f32x4*)(t.gain + t.k0 + 8 * r8 + 4);
        g[0] = g0[0]; g[1] = g0[1]; g[2] = g0[2]; g[3] = g0[3]; g[4] = g1[0]; g[5] = g1[1]; g[6] = g1[2]; g[7] = g1[3]; }
    else {
#pragma unroll
        for (int i = 0; i < 8; ++i) g[i] = 1.0f; }
}
__device__ __forceinline__ void tr_store(const TrItem& t, int lane, const f32x4 (&v)[8], const float (&g)[8], LAS float* scr) {
    (void)scr; const int r8 = lane >> 3, ch = lane & 7;
#pragma unroll
    for (int j = 0; j < 4; ++j) {
        u32x4 o; o.x = cvt_pk_bf16(v[0][j] * g[0], v[1][j] * g[1]); o.y = cvt_pk_bf16(v[2][j] * g[2], v[3][j] * g[3]); o.z = cvt_pk_bf16(v[4][j] * g[4], v[5][j] * g[5]); o.w = cvt_pk_bf16(v[6][j] * g[6], v[7][j] * g[7]);
        *(u32x4*)(t.WT + (size_t)(t.drow + 4 * ch + j) * t.K + t.k0 + 8 * r8) = o; }
}
__device__ __forceinline__ void tr_store8(const TrItem& t, int lane, const f32x4 (&v)[8], const float (&g)[8], LAS float* scr) {
    (void)scr; const int r8 = lane >> 3, ch = lane & 7;
#pragma unroll
    for (int j = 0; j < 4; ++j) {
        int w0 = 0, w1 = 0;
        w0 = __builtin_amdgcn_cvt_pk_fp8_f32(v[0][j] * (g[0] * 64.0f), v[1][j] * (g[1] * 64.0f), w0, false); w0 = __builtin_amdgcn_cvt_pk_fp8_f32(v[2][j] * (g[2] * 64.0f), v[3][j] * (g[3] * 64.0f), w0, true);
        w1 = __builtin_amdgcn_cvt_pk_fp8_f32(v[4][j] * (g[4] * 64.0f), v[5][j] * (g[5] * 64.0f), w1, false); w1 = __builtin_amdgcn_cvt_pk_fp8_f32(v[6][j] * (g[6] * 64.0f), v[7][j] * (g[7] * 64.0f), w1, true);
        *(u32x2*)((unsigned char*)t.WT + (size_t)(t.drow + 4 * ch + j) * t.K + t.k0 + 8 * r8) = (u32x2){(unsigned)w0, (unsigned)w1}; }
}
__device__ __forceinline__ int t5_bucket_d(int dist) {
    if (dist < 16) return dist;
    int lb = 16 + (int)(logf((float)dist / 16.f) / logf(128.f) * 16.f);
    return lb < 31 ? lb : 31;
}
constexpr int I_IN = 16 * 80, I_OUT = 16 * 32, I_G = 16 * 16, I_D = 8 * 32, I_E = 2 * I_G + I_D, PER_L = I_IN + I_OUT;
constexpr int CONV_ITEMS = NE * I_E;
#ifndef CONV_Q_WIN
#define CONV_Q_WIN 6
#endif
#ifndef CONV_Q_GU
#define CONV_Q_GU 0
#endif
#ifndef CONV_Q_DN
#define CONV_Q_DN 0
#endif
#ifndef SLOT_RANKS
#define SLOT_RANKS 24
#endif
#ifndef SLOT_NPW
#define SLOT_NPW 2
#endif
constexpr int SLOT_ITEMS = 8 * SLOT_RANKS * NWAVE * SLOT_NPW;
constexpr int CONV_HEAD = 8 * SLOT_ITEMS;
static_assert(CONV_HEAD == NE * I_E, "the eight barrier slots cover a layer's expert weights exactly");
constexpr int CONV_Q0 = 3 * SLOT_ITEMS;
constexpr int DSLOT = 8 * SLOT_RANKS * NWAVE;
__device__ __forceinline__ void dec_dense(const Params& p, unsigned char* ws_, int it, TrItem& t) {
        const int l = it / PER_L; int r = it % PER_L;
        if (r < I_IN) { const int kb = r / 80, nb = r % 80, n0 = nb * 32, o = n0 & 255;
            t.W = p.in[3] + (size_t)l * D * DIN; t.K = D; t.N = DIN; t.WT = (bf16_t*)(ws_ + WS_WIN) + (size_t)l * DIN * D; t.drow = (n0 & ~255) + 128 * ((o >> 5) & 1) + 32 * ((o >> 6) & 3); t.k0 = kb * 64; t.n0 = n0; t.gain = p.in[2] + l * D; }
        else { r -= I_IN; const int kb = r / 32, nb = r % 32;
            t.W = p.in[15] + (size_t)l * D * D; t.K = D; t.N = D; t.WT = (bf16_t*)(ws_ + WS_WOUT) + (size_t)l * D * D; t.drow = nb * 32; t.k0 = kb * 64; t.n0 = nb * 32; t.gain = kb < 8 ? p.in[13] + l * DA : p.in[14] + l * DR - DA; }
}
__device__ __forceinline__ void dec_exp(const Params& p, unsigned char* ws_, int it, TrItem& t) {
        const int le = it / I_E; int r = it % I_E; const int l = le / NE;
        if (r < 2 * I_G) { const int up = r >= I_G; if (up) r -= I_G; const int kb = r / 16, nb = r % 16, n0 = nb * 32;
            t.W = (up ? p.in[22] : p.in[21]) + (size_t)le * D * DE; t.K = D; t.N = DE; t.WT = (bf16_t*)(ws_ + WS_WGU + (size_t)le * D * D); t.drow = 256 * (n0 >> 7) + 128 * up + (n0 & 127); t.k0 = kb * 64; t.n0 = n0; t.gain = p.in[16] + l * D; t.f8 = 1; }
        else { r -= 2 * I_G; const int kb = r / 32, nb = r % 32;
            t.W = p.in[23] + (size_t)le * DE * D; t.K = DE; t.N = D; t.WT = (bf16_t*)(ws_ + WS_WD + (size_t)le * D * DE); t.drow = nb * 32; t.k0 = kb * 64; t.n0 = nb * 32; t.gain = nullptr; t.f8 = 1; }
}
__device__ __forceinline__ void ph_prologue(const Params& p, LAS unsigned char* lds, int which) {
    unsigned char* const ws_ = opaque_ptr(p.ws);
    const int tid = opaque_tid(), lane = tid & 63, wave = tid >> 6;
    LAS float* scr = (LAS float*)(lds + wave * 8704);
    const int gw = blockIdx.x * NWAVE + wave, NGW = gridDim.x * NWAVE;
    if (which & 1) {
        for (int it = gw; it < PER_L; it += 2 * NGW) {
            TrItem ta, tb; dec_dense(p, ws_, it, ta); const bool hb = it + NGW < PER_L; dec_dense(p, ws_, hb ? it + NGW : it, tb);
            f32x4 va[8], vb[8]; float ga[8], gb[8];
            tr_load(ta, lane, va, ga); tr_load(tb, lane, vb, gb);
            tr_store(ta, lane, va, ga, scr); if (hb) tr_store(tb, lane, vb, gb, scr);
        }
        const int gt = blockIdx.x * NTHR + tid, NGT = gridDim.x * NTHR;
        float* BT = (float*)(ws_ + WS_BT);
        for (int i = gt; i < 3 * 8 * 192; i += NGT) { const int br = i / (8 * 192), h = (i / 192) % 8, j = i % 192; const int dil = br == 0 ? 1 : br == 1 ? 4 : 16;
            const int steps = (190 - j) - 31; float v = -1e30f; if (j < 191 && steps >= 0 && steps <= 128) v = p.in[1][t5_bucket_d(steps * dil) * NH + h] * LOG2E; BT[i] = v; }
        float* BND = (float*)(ws_ + WS_BND);
        if (gw < DEPTH * 24) { const int l = gw / 24, bh = gw % 24, br = bh / 8, h = bh % 8; const int dil = br == 0 ? 1 : br == 1 ? 4 : 16;
            float gm = fabsf(p.in[4][l * 64 + lane] * p.in[5][l * 64 + lane] * 0.125f * LOG2E);
            float bm = -1e30f;
            for (int st = lane; st <= 128; st += 64) bm = fmaxf(bm, p.in[1][t5_bucket_d(st * dil) * NH + h] * LOG2E);
#pragma unroll
            for (int o = 1; o < 64; o <<= 1) { gm = fmaxf(gm, __shfl_xor(gm, o)); bm = fmaxf(bm, __shfl_xor(bm, o)); }
            if (lane == 0) BND[gw] = 64.0f * gm * 1.01f + bm; }
        float* GQK = (float*)(ws_ + WS_GQK);
        for (int i = gt; i < DEPTH * 64; i += NGT) GQK[i] = p.in[4][i] * p.in[5][i] * 0.125f * LOG2E;
        float* SPL = (float*)(ws_ + WS_SPL);
        for (int i = gt; i < DEPTH * DR; i += NGT) { const float lm = -p.in[12][i]; SPL[i] = 8.f * LOG2E * (fmaxf(lm, 0.f) + log1pf(expf(-fabsf(lm)))); }
        bf16_t* RTT = (bf16_t*)(ws_ + WS_RTT);
        for (int i = gt; i < DEPTH * 48 * D; i += NGT) { const int l = i / (48 * D), j = (i / D) % 48, k = i % D; float v = 0.f;
            if (j < 36) v = p.in[16][l * D + k] * (j < 4 ? p.in[17][(l * D + k) * 4 + j] : p.in[19][(l * D + k) * 32 + j - 4]);
            const unsigned h = cvt_pk_bf16(v, 0.f) & 0xffffu; const unsigned lo = cvt_pk_bf16(v - bf_lo(h), 0.f) & 0xffffu;
            RTT[(size_t)(l * 2) * 48 * D + (size_t)j * D + k] = (bf16_t)h; RTT[(size_t)(l * 2 + 1) * 48 * D + (size_t)j * D + k] = (bf16_t)lo; }
        bf16_t* WAT = (bf16_t*)(ws_ + WS_WAT);
        for (int i = gt; i < DEPTH * 2 * 8 * 4096; i += NGT) { const int l = i / (2 * 8 * 4096), wh = (i / (8 * 4096)) & 1, g = (i / 4096) & 7, j = (i / 64) & 63, ii = i & 63;
            const float v = (wh ? p.in[10] : p.in[8])[((size_t)(l * 8 + g) * 64 + ii) * 64 + j]; WAT[i] = (bf16_t)(cvt_pk_bf16(v, 0.f) & 0xffffu); }
    }
    (void)scr;
}

__device__ __forceinline__ int conv_idle(int ntiles, int G) { const int rem = (ntiles * 4) % G; return rem == 0 ? 0 : G - rem; }
__device__ __forceinline__ void convert_range(const Params& p, LAS unsigned char* lds, int l, int first, int stride, int npairs, int limit) {
    unsigned char* const ws_ = opaque_ptr(p.ws);
    const int tid = opaque_tid(), lane = tid & 63, wave = tid >> 6;
    LAS float* scr = (LAS float*)(lds + wave * 8704);
#pragma unroll 1
    for (int it = 0; it < npairs; ++it) {
        const int base = first + it * stride;
        if (base >= limit) break;
        TrItem ta, tb; dec_exp(p, ws_, l * CONV_ITEMS + base, ta); dec_exp(p, ws_, l * CONV_ITEMS + base + 1, tb);
        f32x4 va[8], vb[8]; float ga[8], gb[8];
        tr_load(ta, lane, va, ga); tr_load(tb, lane, vb, gb);
        tr_store8(ta, lane, va, ga, scr); tr_store8(tb, lane, vb, gb, scr);
    }
}

__device__ __forceinline__ void convert_queue(const Params& p, LAS unsigned char* lds, int l, bool use_stop) {
    unsigned char* const ws_ = opaque_ptr(p.ws);
    const int tid = opaque_tid(), lane = tid & 63, wave = tid >> 6;
    LAS float* scr = (LAS float*)(lds + wave * 8704);
    volatile LAS unsigned* slot = (volatile LAS unsigned*)(lds + LDS_MISC + 128);
    unsigned* head = (unsigned*)(ws_ + WS_CONV) + l * 64; unsigned* stop = (unsigned*)(ws_ + WS_CONV) + 512 + l * 64;
#pragma unroll 1
    for (;;) {
        __syncthreads();
        if (tid == 0) { unsigned b = 0xffffffffu;
            if (!(use_stop && __hip_atomic_load(stop, __ATOMIC_RELAXED, __HIP_MEMORY_SCOPE_AGENT) != 0u)) b = atomicAdd(head, 16u);
            slot[0] = b; }
        __syncthreads();
        const unsigned b = slot[0];
        if (b >= (unsigned)CONV_Q0) break;
        const int base = (int)b + 2 * wave;
        TrItem ta, tb; dec_exp(p, ws_, l * CONV_ITEMS + base, ta); dec_exp(p, ws_, l * CONV_ITEMS + base + 1, tb);
        f32x4 va[8], vb[8]; float ga[8], gb[8];
        tr_load(ta, lane, va, ga); tr_load(tb, lane, vb, gb);
        tr_store8(ta, lane, va, ga, scr); tr_store8(tb, lane, vb, gb, scr);
    }
}

__device__ __forceinline__ void build_tiles(const int* counts, LAS int* tab) {
    const int tid = opaque_tid();
    __syncthreads();
    if (tid < 64) {
        const int cnt = tid < NE ? counts[tid * CNT_STRIDE] : 0; const int nt = (cnt + 255) >> 8, rem = cnt & 255;
        const int sm = (rem >= 1 && rem <= 128) ? 1 : 0, nm = nt - sm;
        int im = nm, is = sm;
#pragma unroll
        for (int o = 1; o < 32; o <<= 1) { const int v = __shfl_up(im, o), w = __shfl_up(is, o); if (tid >= o) { im += v; is += w; } }
        const int TM = __shfl(im, NE - 1), TS = __shfl(is, NE - 1);
        const int em = im - nm, es = is - sm;
        if (tid < NE) { tab[tid] = cnt; tab[32 + tid] = em; tab[448 + tid] = es; tab[480 + tid] = nm;
#pragma unroll 1
            for (int t = 0; t < nm; ++t) { tab[128 + em + t] = tid; tab[288 + em + t] = t * 256; }
            if (sm) { tab[128 + TM + es] = tid; tab[288 + TM + es] = nm * 256; } }
        if (tid == 0) { tab[66] = TM + TS; tab[67] = TM; }
    }
    __syncthreads();
}
__device__ __forceinline__ int moe_slot(const LAS int* tab, int e, int rk) {
    const int t = rk >> 8; const int gt = (t < tab[480 + e]) ? tab[32 + e] + t : tab[67] + tab[448 + e];
    return gt * 256 + (rk & 255);
}

__device__ __forceinline__ void norm_finish(f32x4 (&v)[4], int row, int lane, float* dst, bf16_t* HN, int mode, bool donorm) {
    if (mode) { f32x4* xo = (f32x4*)(dst + (size_t)row * D) + lane;
#pragma unroll
        for (int j = 0; j < 4; ++j) xo[64 * j] = v[j]; }
    if (donorm) {
        float s = 0.f;
#pragma unroll
        for (int j = 0; j < 4; ++j) s += (v[j][0] * v[j][0] + v[j][1] * v[j][1]) + (v[j][2] * v[j][2] + v[j][3] * v[j][3]);
        s = wave_sum(s);
        const float rstd = rsqrtf(s * (1.0f / D) + EPS);
        u32x2* o = (u32x2*)(HN + (size_t)row * D) + lane;
#pragma unroll
        for (int j = 0; j < 4; ++j) { u32x2 w; w.x = cvt_pk_bf16(v[j][0] * rstd, v[j][1] * rstd); w.y = cvt_pk_bf16(v[j][2] * rstd, v[j][3] * rstd); o[64 * j] = w; }
    }
}
__device__ __forceinline__ void norm_add(f32x4 (&v)[4], const u32x2 (&a)[4], const u32x2 (&b)[4], float g0, float g1) {
#pragma unroll
    for (int j = 0; j < 4; ++j) {
        v[j][0] += g0 * bf_lo(a[j].x) + g1 * bf_lo(b[j].x); v[j][1] += g0 * bf_hi(a[j].x) + g1 * bf_hi(b[j].x);
        v[j][2] += g0 * bf_lo(a[j].y) + g1 * bf_lo(b[j].y); v[j][3] += g0 * bf_hi(a[j].y) + g1 * bf_hi(b[j].y); }
}
__device__ __forceinline__ void ph_norm(const Params& p, LAS unsigned char* lds, const float* src, float* dst, int mode, const int* counts, bool donorm, int conv_l) {
    unsigned char* const ws_ = opaque_ptr(p.ws);
    const int tid = opaque_tid(), lane = tid & 63, wave = __builtin_amdgcn_readfirstlane(tid >> 6);
    LAS int* tab = (LAS int*)(lds + LDS_TAB);
    if (mode) build_tiles(counts, tab);
    const int* eid = (const int*)(ws_ + WS_TOK); const int* rank = eid + M * 2; const float* gate = (const float*)(rank + M * 2);
    const bf16_t* Y = (const bf16_t*)(ws_ + WS_Y); bf16_t* HN = (bf16_t*)(ws_ + WS_HN);
    const bool own = gridDim.x == 256;
    const int stride = own ? 1 : gridDim.x * NWAVE;
    for (int base = own ? 64 * xcd_unit(blockIdx.x) + 8 * wave : blockIdx.x * NWAVE + wave; base < M; base += own ? M : 8 * stride) {
        int ms0 = 0, ms1 = 0; float mg0 = 0.f, mg1 = 0.f;
        if (mode && lane < 8) { const int r = base + lane * stride;
            if (r < M) { const int e0 = eid[r * 2], e1 = eid[r * 2 + 1]; ms0 = moe_slot(tab, e0, rank[r * 2]); ms1 = moe_slot(tab, e1, rank[r * 2 + 1]); mg0 = gate[r * 2]; mg1 = gate[r * 2 + 1]; } }
#pragma unroll
        for (int i = 0; i < 8; i += 2) {
            const int ra = base + i * stride, rb = ra + stride;
            if (ra < M) {
                const bool hb = rb < M; const int rbb = hb ? rb : ra;
                f32x4 va[4], vb[4];
                const f32x4* xa = (const f32x4*)(src + (size_t)ra * D) + lane; const f32x4* xb = (const f32x4*)(src + (size_t)rbb * D) + lane;
#pragma unroll
                for (int j = 0; j < 4; ++j) { va[j] = xa[64 * j]; vb[j] = xb[64 * j]; }
                if (mode) {
                    const int sa0 = __builtin_amdgcn_readlane(ms0, i), sa1 = __builtin_amdgcn_readlane(ms1, i), sb0 = __builtin_amdgcn_readlane(ms0, i + 1), sb1 = __builtin_amdgcn_readlane(ms1, i + 1);
                    const float ga0 = __int_as_float(__builtin_amdgcn_readlane(__float_as_int(mg0), i)), ga1 = __int_as_float(__builtin_amdgcn_readlane(__float_as_int(mg1), i)), gb0 = __int_as_float(__builtin_amdgcn_readlane(__float_as_int(mg0), i + 1)), gb1 = __int_as_float(__builtin_amdgcn_readlane(__float_as_int(mg1), i + 1));
                    u32x2 ya0[4], ya1[4], yb0[4], yb1[4];
                    const u32x2* pa0 = (const u32x2*)(Y + (size_t)sa0 * D) + lane; const u32x2* pa1 = (const u32x2*)(Y + (size_t)sa1 * D) + lane;
                    const u32x2* pb0 = (const u32x2*)(Y + (size_t)sb0 * D) + lane; const u32x2* pb1 = (const u32x2*)(Y + (size_t)sb1 * D) + lane;
#pragma unroll
                    for (int j = 0; j < 4; ++j) { ya0[j] = pa0[64 * j]; ya1[j] = pa1[64 * j]; yb0[j] = pb0[64 * j]; yb1[j] = pb1[64 * j]; }
                    norm_add(va, ya0, ya1, ga0, ga1); norm_add(vb, yb0, yb1, gb0, gb1);
                }
                norm_finish(va, ra, lane, dst, HN, mode, donorm);
                if (hb) norm_finish(vb, rb, lane, dst, HN, mode, donorm);
            }
        }
    }
    if (conv_l >= 0) {
        const int T = __builtin_amdgcn_readfirstlane(tab[66]), idle = conv_idle(T, gridDim.x);
        int a3 = 0, lim = CONV_HEAD; (void)idle;
        convert_range(p, lds, conv_l, a3 + 2 * (blockIdx.x * NWAVE + wave), 2 * gridDim.x * NWAVE, 1 << 30, lim);
    }
}

__device__ __forceinline__ void ph_win(const Params& p, LAS unsigned char* lds, int l) {
    unsigned char* const ws_ = opaque_ptr(p.ws);
    LAS float* gq = (LAS float*)(lds + LDS_TAB + 4096);
    { const int t_ = opaque_tid(); if (t_ < 64) gq[t_] = ((const float*)(ws_ + WS_GQK))[l * 64 + t_]; }
    __syncthreads();
    if (((volatile LAS unsigned*)(lds + LDS_MISC))[2] == 0u) {
        const int w_ = opaque_tid() >> 6, gw_ = (int)blockIdx.x * NWAVE + w_, ngw_ = gridDim.x * NWAVE;
        convert_range(p, lds, l, (l == 0 ? 3 * SLOT_ITEMS : 0) + 2 * gw_, 2 * ngw_, 1 << 30, CONV_HEAD);
        if (l + 1 < DEPTH) {
#pragma unroll 1
            for (int it = gw_; it < PER_L; it += ngw_) { TrItem t; dec_dense(p, ws_, (l + 1) * PER_L + it, t); f32x4 v[8]; float g[8]; tr_load(t, opaque_tid() & 63, v, g); tr_store(t, opaque_tid() & 63, v, g, nullptr); } }
        __syncthreads(); }
    pg8::StaticOrder S; S.init((const bf16_t*)(ws_ + WS_HN), (const bf16_t*)(ws_ + WS_WIN) + (size_t)l * DIN * D, M, DIN, D, gridDim.x, opaque_bid());
    pg8::EpiQKV E{(bf16_t*)(ws_ + WS_ZB), gq};
    pg8::gemm_phase<pg8::EpiQKV, pg8::StaticOrder, false>(lds + LDS_STAGE, nullptr, 2 * D, S, E);
    { pg8::Unit u_; const bool third = S.next(2, u_);
      if (third) { if (opaque_tid() == 0) __hip_atomic_store((unsigned*)(ws_ + WS_CONV) + 512 + l * 64, 1u, __ATOMIC_RELAXED, __HIP_MEMORY_SCOPE_AGENT); }
      else if (l == 0) convert_queue(p, lds, l, true); }
}
__device__ __forceinline__ void ph_wout(const Params& p, LAS unsigned char* lds, int l, const float* base, float* out) {
    unsigned char* const ws_ = opaque_ptr(p.ws);
    pg8::StaticOrder S; S.init((const bf16_t*)(ws_ + WS_MIX), (const bf16_t*)(ws_ + WS_WOUT) + (size_t)l * D * D, M, D, D, gridDim.x, opaque_bid());
    pg8::EpiRes E{base, out, D};
    pg8::gemm_phase<pg8::EpiRes, pg8::StaticOrder, false>(lds + LDS_STAGE, nullptr, 2 * D, S, E);
}

__device__ __forceinline__ void split_hilo(const f32x4& a, const f32x4& b, bf16x8& hi, bf16x8& lo) {
    u32x4 h; h.x = cvt_pk_bf16(a[0], a[1]); h.y = cvt_pk_bf16(a[2], a[3]); h.z = cvt_pk_bf16(b[0], b[1]); h.w = cvt_pk_bf16(b[2], b[3]);
    u32x4 l; l.x = cvt_pk_bf16(a[0] - bf_lo(h.x), a[1] - bf_hi(h.x)); l.y = cvt_pk_bf16(a[2] - bf_lo(h.y), a[3] - bf_hi(h.y));
    l.z = cvt_pk_bf16(b[0] - bf_lo(h.z), b[1] - bf_hi(h.z)); l.w = cvt_pk_bf16(b[2] - bf_lo(h.w), b[3] - bf_hi(h.w));
    hi = __builtin_bit_cast(bf16x8, h); lo = __builtin_bit_cast(bf16x8, l);
}
__device__ __forceinline__ void ph_router(const Params& p, LAS unsigned char* lds, int l, const float* X) {
    unsigned char* const ws_ = opaque_ptr(p.ws);
    const int tid = opaque_tid(), lane = tid & 63, wave = __builtin_amdgcn_readfirstlane(tid >> 6);
    LAS float* rs = (LAS float*)lds; LAS float* Lg = (LAS float*)(lds + 1024);
    LAS int* hist = (LAS int*)(lds + 110592); LAS int* base = hist + 32;
    LAS int* t_e = hist + 64; LAS int* t_lr = t_e + 128; LAS float* t_g = (LAS float*)(t_lr + 128);
    const bf16_t* RTH = (const bf16_t*)(ws_ + WS_RTT) + (size_t)l * 2 * 48 * D; const bf16_t* RTL = RTH + 48 * D;
    int* counts = (int*)(ws_ + WS_CNT) + l * NE * CNT_STRIDE;
    int* eid = (int*)(ws_ + WS_TOK); int* rank = eid + M * 2; float* gate = (float*)(rank + M * 2);
    int* list = (int*)(ws_ + WS_LIST); bf16_t* HN = (bf16_t*)(ws_ + WS_HN);
    const float* bg = p.in[18] + l * NG; const float* be = p.in[20] + l * NE;
    SP_DECL;
    for (int g0 = blockIdx.x; g0 < M / 64; g0 += gridDim.x) {
        const int grp = xcd_unit(g0);
        __syncthreads();
        if (tid < 32) hist[tid] = 0;
        SP_BEGIN();
#pragma unroll 1
        for (int ti = 0; ti < 8; ti += 4) {
            const int ta = grp * 64 + wave * 8 + ti;
            const f32x4* xa = (const f32x4*)(X + (size_t)ta * D) + lane;
            f32x4 v[4][4]; float sq[4];
#pragma unroll
            for (int r = 0; r < 4; ++r)
#pragma unroll
                for (int j = 0; j < 4; ++j) v[r][j] = xa[r * (D / 4) + 64 * j];
#pragma unroll
            for (int r = 0; r < 4; ++r) { float s = 0.f;
#pragma unroll
                for (int j = 0; j < 4; ++j) s += (v[r][j][0] * v[r][j][0] + v[r][j][1] * v[r][j][1]) + (v[r][j][2] * v[r][j][2] + v[r][j][3] * v[r][j][3]);
                sq[r] = s; }
#pragma unroll
            for (int r = 0; r < 4; ++r) sq[r] = wave_sum(sq[r]);
#pragma unroll
            for (int r = 0; r < 4; ++r) { const float rr = rsqrtf(sq[r] * (1.0f / D) + EPS);
                unsigned* o = (unsigned*)((unsigned char*)HN + (size_t)(ta + r) * D) + lane;
#pragma unroll
                for (int j = 0; j < 4; ++j) { int w = 0; w = __builtin_amdgcn_cvt_pk_fp8_f32(v[r][j][0] * rr, v[r][j][1] * rr, w, false); w = __builtin_amdgcn_cvt_pk_fp8_f32(v[r][j][2] * rr, v[r][j][3] * rr, w, true); o[64 * j] = (unsigned)w; }
                if (lane == 0) rs[wave * 8 + ti + r] = rr; }
        }
        SP_SYNC(); SP_END(3); SP_BEGIN();
        { const int fr = lane & 15, kq = lane >> 4;
          const float* xrow = X + (size_t)(grp * 64 + fr) * D + wave * 128 + 8 * kq;
          const bf16_t* bh = RTH + (size_t)fr * D + wave * 128 + 8 * kq; const bf16_t* bl = RTL + (size_t)fr * D + wave * 128 + 8 * kq;
          f32x4 acc[4][3];
#pragma unroll
          for (int tb = 0; tb < 4; ++tb)
#pragma unroll
              for (int ob = 0; ob < 3; ++ob) acc[tb][ob] = (f32x4){0.f, 0.f, 0.f, 0.f};
#pragma unroll 1
          for (int ks = 0; ks < 4; ++ks) {
              bf16x8 wh[3], wl[3];
#pragma unroll
              for (int ob = 0; ob < 3; ++ob) { wh[ob] = *(const bf16x8*)(bh + (size_t)ob * 16 * D + 32 * ks); wl[ob] = *(const bf16x8*)(bl + (size_t)ob * 16 * D + 32 * ks); }
              f32x4 x0[4], x1[4];
#pragma unroll
              for (int tb = 0; tb < 4; ++tb) { x0[tb] = *(const f32x4*)(xrow + (size_t)tb * 16 * D + 32 * ks); x1[tb] = *(const f32x4*)(xrow + (size_t)tb * 16 * D + 32 * ks + 4); }
#pragma unroll
              for (int tb = 0; tb < 4; ++tb) { bf16x8 ah, al; split_hilo(x0[tb], x1[tb], ah, al);
#pragma unroll
                  for (int ob = 0; ob < 3; ++ob) {
                      acc[tb][ob] = __builtin_amdgcn_mfma_f32_16x16x32_bf16(ah, wh[ob], acc[tb][ob], 0, 0, 0);
                      acc[tb][ob] = __builtin_amdgcn_mfma_f32_16x16x32_bf16(al, wh[ob], acc[tb][ob], 0, 0, 0);
                      acc[tb][ob] = __builtin_amdgcn_mfma_f32_16x16x32_bf16(ah, wl[ob], acc[tb][ob], 0, 0, 0); } } }
#pragma unroll
          for (int tb = 0; tb < 4; ++tb)
#pragma unroll
              for (int ob = 0; ob < 3; ++ob)
#pragma unroll
                  for (int r = 0; r < 4; ++r) Lg[(wave * 64 + tb * 16 + 4 * kq + r) * 52 + ob * 16 + fr] = acc[tb][ob][r];
        }
        __syncthreads(); SP_END(4); SP_BEGIN();
        if (tid < 64) {
            const float rstd = rs[tid];
            f32x4 l4[9];
#pragma unroll
            for (int q = 0; q < 9; ++q) l4[q] = *(const LAS f32x4*)(Lg + tid * 52 + 4 * q);
#pragma unroll 1
            for (int sl = 1; sl < 8; ++sl) {
#pragma unroll
                for (int q = 0; q < 9; ++q) l4[q] += *(const LAS f32x4*)(Lg + (sl * 64 + tid) * 52 + 4 * q); }
            float lg[36];
#pragma unroll
            for (int q = 0; q < 9; ++q) { lg[4 * q] = l4[q][0] * rstd; lg[4 * q + 1] = l4[q][1] * rstd; lg[4 * q + 2] = l4[q][2] * rstd; lg[4 * q + 3] = l4[q][3] * rstd; }
            float gl[4];
#pragma unroll
            for (int j = 0; j < 4; ++j) gl[j] = lg[j] + bg[j];
            int gs = 0; float gm = gl[0];
#pragma unroll
            for (int j = 1; j < 4; ++j) if (gl[j] > gm) { gm = gl[j]; gs = j; }
            float den = 0.f;
#pragma unroll
            for (int j = 0; j < 4; ++j) den += expf(gl[j] - gm);
            const float gw = 1.f / den;
            float el[8];
#pragma unroll
            for (int j = 0; j < 8; ++j) el[j] = (gs == 0 ? lg[4 + j] : gs == 1 ? lg[12 + j] : gs == 2 ? lg[20 + j] : lg[28 + j]) + be[gs * 8 + j];
            int i0 = 0; float m0 = el[0];
#pragma unroll
            for (int j = 1; j < 8; ++j) if (el[j] > m0) { m0 = el[j]; i0 = j; }
            int i1 = -1; float m1 = -3.0e38f;
#pragma unroll
            for (int j = 0; j < 8; ++j) if (j != i0 && el[j] > m1) { m1 = el[j]; i1 = j; }
            const float e1 = expf(m1 - m0); const float p0 = 1.f / (1.f + e1), p1 = e1 / (1.f + e1);
            const int ex0 = gs * 8 + i0, ex1 = gs * 8 + i1;
            t_e[tid * 2] = ex0; t_e[tid * 2 + 1] = ex1; t_g[tid * 2] = gw * p0; t_g[tid * 2 + 1] = gw * p1;
            t_lr[tid * 2] = __hip_atomic_fetch_add(hist + ex0, 1, __ATOMIC_RELAXED, __HIP_MEMORY_SCOPE_WORKGROUP); t_lr[tid * 2 + 1] = __hip_atomic_fetch_add(hist + ex1, 1, __ATOMIC_RELAXED, __HIP_MEMORY_SCOPE_WORKGROUP);
        }
        __syncthreads();
        if (tid < 32) { const int hcount = hist[tid]; base[tid] = hcount > 0 ? atomicAdd(&counts[tid * CNT_STRIDE], hcount) : 0; }
        __syncthreads();
        if (tid < 128) { const int tok = grp * 64 + (tid >> 1); const int e = t_e[tid]; const int r = base[e] + t_lr[tid];
            eid[tok * 2 + (tid & 1)] = e; rank[tok * 2 + (tid & 1)] = r; gate[tok * 2 + (tid & 1)] = t_g[tid]; list[(size_t)e * M + r] = tok; }
        SP_SYNC(); SP_END(5);
    }
}
__device__ __forceinline__ void ph_gateup(const Params& p, LAS unsigned char* lds, int l) {
    unsigned char* const ws_ = opaque_ptr(p.ws);
    LAS int* tab = (LAS int*)(lds + LDS_TAB);
    build_tiles((const int*)(ws_ + WS_CNT) + l * NE * CNT_STRIDE, tab);
    pg8::MoeOrder S; S.G = gridDim.x; S.c = opaque_bid(); S.ntiles = __builtin_amdgcn_readfirstlane(tab[66]); S.tile_e = tab + 128; S.tile_r0 = tab + 288; S.cnt = tab;
    S.A = nullptr; S.tA = 0; S.W = (const char*)(ws_ + WS_WGU) + (size_t)l * NE * D * D; S.estride = (size_t)D * D; S.tB = (size_t)256 * D;
    S.list = (const int*)(ws_ + WS_LIST); S.Mrows = M;
    S.pub = nullptr; S.wait = nullptr; S.need = 0u; S.tmo = nullptr;
    pg8::EpiSwiGLU8 E{(unsigned char*)(ws_ + WS_ACT)};
    pg8::gemm_phase<pg8::EpiSwiGLU8, pg8::MoeOrder, true, true, 0x79797979, 0x7f7f7f7f, false, 10>(lds + LDS_STAGE, (const void*)(ws_ + WS_HN), D, S, E);
    if (l + 1 < DEPTH && gridDim.x == 256 && CONV_Q_GU > 0) { const int rem = (S.ntiles * 4) % S.G;
        if (rem != 0 && (int)blockIdx.x >= rem) { const int wv = opaque_tid() >> 6;
            convert_range(p, lds, l + 1, (((int)blockIdx.x - rem) * NWAVE + wv) * 2 * CONV_Q_GU, 2, CONV_Q_GU, CONV_HEAD); } }
}
__device__ __forceinline__ void ph_down(const Params& p, LAS unsigned char* lds, int l) {
    unsigned char* const ws_ = opaque_ptr(p.ws);
    LAS int* tab = (LAS int*)(lds + LDS_TAB);
    build_tiles((const int*)(ws_ + WS_CNT) + l * NE * CNT_STRIDE, tab);
    pg8::MoeOrder S; S.G = gridDim.x; S.c = opaque_bid(); S.ntiles = __builtin_amdgcn_readfirstlane(tab[66]); S.tile_e = tab + 128; S.tile_r0 = tab + 288; S.cnt = tab;
    S.A = (const char*)(ws_ + WS_ACT); S.tA = (size_t)256 * DE; S.W = (const char*)(ws_ + WS_WD) + (size_t)l * NE * D * DE; S.estride = (size_t)D * DE; S.tB = (size_t)256 * DE;
    S.list = (const int*)(ws_ + WS_LIST); S.Mrows = M;
    S.pub = nullptr; S.wait = nullptr; S.need = 0u; S.tmo = nullptr;
    pg8::EpiBf16 E{(bf16_t*)(ws_ + WS_Y), D};
    pg8::gemm_phase<pg8::EpiBf16, pg8::MoeOrder, true, true, 0x79797979, 0x7c7c7c7c, true, 9>(lds + LDS_STAGE, (const void*)(ws_ + WS_ACT), DE, S, E);
    if (l + 1 < DEPTH && gridDim.x == 256 && CONV_Q_DN > 0) { const int rem = (S.ntiles * 4) % S.G;
        if (rem != 0 && (int)blockIdx.x >= rem) { const int wv = opaque_tid() >> 6; const int a2 = (S.G - rem) * 8 * 2 * CONV_Q_GU;
            convert_range(p, lds, l + 1, a2 + (((int)blockIdx.x - rem) * NWAVE + wv) * 2 * CONV_Q_DN, 2, CONV_Q_DN, CONV_HEAD); } }
}

#define TRREAD(dst, addr, off) asm volatile("ds_read_b64_tr_b16 %0, %1 offset:%2" : "=&v"(dst) : "v"(addr), "i"(off) : "memory")
struct AttnPf { u32x4 k[6], v[6]; bf16x8 q[4]; };
__device__ __forceinline__ void attn_issue(const bf16_t* ZB, int item, int tid, AttnPf& pf, int which) {
    const int br = item >> 9, rem = item & 511, b = rem >> 8, h = (rem >> 5) & 7, j = rem & 31;
    const int dsh = br * 2, dil = 1 << dsh, nblk = 32 >> dsh, r = j / nblk, blk = j % nblk, i0 = blk * 256;
    if (which & 3) {
#pragma unroll
        for (int jj = 0; jj < 6; ++jj) {
            const int idx = tid + 512 * jj, key = idx >> 3, ch = idx & 7, sub = i0 - 128 + key;
            const bf16_t* rp = ZB + (size_t)(b * SEQ + (sub >= 0 ? sub : 0) * dil + r) * DIN + h * HD + ch * 8;
            if (which & 1) { pf.k[jj] = (u32x4){0u, 0u, 0u, 0u}; if (sub >= 0) pf.k[jj] = *(const u32x4*)(rp + DA); }
            if (which & 2) { pf.v[jj] = (u32x4){0u, 0u, 0u, 0u}; if (sub >= 0) pf.v[jj] = *(const u32x4*)(rp + 2 * DA); }
        }
    }
    if (which & 4) {
        const int lane = tid & 63, w = tid >> 6, hh = lane >> 5, ql = lane & 31;
        const size_t qtok = (size_t)(b * SEQ + (i0 + 32 * w + ql) * dil + r);
#pragma unroll
        for (int ks = 0; ks < 4; ++ks) pf.q[ks] = *(const bf16x8*)(ZB + qtok * DIN + h * HD + 16 * ks + 8 * hh);
    }
}
__device__ __forceinline__ void attn_item(const Params& p, LAS unsigned char* lds, int l, int item, AttnPf& pf, int next_item) {
    unsigned char* const ws_ = opaque_ptr(p.ws);
    const int tid = opaque_tid(), lane = tid & 63, w = __builtin_amdgcn_readfirstlane(tid >> 6), hh = lane >> 5, ql = lane & 31;
    const int br = item >> 9, rem = item & 511, b = rem >> 8, h = (rem >> 5) & 7, j = rem & 31;
    const int dsh = br * 2, dil = 1 << dsh, nblk = 32 >> dsh, r = j / nblk, blk = j % nblk, i0 = blk * 256;
    const bf16_t* ZB = (const bf16_t*)(ws_ + WS_ZB);
    LAS unsigned char* Kl = lds; LAS unsigned char* Vl = lds + 49152; LAS float* Tl = (LAS float*)(lds + 98304) + (br * 8 + h) * 192;
    LAS unsigned char* Ost = lds + 116736 + w * 4096;
    SP_DECL;
    __syncthreads();
    SP_BEGIN();
#pragma unroll
    for (int jj = 0; jj < 6; ++jj) {
        const int idx = tid + 512 * jj, key = idx >> 3, ch = idx & 7;
        *(LAS u32x4*)(Kl + key * 128 + ((ch ^ ((key >> 1) & 7)) << 4)) = pf.k[jj];
        *(LAS u32x4*)(Vl + ((key >> 2) * 2 + (ch >> 2)) * 256 + (key & 3) * 64 + (ch & 3) * 16) = pf.v[jj];
    }
    bf16x8 qf[4];
#pragma unroll
    for (int ks = 0; ks < 4; ++ks) qf[ks] = pf.q[ks];
    __syncthreads();
    SP_END(11); SP_BEGIN();
    const int sw = (ql >> 1) & 7;
    int koff[4];
#pragma unroll
    for (int ks = 0; ks < 4; ++ks) koff[ks] = ((2 * ks + hh) ^ sw) << 4;
    const LAS unsigned char* kbase = Kl + (32 * w + ql) * 128;
    const LAS float* tl = Tl + (31 - ql + 4 * hh);
    if (next_item >= 0) attn_issue(ZB, next_item, tid, pf, 1);
    __builtin_amdgcn_sched_barrier(0);
    f32x16 S[5];
#pragma unroll
    for (int kb = 0; kb < 5; ++kb) {
#pragma unroll
        for (int rr = 0; rr < 16; ++rr) S[kb][rr] = tl[32 * kb + (rr & 3) + 8 * (rr >> 2)];
#pragma unroll
        for (int ks = 0; ks < 4; ++ks) { const bf16x8 kf = *(const LAS bf16x8*)(kbase + kb * 4096 + koff[ks]);
            S[kb] = __builtin_amdgcn_mfma_f32_32x32x16_bf16(kf, qf[ks], S[kb], 0, 0, 0); }
    }
    __builtin_amdgcn_sched_barrier(0);
    if (next_item >= 0) attn_issue(ZB, next_item, tid, pf, 2);
    __builtin_amdgcn_sched_barrier(0);
    const int thr = 128 - i0 - 32 * w;
    if (thr > 0) {
        asm volatile("" ::: "memory");
#pragma unroll
        for (int kb = 0; kb < 5; ++kb)
#pragma unroll
            for (int rr = 0; rr < 16; ++rr) { const int c = 32 * kb + (rr & 3) + 8 * (rr >> 2); if (c + 4 * hh < thr) S[kb][rr] = -1e30f; }
    }
    float ls = 0.f;
#pragma unroll
    for (int kb = 0; kb < 5; ++kb)
#pragma unroll
        for (int rr = 0; rr < 16; ++rr) { const float e = __builtin_amdgcn_exp2f(S[kb][rr]); S[kb][rr] = e; ls += e; }
    ls += __shfl_xor(ls, 32);
    __builtin_amdgcn_sched_barrier(0);
    if (next_item >= 0) attn_issue(ZB, next_item, tid, pf, 4);
    __builtin_amdgcn_sched_barrier(0);
    f32x16 O[2];
    O[0] = (f32x16){0.f, 0.f, 0.f, 0.f, 0.f, 0.f, 0.f, 0.f, 0.f, 0.f, 0.f, 0.f, 0.f, 0.f, 0.f, 0.f}; O[1] = O[0];
    const unsigned vaddr = (unsigned)(size_t)(Vl) + (unsigned)(w * 4096 + hh * 512 + ((lane >> 2) & 3) * 64 + ((lane >> 4) & 1) * 32 + (lane & 3) * 8);
#define PV_READ(V0, V1, kb) do { \
        TRREAD(V0[0][0], vaddr, (8 * (kb) + 0) * 512 + 0);   TRREAD(V1[0][0], vaddr, (8 * (kb) + 2) * 512 + 0); \
        TRREAD(V0[0][1], vaddr, (8 * (kb) + 0) * 512 + 256); TRREAD(V1[0][1], vaddr, (8 * (kb) + 2) * 512 + 256); \
        TRREAD(V0[1][0], vaddr, (8 * (kb) + 4) * 512 + 0);   TRREAD(V1[1][0], vaddr, (8 * (kb) + 6) * 512 + 0); \
        TRREAD(V0[1][1], vaddr, (8 * (kb) + 4) * 512 + 256); TRREAD(V1[1][1], vaddr, (8 * (kb) + 6) * 512 + 256); } while (0)
#define PV_MMA(V0, V1, kb) do { _Pragma("unroll") for (int s2 = 0; s2 < 2; ++s2) { \
            u32x4 pw; pw.x = cvt_pk_bf16(S[kb][8 * s2 + 0], S[kb][8 * s2 + 1]); pw.y = cvt_pk_bf16(S[kb][8 * s2 + 2], S[kb][8 * s2 + 3]); \
            pw.z = cvt_pk_bf16(S[kb][8 * s2 + 4], S[kb][8 * s2 + 5]); pw.w = cvt_pk_bf16(S[kb][8 * s2 + 6], S[kb][8 * s2 + 7]); \
            const bf16x8 pb = __builtin_bit_cast(bf16x8, pw); \
            _Pragma("unroll") for (int db = 0; db < 2; ++db) { const bf16x8 va = (bf16x8){V0[s2][db][0], V0[s2][db][1], V0[s2][db][2], V0[s2][db][3], V1[s2][db][0], V1[s2][db][1], V1[s2][db][2], V1[s2][db][3]}; \
                O[db] = __builtin_amdgcn_mfma_f32_32x32x16_bf16(va, pb, O[db], 0, 0, 0); } } } while (0)
    {
        s16x4 va0[2][2], va1[2][2], vb0[2][2], vb1[2][2];
        PV_READ(va0, va1, 0);
        PV_READ(vb0, vb1, 1); asm volatile("s_waitcnt lgkmcnt(8)" ::: "memory"); __builtin_amdgcn_sched_barrier(0); PV_MMA(va0, va1, 0); __builtin_amdgcn_sched_barrier(0);
        PV_READ(va0, va1, 2); asm volatile("s_waitcnt lgkmcnt(8)" ::: "memory"); __builtin_amdgcn_sched_barrier(0); PV_MMA(vb0, vb1, 1); __builtin_amdgcn_sched_barrier(0);
        PV_READ(vb0, vb1, 3); asm volatile("s_waitcnt lgkmcnt(8)" ::: "memory"); __builtin_amdgcn_sched_barrier(0); PV_MMA(va0, va1, 2); __builtin_amdgcn_sched_barrier(0);
        PV_READ(va0, va1, 4); asm volatile("s_waitcnt lgkmcnt(8)" ::: "memory"); __builtin_amdgcn_sched_barrier(0); PV_MMA(vb0, vb1, 3); __builtin_amdgcn_sched_barrier(0);
        asm volatile("s_waitcnt lgkmcnt(0)" ::: "memory"); __builtin_amdgcn_sched_barrier(0); PV_MMA(va0, va1, 4);
    }
#undef PV_READ
#undef PV_MMA
    asm volatile("s_waitcnt lgkmcnt(0)" ::: "memory"); SP_END(12); SP_BEGIN();
    const float inv = 1.0f / ls;
#pragma unroll
    for (int db = 0; db < 2; ++db)
#pragma unroll
        for (int rg = 0; rg < 4; ++rg) { u32x2 o; o.x = cvt_pk_bf16(O[db][4 * rg] * inv, O[db][4 * rg + 1] * inv); o.y = cvt_pk_bf16(O[db][4 * rg + 2] * inv, O[db][4 * rg + 3] * inv);
            *(LAS u32x2*)(Ost + ql * 128 + (((4 * db + rg) ^ (ql & 7)) << 4) + 8 * hh) = o; }
    const float bound = ((const float*)(ws_ + WS_BND))[l * 24 + br * 8 + h];
    const size_t qtok = (size_t)(b * SEQ + (i0 + 32 * w + ql) * dil + r);
    if (hh == 0) ((float*)(ws_ + WS_LSE))[((size_t)br * M + qtok) * NH + h] = __builtin_amdgcn_logf(ls) + bound;
    asm volatile("s_waitcnt lgkmcnt(0)" ::: "memory");
    bf16_t* obase = (bf16_t*)(ws_ + WS_OB) + (size_t)br * M * DA + h * HD;
#pragma unroll
    for (int i = 0; i < 4; ++i) { const int row = (lane >> 3) + 8 * i, cp = lane & 7;
        const u32x4 d = *(const LAS u32x4*)(Ost + row * 128 + cp * 16);
        const size_t tok = (size_t)(b * SEQ + (i0 + 32 * w + row) * dil + r);
        *(u32x4*)(obase + tok * DA + ((cp ^ (row & 7)) << 3)) = d; }
#if SUBPROBE == 13
    asm volatile("s_waitcnt vmcnt(0)" ::: "memory");
#endif
    SP_END(13);
}

__device__ __forceinline__ float sigm(float x) { return __builtin_amdgcn_rcpf(1.0f + __builtin_amdgcn_exp2f(-x * LOG2E)); }
__device__ __forceinline__ void rnn_agg_unit(const Params& p, LAS unsigned char* lds, int l, int unit) {
    unsigned char* const ws_ = opaque_ptr(p.ws);
    const int tid = opaque_tid(), lane = tid & 63, g = __builtin_amdgcn_readfirstlane(tid >> 6), hh = lane >> 5, ql = lane & 31;
    const int b = unit >> 7, chunk = unit & 127, t0 = chunk * 64;
    const bf16_t* ZB = (const bf16_t*)(ws_ + WS_ZB);
    LAS float* ut = (LAS float*)(lds + g * 17408); LAS float* at = ut + 32 * 68;
    float* AGG = (float*)(ws_ + WS_AGG); unsigned* AD = (unsigned*)(ws_ + WS_AD);
    const int c = g * 64 + lane;
    float hst = 0.f, Ap = 1.f;
    const float* cw = p.in[6] + l * 4 * DR; const float w0 = cw[c], w1 = cw[DR + c], w2 = cw[2 * DR + c], w3 = cw[3 * DR + c], cbv = p.in[7][l * DR + c];
    float bav[2], bxv[2], splv[2];
#pragma unroll
    for (int nb = 0; nb < 2; ++nb) { const int cd = g * 64 + 32 * nb + ql; bav[nb] = p.in[9][l * DR + cd]; bxv[nb] = p.in[11][l * DR + cd]; splv[nb] = ((const float*)(ws_ + WS_SPL))[l * DR + cd]; }
    bf16x8 Wa[2][4], Wx[2][4];
    { const bf16_t* wat = (const bf16_t*)(ws_ + WS_WAT) + (size_t)((l * 2) * 8 + g) * 4096;
#pragma unroll
      for (int nb = 0; nb < 2; ++nb)
#pragma unroll
          for (int ks = 0; ks < 4; ++ks) { const int off = (32 * nb + ql) * 64 + 16 * ks + 8 * hh; Wa[nb][ks] = *(const bf16x8*)(wat + off); Wx[nb][ks] = *(const bf16x8*)(wat + 8 * 4096 + off); } }
    const size_t tokb = (size_t)b * SEQ + t0;
    float xm3 = 0.f, xm2 = 0.f, xm1 = 0.f;
    if (t0 > 0) { xm3 = bf2f(ZB[(tokb - 3) * DIN + 1536 + c]); xm2 = bf2f(ZB[(tokb - 2) * DIN + 1536 + c]); xm1 = bf2f(ZB[(tokb - 1) * DIN + 1536 + c]); }
    __syncthreads();
#pragma unroll 1
    for (int hf = 0; hf < 2; ++hf) {
        const size_t tk0 = tokb + 32 * hf;
        { bf16_t xr_[32];
#pragma unroll
          for (int tt = 0; tt < 32; ++tt) xr_[tt] = ZB[(tk0 + tt) * DIN + 1536 + c];
#pragma unroll
          for (int tt = 0; tt < 32; ++tt) { const float xv = bf2f(xr_[tt]); ut[tt * 68 + lane] = cbv + w0 * xm3 + w1 * xm2 + w2 * xm1 + w3 * xv; xm3 = xm2; xm2 = xm1; xm1 = xv; } }
        asm volatile("s_waitcnt lgkmcnt(0)" ::: "memory");
        bf16x8 Af[4];
#pragma unroll
        for (int ks = 0; ks < 4; ++ks) { const LAS f32x4* s = (const LAS f32x4*)(ut + ql * 68 + 16 * ks + 8 * hh); const f32x4 x0 = s[0], x1 = s[1];
            u32x4 pw; pw.x = cvt_pk_bf16(x0[0], x0[1]); pw.y = cvt_pk_bf16(x0[2], x0[3]); pw.z = cvt_pk_bf16(x1[0], x1[1]); pw.w = cvt_pk_bf16(x1[2], x1[3]); Af[ks] = __builtin_bit_cast(bf16x8, pw); }
        f32x16 Dr[2], Dx[2];
#pragma unroll
        for (int nb = 0; nb < 2; ++nb) { Dr[nb] = (f32x16){0.f, 0.f, 0.f, 0.f, 0.f, 0.f, 0.f, 0.f, 0.f, 0.f, 0.f, 0.f, 0.f, 0.f, 0.f, 0.f}; Dx[nb] = Dr[nb];
#pragma unroll
            for (int ks = 0; ks < 4; ++ks) { Dr[nb] = __builtin_amdgcn_mfma_f32_32x32x16_bf16(Af[ks], Wa[nb][ks], Dr[nb], 0, 0, 0); Dx[nb] = __builtin_amdgcn_mfma_f32_32x32x16_bf16(Af[ks], Wx[nb][ks], Dx[nb], 0, 0, 0); } }
#pragma unroll
        for (int nb = 0; nb < 2; ++nb)
#pragma unroll
            for (int rr = 0; rr < 16; ++rr) { const int row = (rr & 3) + 8 * (rr >> 2) + 4 * hh; const int o = row * 68 + 32 * nb + ql;
                const float rs = sigm(Dr[nb][rr] + bav[nb]), is = sigm(Dx[nb][rr] + bxv[nb]);
                const float a = __builtin_amdgcn_exp2f(-splv[nb] * rs); const float uv = ut[o];
                const unsigned pk = cvt_pk_bf16(1.0f - a, __builtin_amdgcn_sqrtf(fmaxf(1.0f - a * a, 0.f)) * (is * uv));
                AD[(tk0 + row) * DR + g * 64 + 32 * nb + ql] = pk;
                at[o] = 1.0f - bf_lo(pk); ut[o] = bf_hi(pk); }
        asm volatile("s_waitcnt lgkmcnt(0)" ::: "memory");
#pragma unroll 8
        for (int tt = 0; tt < 32; ++tt) { const float a = at[tt * 68 + lane], d = ut[tt * 68 + lane]; hst = a * hst + d; Ap *= a; }
    }
    { float* ag = AGG + (size_t)(b * 128 + chunk) * 1024 + c; ag[0] = Ap; ag[512] = hst; }
}
__device__ __forceinline__ void rnn_final_unit(const Params& p, LAS unsigned char* lds, int l, int unit) {
    unsigned char* const ws_ = opaque_ptr(p.ws);
    const int tid = opaque_tid(), lane = tid & 63, g = __builtin_amdgcn_readfirstlane(tid >> 6), hh = lane >> 5, ql = lane & 31;
    const int b = unit >> 7, chunk = unit & 127, t0 = chunk * 64;
    const bf16_t* ZB = (const bf16_t*)(ws_ + WS_ZB); const unsigned* AD = (const unsigned*)(ws_ + WS_AD);
    LAS float* at = (LAS float*)(lds + g * 17408);
    LAS float* part = (LAS float*)(lds + 139264);
    const float* AGG = (const float*)(ws_ + WS_AGG);
    const int c = g * 64 + lane;
    const size_t tokb = (size_t)b * SEQ + t0;
    unsigned ad0[32]; bf16_t gr0[32];
#pragma unroll
    for (int tt = 0; tt < 32; ++tt) { ad0[tt] = AD[(tokb + tt) * DR + c]; gr0[tt] = ZB[(tokb + tt) * DIN + 2048 + c]; }
    float hst = 0.f;
    {
        LAS float* ex = (LAS float*)lds;
        __syncthreads();
        const float* ag = AGG + (size_t)(b * 128 + 16 * g) * 1024 + 8 * lane;
        int n = chunk - 16 * g; n = n < 0 ? 0 : (n > 16 ? 16 : n);
        float sa[8], sh[8];
#pragma unroll
        for (int j = 0; j < 8; ++j) { sa[j] = 1.0f; sh[j] = 0.f; }
        int cc = 0;
#pragma unroll 1
        for (; cc + 4 <= n; cc += 4) { f32x4 A[4][2], H[4][2];
#pragma unroll
            for (int q = 0; q < 4; ++q) { const float* r = ag + (size_t)(cc + q) * 1024; A[q][0] = *(const f32x4*)r; A[q][1] = *(const f32x4*)(r + 4); H[q][0] = *(const f32x4*)(r + 512); H[q][1] = *(const f32x4*)(r + 516); }
#pragma unroll
            for (int q = 0; q < 4; ++q)
#pragma unroll
                for (int j = 0; j < 8; ++j) { const float av = A[q][j >> 2][j & 3]; sh[j] = av * sh[j] + H[q][j >> 2][j & 3]; sa[j] *= av; } }
#pragma unroll 1
        for (; cc < n; ++cc) { const float* r = ag + (size_t)cc * 1024; const f32x4 A0 = *(const f32x4*)r, A1 = *(const f32x4*)(r + 4), H0 = *(const f32x4*)(r + 512), H1 = *(const f32x4*)(r + 516);
#pragma unroll
            for (int j = 0; j < 8; ++j) { const float av = j < 4 ? A0[j & 3] : A1[j & 3]; sh[j] = av * sh[j] + (j < 4 ? H0[j & 3] : H1[j & 3]); sa[j] *= av; } }
        LAS f32x4* eo = (LAS f32x4*)(ex + (g * 512 + 8 * lane) * 2);
#pragma unroll
        for (int j = 0; j < 4; ++j) eo[j] = (f32x4){sa[2 * j], sh[2 * j], sa[2 * j + 1], sh[2 * j + 1]};
        __syncthreads();
        const int nseg = (chunk + 15) >> 4;
#pragma unroll 1
        for (int s = 0; s < nseg; ++s) { const LAS float* e = ex + (s * 512 + c) * 2; hst = e[0] * hst + e[1]; }
    }
    __syncthreads();
#pragma unroll
    for (int hf = 0; hf < 2; ++hf) {
        const size_t tk0 = tokb + 32 * hf;
        unsigned ad1[32]; bf16_t gr1[32];
        if (hf == 0) {
#pragma unroll
            for (int tt = 0; tt < 32; ++tt) { ad1[tt] = AD[(tokb + 32 + tt) * DR + c]; gr1[tt] = ZB[(tokb + 32 + tt) * DIN + 2048 + c]; } }
#pragma unroll
        for (int tt = 0; tt < 32; ++tt) { const unsigned pk = ad0[tt]; hst = (1.0f - bf_lo(pk)) * hst + bf_hi(pk);
            const float gv = bf2f(gr0[tt]); const float y2 = 1.5957691216057308f * (gv + 0.044715f * gv * gv * gv);
            at[tt * 68 + lane] = hst * gv * sigm(y2); }
        asm volatile("s_waitcnt lgkmcnt(0)" ::: "memory");
        f32x4 ov[8]; float ss = 0.f;
#pragma unroll
        for (int q = 0; q < 8; ++q) { ov[q] = *(const LAS f32x4*)(at + ql * 68 + 32 * hh + 4 * q); ss += (ov[q][0] * ov[q][0] + ov[q][1] * ov[q][1]) + (ov[q][2] * ov[q][2] + ov[q][3] * ov[q][3]); }
        ss += __shfl_xor(ss, 32);
        if (hh == 0) part[(hf * 32 + ql) * 8 + g] = ss;
        __syncthreads();
        const LAS f32x4* pp = (const LAS f32x4*)(part + (hf * 32 + ql) * 8); const f32x4 p0 = pp[0], p1 = pp[1];
        const float rstd = rsqrtf(((p0[0] + p0[1]) + (p0[2] + p0[3]) + (p1[0] + p1[1]) + (p1[2] + p1[3])) * (1.0f / DR) + EPS);
        bf16_t* mo = (bf16_t*)(ws_ + WS_MIX) + (tk0 + ql) * D + DA + g * 64 + 32 * hh;
#pragma unroll
        for (int q = 0; q < 4; ++q) { u32x4 wv; wv.x = cvt_pk_bf16(ov[2 * q][0] * rstd, ov[2 * q][1] * rstd); wv.y = cvt_pk_bf16(ov[2 * q][2] * rstd, ov[2 * q][3] * rstd);
            wv.z = cvt_pk_bf16(ov[2 * q + 1][0] * rstd, ov[2 * q + 1][1] * rstd); wv.w = cvt_pk_bf16(ov[2 * q + 1][2] * rstd, ov[2 * q + 1][3] * rstd); *(u32x4*)(mo + 8 * q) = wv; }
        if (hf == 0) {
#pragma unroll
            for (int tt = 0; tt < 32; ++tt) { ad0[tt] = ad1[tt]; gr0[tt] = gr1[tt]; } }
    }
}

__device__ __forceinline__ void attn_merge_unit(const Params& p, int unit) {
    unsigned char* const ws_ = opaque_ptr(p.ws);
    const int tid = opaque_tid(), lane = tid & 63, w = tid >> 6;
    const bf16_t* OB = (const bf16_t*)(ws_ + WS_OB); const float* LSE = (const float*)(ws_ + WS_LSE);
#pragma unroll 1
    for (int tg = 0; tg < 8; tg += 4) {
        float ls[4][3]; u32x4 ov[4][3];
#pragma unroll
        for (int t4 = 0; t4 < 4; ++t4) { const size_t tok = (size_t)unit * 64 + w * 8 + tg + t4;
#pragma unroll
            for (int br = 0; br < 3; ++br) { ls[t4][br] = LSE[((size_t)br * M + tok) * NH + (lane >> 3)]; ov[t4][br] = *(const u32x4*)(OB + ((size_t)br * M + tok) * DA + 8 * lane); } }
#pragma unroll
        for (int t4 = 0; t4 < 4; ++t4) { const size_t tok = (size_t)unit * 64 + w * 8 + tg + t4;
            const float mx = fmaxf(ls[t4][0], fmaxf(ls[t4][1], ls[t4][2]));
            float wb[3];
#pragma unroll
            for (int br = 0; br < 3; ++br) wb[br] = __builtin_amdgcn_exp2f(ls[t4][br] - mx);
            const float wi = 1.0f / (wb[0] + wb[1] + wb[2]);
            float o[8];
#pragma unroll
            for (int q = 0; q < 4; ++q) { float lo = 0.f, hi = 0.f;
#pragma unroll
                for (int br = 0; br < 3; ++br) { lo += wb[br] * bf_lo(ov[t4][br][q]); hi += wb[br] * bf_hi(ov[t4][br][q]); }
                o[2 * q] = lo * wi; o[2 * q + 1] = hi * wi; }
            float ss = 0.f;
#pragma unroll
            for (int q = 0; q < 8; ++q) ss += o[q] * o[q];
            ss = wave_sum(ss);
            const float rstd = rsqrtf(ss * (1.0f / DA) + EPS);
            u32x4 wv; wv.x = cvt_pk_bf16(o[0] * rstd, o[1] * rstd); wv.y = cvt_pk_bf16(o[2] * rstd, o[3] * rstd); wv.z = cvt_pk_bf16(o[4] * rstd, o[5] * rstd); wv.w = cvt_pk_bf16(o[6] * rstd, o[7] * rstd);
            *(u32x4*)((bf16_t*)(ws_ + WS_MIX) + tok * D + 8 * lane) = wv; }
    }
}
__device__ __forceinline__ void ph_mix1(const Params& p, LAS unsigned char* lds, int l) {
    SP_DECL;
    SP_BEGIN();
    { unsigned char* const ws_ = opaque_ptr(p.ws); const int tid = opaque_tid();
      { LAS float* T = (LAS float*)(lds + 98304); const float* BT = (const float*)(ws_ + WS_BT); const float* BND = (const float*)(ws_ + WS_BND) + l * 24;
        for (int i = tid; i < 24 * 192; i += NTHR) T[i] = BT[i] - BND[i / 192]; }
      AttnPf pf;
      if (gridDim.x == 256) {
          const int xcd = blockIdx.x & 7, rank = blockIdx.x >> 3;
#define ATT_ITEM(k) ((((k) % 3) << 9) + ((2 * xcd + (k) / 3) << 5) + rank)
          attn_issue((const bf16_t*)(ws_ + WS_ZB), ATT_ITEM(0), tid, pf, 7);
#pragma unroll 1
          for (int k = 0; k < 6; ++k) attn_item(p, lds, l, ATT_ITEM(k), pf, k < 5 ? ATT_ITEM(k + 1) : -1);
#undef ATT_ITEM
      } else {
          int it = blockIdx.x;
          if (it < 1536) attn_issue((const bf16_t*)(ws_ + WS_ZB), it, tid, pf, 7);
          for (; it < 1536; it += gridDim.x) { const int nx = it + (int)gridDim.x; attn_item(p, lds, l, it, pf, nx < 1536 ? nx : -1); }
      } }
    SP_SYNC(); SP_END(1); SP_BEGIN();
    for (int u = blockIdx.x; u < 256; u += gridDim.x) rnn_agg_unit(p, lds, l, xcd_unit(u));
    SP_SYNC(); SP_END(2);
    if (l == 0) convert_queue(p, lds, l, false);
}
__device__ __forceinline__ void ph_mix2(const Params& p, LAS unsigned char* lds, int l) {
    SP_DECL;
    for (int u = blockIdx.x; u < 256; u += gridDim.x) { SP_BEGIN(); rnn_final_unit(p, lds, l, xcd_unit(u)); SP_SYNC(); SP_END(6); SP_BEGIN(); attn_merge_unit(p, xcd_unit(u)); SP_SYNC(); SP_END(7); }
}
#define DYN_LDS extern __shared__ __attribute__((aligned(16))) unsigned char smem_[]; LAS unsigned char* lds = (LAS unsigned char*)smem_

#define XB_TMO      128
#define XB_XCNT(j)  (256  + 64 * (j))
#define XB_XSUB(j)  (1280 + 64 * (j))
#define XB_XGEN(j)  (2304 + 64 * (j))
#define XB_TOP      3328
#define XB_TOPGEN   3392
#define XCD_BAR_WORDS 3456
#define XB_SPIN_CAP (1u << 18)
__device__ __forceinline__ unsigned xb_ld(unsigned* p)              { return __hip_atomic_load(p, __ATOMIC_RELAXED, __HIP_MEMORY_SCOPE_AGENT); }
__device__ __forceinline__ unsigned xb_add(unsigned* p, unsigned v) { return __hip_atomic_fetch_add(p, v, __ATOMIC_RELAXED, __HIP_MEMORY_SCOPE_AGENT); }
__device__ __forceinline__ unsigned xb_xcc_id() { return (unsigned)__builtin_amdgcn_s_getreg((3 << 11) | 20) & 0xFu; }
#define XB_SPIN(cond, bar) do { unsigned _sp = 0; while (cond) { __builtin_amdgcn_s_sleep(1); \
    if ((++_sp & 255u) == 0u) { if (xb_ld(&(bar)[XB_TMO])) break; if (_sp > XB_SPIN_CAP) { atomicAdd(&(bar)[XB_TMO], 1u); break; } } } } while (0)
struct XcdBarrier { unsigned* bar; unsigned x; volatile LAS unsigned* st; };
__device__ __forceinline__ XcdBarrier xcd_barrier_post(unsigned* bar, volatile LAS unsigned* st) {
    XcdBarrier b; b.bar = bar; b.x = xb_xcc_id(); b.st = st;
    if (threadIdx.x == 0) (void)xb_add(&bar[XB_XCNT(b.x)], 1u);
    return b;
}
__device__ __forceinline__ void xcd_barrier_complete(unsigned* bar, unsigned x, unsigned& nloc, unsigned& nx, unsigned& stdc) {
    const unsigned G = gridDim.x * gridDim.y * gridDim.z;
    unsigned sum, cnt, mine, sd, sp = 0u;
    for (;;) {
        sum = 0u; cnt = 0u; mine = 0u; sd = 1u;
#pragma unroll
        for (unsigned j = 0; j < 16; ++j) { const unsigned c = xb_ld(&bar[XB_XCNT(j)]); sum += c; cnt += (c > 0u) ? 1u : 0u; mine = (j == x) ? c : mine; sd = (c == (j < 8u ? 32u : 0u)) ? sd : 0u; }
        if (sum == G) break;
        __builtin_amdgcn_s_sleep(1);
        if ((++sp & 255u) == 0u) { if (xb_ld(&bar[XB_TMO])) break; if (sp > XB_SPIN_CAP) { atomicAdd(&bar[XB_TMO], 1u); break; } }
    }
    nloc = mine > 0u ? mine : 1u; nx = cnt > 0u ? cnt : 1u; stdc = sd;
}
__device__ __forceinline__ void xcd_barrier(const XcdBarrier& b, const Params& p, int item_base, int dense_first = 0, int dense_lim = 0) {
    asm volatile("s_waitcnt vmcnt(0)" ::: "memory");
    __syncthreads();
    const int tid = opaque_tid();
    unsigned* bar = b.bar; unsigned old = 0u, gen = 0u, tg = 0u; bool last = false, fin = false;
    const unsigned bx = xb_xcc_id();
    if (tid == 0) {
        size_t zb_ = 0; asm volatile("" : "+s"(zb_)); bar = b.bar + zb_;
        __builtin_amdgcn_s_waitcnt(0);
        unsigned nloc = b.st[0], nx = b.st[1];
        if (nloc == 0u) { unsigned sd; xcd_barrier_complete(bar, bx, nloc, nx, sd); b.st[0] = nloc; b.st[1] = nx; b.st[2] = sd; }
        old = xb_add(&bar[XB_XSUB(bx)], 1u);
        gen = old / nloc;
        last = old + 1u == (gen + 1u) * nloc;
        b.st[3] = b.st[2] ? old - gen * nloc : 0xffffu;
        if (last) {
            __builtin_amdgcn_fence(__ATOMIC_RELEASE, "agent");
            asm volatile("s_waitcnt vmcnt(0)" ::: "memory");
            const unsigned og = xb_add(&bar[XB_TOP], 1u);
            tg = og / nx;
            fin = og + 1u == (tg + 1u) * nx;
            if (fin) xb_add(&bar[XB_TOPGEN], 1u);
        }
    }
    if (item_base >= 0) {
        __syncthreads();
        const unsigned rank = b.st[3];
        if (rank < (unsigned)SLOT_RANKS) {
            unsigned char* const ws_ = opaque_ptr(p.ws);
            const int lane = tid & 63, wave = tid >> 6;
#if SLOT_NPW == 2
            const int it = item_base + ((int)(bx * SLOT_RANKS + rank) * NWAVE + wave) * 2;
            TrItem ta, tb; dec_exp(p, ws_, it, ta); dec_exp(p, ws_, it + 1, tb);
            f32x4 va[8], vb[8]; float ga[8], gb[8];
            tr_load(ta, lane, va, ga); tr_load(tb, lane, vb, gb);
            tr_store8(ta, lane, va, ga, nullptr); tr_store8(tb, lane, vb, gb, nullptr);
#else
            TrItem t; dec_exp(p, ws_, item_base + ((int)(bx * SLOT_RANKS + rank) * NWAVE + wave), t);
            f32x4 v[8]; float g[8];
            tr_load(t, lane, v, g); tr_store8(t, lane, v, g, nullptr);
#endif
            { const int di = dense_first + ((int)(bx * SLOT_RANKS + rank) * NWAVE + wave);
              if (di < dense_lim) { TrItem t; dec_dense(p, ws_, di, t); f32x4 v[8]; float g[8]; tr_load(t, lane, v, g); tr_store(t, lane, v, g, nullptr); } }
        }
    }
    if (tid == 0) {
        if (last) {
            if (!fin) XB_SPIN(xb_ld(&bar[XB_TOPGEN]) == tg, bar);
            __builtin_amdgcn_fence(__ATOMIC_ACQUIRE, "agent");
            xb_add(&bar[XB_XGEN(bx)], 1u);
            asm volatile("s_waitcnt vmcnt(0)" ::: "memory");
        } else {
            XB_SPIN(xb_ld(&bar[XB_XGEN(bx)]) == gen, bar);
            __builtin_amdgcn_fence(__ATOMIC_ACQUIRE, "agent");
            asm volatile("s_waitcnt vmcnt(0)" ::: "memory");
        }
    }
    __syncthreads();
}

__global__ void __launch_bounds__(512, 2) k_fused(Params p) {
    DYN_LDS;
    if (threadIdx.x < 64) ((LAS unsigned*)(lds + LDS_MISC))[threadIdx.x] = 0u;
    __syncthreads();
    XcdBarrier bar = xcd_barrier_post((unsigned*)(p.ws + WS_CTL), (volatile LAS unsigned*)(lds + LDS_MISC));
    const float* x_in = p.in[0]; float* X = p.out;
    const int* counts = (const int*)(p.ws + WS_CNT);
#ifndef PROBE_MASK
#define PROBE_MASK 0
#endif
#ifndef BARPROBE
#define BARPROBE 0
#endif
#if BARPROBE
#define BAR(id, ...) do { const unsigned long long tb_ = __builtin_amdgcn_s_memrealtime(); xcd_barrier(bar, p, __VA_ARGS__); if (BARPROBE == (id)) bacc += __builtin_amdgcn_s_memrealtime() - tb_; } while (0)
#else
#define BAR(id, ...) xcd_barrier(bar, p, __VA_ARGS__)
#endif
#if PROBE_MASK
    unsigned long long tacc = 0, tp = 0;
#define PH_BEGIN() tp = __builtin_amdgcn_s_memrealtime()
#define PH_END(g) do { if (PROBE_MASK & (1 << (g))) tacc += __builtin_amdgcn_s_memrealtime() - tp; } while (0)
#else
#define PH_BEGIN() do {} while (0)
#define PH_END(g) do {} while (0)
#endif
#if BARPROBE
    unsigned long long bacc = 0;
#endif
    PH_BEGIN();
    ph_prologue(p, lds, 3);
    ph_norm(p, lds, x_in, X, 0, nullptr, true, -1);
    BAR(0, 3 * SLOT_ITEMS); PH_END(0);
    for (int l = 0; l < DEPTH; ++l) {
        const int cur = l * CONV_ITEMS, nxt = l + 1 < DEPTH ? (l + 1) * CONV_ITEMS : -(1 << 28);
        const int dn = l + 1 < DEPTH ? (l + 1) * PER_L : 0, dl = l + 1 < DEPTH ? dn + PER_L : 0;
        PH_BEGIN(); ph_win(p, lds, l);                               BAR(1, cur + 4 * SLOT_ITEMS, dn, dl); PH_END(1);
        PH_BEGIN(); ph_mix1(p, lds, l);                              BAR(2, cur + 5 * SLOT_ITEMS, dn + DSLOT, dl); PH_END(2);
        PH_BEGIN(); ph_mix2(p, lds, l);                              BAR(3, cur + 6 * SLOT_ITEMS); PH_END(3);
        PH_BEGIN(); ph_wout(p, lds, l, l == 0 ? x_in : X, X);        BAR(4, cur + 7 * SLOT_ITEMS); PH_END(1);
        PH_BEGIN(); ph_router(p, lds, l, X);                         BAR(5, nxt + 0 * SLOT_ITEMS); PH_END(4);
        PH_BEGIN(); ph_gateup(p, lds, l);                            BAR(6, nxt + 1 * SLOT_ITEMS); PH_END(5);
        PH_BEGIN(); ph_down(p, lds, l);                              BAR(7, nxt + 2 * SLOT_ITEMS); PH_END(5);
        PH_BEGIN(); ph_norm(p, lds, X, X, 1, counts + l * NE * CNT_STRIDE, l < DEPTH - 1, -1);
        if (l < DEPTH - 1) BAR(8, nxt + 3 * SLOT_ITEMS);
        PH_END(6);
    }
#if PROBE_MASK
    { const unsigned long long t0 = __builtin_amdgcn_s_memrealtime(); while (__builtin_amdgcn_s_memrealtime() - t0 < tacc) __builtin_amdgcn_s_sleep(8); }
#endif
#if BARPROBE
    { const unsigned long long t0 = __builtin_amdgcn_s_memrealtime(); while (__builtin_amdgcn_s_memrealtime() - t0 < bacc) __builtin_amdgcn_s_sleep(8); }
#endif
#if SUBPROBE
    { __syncthreads(); const unsigned long long tw = *(volatile LAS unsigned*)(lds + LDS_MISC + 64); const unsigned long long t0 = __builtin_amdgcn_s_memrealtime(); while (__builtin_amdgcn_s_memrealtime() - t0 < tw) __builtin_amdgcn_s_sleep(8); }
#endif
}
}

extern "C" void kernel_launch(void* const* d_in, const int* in_sizes, int n_in, void* d_out, int out_size, void* d_ws, size_t ws_size, hipStream_t stream) {
    static int grid = 0;
    if (!grid) {
        (void)hipFuncSetAttribute((const void*)k_fused, hipFuncAttributeMaxDynamicSharedMemorySize, LDS_BYTES);
        int dev = 0, cus = 0, per_cu = 0;
        (void)hipGetDevice(&dev); (void)hipDeviceGetAttribute(&cus, hipDeviceAttributeMultiprocessorCount, dev);
        (void)hipOccupancyMaxActiveBlocksPerMultiprocessor(&per_cu, (const void*)k_fused, 512, LDS_BYTES);
        if (per_cu < 1) fprintf(stderr, "kernel_launch: occupancy query reports %d blocks per CU\n", per_cu);
        (void)hipGetLastError();
        grid = cus > 0 ? cus : 256;
        if (ws_size < WS_END) fprintf(stderr, "kernel_launch: ws_size %zu smaller than expected\n", ws_size);
    }
    Params p{}; for (int i = 0; i < 24; ++i) p.in[i] = (const float*)d_in[i]; p.out = (float*)d_out; p.ws = (unsigned char*)d_ws;
    (void)hipMemsetAsync((unsigned char*)d_ws + WS_CTL, 0, CTL_ZERO, stream);
    k_fused<<<grid, 512, LDS_BYTES, stream>>>(p);
}
```

```cpp
#include <hip/hip_runtime.h>
#include <cstdio>
#include <cstdint>
#include <cmath>

namespace {
constexpr int BATCH = 2, SEQ = 8192, M = BATCH * SEQ, D = 1024, DEPTH = 4;
constexpr int NH = 8, HD = 64, DA = 512, DR = 512, DIN = 2560;
constexpr int NE = 32, EPG = 8, NG = 4, DE = 512;
constexpr float EPS = 1e-6f;

__device__ __forceinline__ float wave_sum(float v) {
#pragma unroll
    for (int o = 1; o < 64; o <<= 1) v += __shfl_xor(v, o);
    return v;
}

#define LAS __attribute__((address_space(3)))
typedef unsigned short bf16_t;
typedef short bf16x8 __attribute__((ext_vector_type(8)));
typedef short s16x4 __attribute__((ext_vector_type(4)));
typedef float f32x4 __attribute__((ext_vector_type(4)));
typedef float f32x16 __attribute__((ext_vector_type(16)));
typedef unsigned u32x4 __attribute__((ext_vector_type(4)));
typedef unsigned u32x2 __attribute__((ext_vector_type(2)));
__device__ __forceinline__ unsigned cvt_pk_bf16(float lo, float hi) { unsigned r; asm volatile("v_cvt_pk_bf16_f32 %0, %1, %2" : "=v"(r) : "v"(lo), "v"(hi)); return r; }
__device__ __forceinline__ float bf_lo(unsigned w) { return __uint_as_float(w << 16); }
__device__ __forceinline__ float bf_hi(unsigned w) { return __uint_as_float(w & 0xffff0000u); }
__device__ __forceinline__ float bf2f(bf16_t v) { return __uint_as_float(((unsigned)v) << 16); }

__device__ __forceinline__ int opaque_tid() { int t = threadIdx.x; asm volatile("" : "+v"(t)); return t; }
__device__ __forceinline__ unsigned char* opaque_ptr(unsigned char* w) { size_t z = 0; asm volatile("" : "+s"(z)); return w + z; }
__device__ __forceinline__ int opaque_bid() { int b = blockIdx.x; asm volatile("" : "+s"(b)); return b; }
__device__ __forceinline__ int xcd_unit(int c) { return gridDim.x == 256 ? 32 * (c & 7) + (c >> 3) : c; }
constexpr float LOG2E = 1.4426950408889634f;
constexpr size_t MiB = 1ull << 20;
constexpr size_t WS_CTL = 0, CTL_ZERO = 128 * 1024;
constexpr size_t WS_TCNT = 16 * 1024;
constexpr size_t WS_CONV = 60 * 1024;
constexpr size_t WS_CNT = 64 * 1024;
constexpr int CNT_STRIDE = 64;
constexpr size_t WS_BT = 1 * MiB;
constexpr size_t WS_BND = 1 * MiB + 32 * 1024;
constexpr size_t WS_GQK = 1 * MiB + 64 * 1024;
constexpr size_t WS_SPL = 1 * MiB + 128 * 1024;
constexpr size_t WS_RTT = 2 * MiB;
constexpr size_t WS_WAT = 3 * MiB;
constexpr size_t WS_WIN = 4 * MiB;
constexpr size_t WS_WOUT = 24 * MiB;
constexpr size_t WS_WGU = 32 * MiB;
constexpr size_t WS_WD = 288 * MiB;
constexpr size_t WS_HN = 416 * MiB;
constexpr size_t WS_ZB = 448 * MiB;
constexpr size_t WS_OB = 528 * MiB;
constexpr size_t WS_LSE = 576 * MiB;
constexpr size_t WS_AGG = 578 * MiB;
constexpr size_t WS_MIX = 580 * MiB;
constexpr size_t WS_TOK = 612 * MiB;
constexpr size_t WS_LIST = 613 * MiB;
constexpr size_t WS_ACT = 616 * MiB;
constexpr size_t WS_Y = 656 * MiB;
constexpr size_t WS_AD = 736 * MiB;
constexpr size_t WS_XB = 768 * MiB;
constexpr size_t WS_END = 800 * MiB;
constexpr int MAXTILES = 160;
constexpr int LDS_BYTES = 160 * 1024;
constexpr int LDS_STAGE = 0;
constexpr int LDS_TAB = 131072;
constexpr int LDS_MISC = LDS_BYTES - 256;

#ifndef SUBPROBE
#define SUBPROBE 0
#endif
#if SUBPROBE
#define SP_DECL unsigned long long sp_t0_ = 0
#define SP_BEGIN() sp_t0_ = __builtin_amdgcn_s_memrealtime()
#define SP_SYNC() __syncthreads()
#define SP_END(id) do { if (SUBPROBE == (id) && threadIdx.x == 0) { volatile LAS unsigned* w_ = (volatile LAS unsigned*)(lds + LDS_MISC + 64); *w_ = *w_ + (unsigned)(__builtin_amdgcn_s_memrealtime() - sp_t0_); } } while (0)
#else
#define SP_DECL do {} while (0)
#define SP_SYNC() do {} while (0)
#define SP_BEGIN() do {} while (0)
#define SP_END(id) do {} while (0)
#endif
namespace pg8 {
constexpr int BM = 256, BK = 64, HALF = 128, HTB = HALF * BK * 2, STAGE_BYTES = 8 * HTB, NXCD = 8, WGM = 8;
__host__ __device__ __forceinline__ int lds_byte(int r, int c) { const int st = (r >> 4) * 2 + (c >> 5), rr = r & 15, cc = c & 31, ob = rr * 64 + cc * 2; return st * 1024 + (ob ^ (((ob >> 9) & 1) << 5)); }
__host__ __device__ __forceinline__ void stage_rc(int b, int& R, int& C) { const int st = b / 1024, sb = b % 1024, swz = sb ^ (((sb >> 9) & 1) << 5); R = (st >> 1) * 16 + swz / 64; C = (st & 1) * 32 + (swz % 64) / 2; }
__host__ __device__ __forceinline__ int perm32(int rho) { const int n = rho >> 4, i = rho & 15; return 8 * (i >> 2) + 4 * n + (i & 3); }

struct Unit { int pm, pn; const char* a; const char* b; const int* glist; int gcount; };

struct StaticOrder {
    int nM, nN, nwg, G, c; const char* A; const char* Bt; size_t tA, tB;
    __device__ void init(const bf16_t* A_, const bf16_t* Bt_, int M_, int N_, int K_, int G_, int c_) { nM = M_ / BM; nN = N_ / BM; nwg = nM * nN; G = G_; c = c_; A = (const char*)A_; Bt = (const char*)Bt_; tA = (size_t)BM * K_ * 2; tB = tA; }
    __device__ bool next(int i, Unit& u) const {
        const long L = (long)i * G + c; if (L >= nwg) return false;
        int wgid = (int)L; { const int q = nwg / NXCD, r = nwg % NXCD, xcd = wgid % NXCD, off = wgid / NXCD; wgid = (xcd < r ? xcd * (q + 1) : r * (q + 1) + (xcd - r) * q) + off; }
        const int nig = WGM * nN, gid = wgid / nig, fm = gid * WGM, gsz = (nM - fm) < WGM ? (nM - fm) : WGM;
        u.pm = fm + ((wgid % nig) % gsz); u.pn = (wgid % nig) / gsz; u.a = A + (size_t)u.pm * tA; u.b = Bt + (size_t)u.pn * tB; u.glist = nullptr; u.gcount = 0; return true;
    }    __device__ __forceinline__ void a_ready(const Unit&, int) const {}
    __device__ __forceinline__ void done(const Unit&, int) const {}
};
struct MoeOrder {
    int G, c, ntiles; const LAS int* tile_e; const LAS int* tile_r0; const LAS int* cnt;
    const char* A; size_t tA; const char* W; size_t estride, tB; const int* list; int Mrows;
    __device__ bool next(int i, Unit& u) const {
        const int L = i * G + c; if (L >= ntiles * 4) return false;
        const int gt = L >> 2, e = __builtin_amdgcn_readfirstlane(tile_e[gt]), r0 = __builtin_amdgcn_readfirstlane(tile_r0[gt]);
        u.pm = gt; u.pn = L & 3; u.a = A + (size_t)gt * tA; u.b = W + (size_t)e * estride + (size_t)u.pn * tB;
        u.glist = list + (size_t)e * Mrows + r0; u.gcount = __builtin_amdgcn_readfirstlane(cnt[e]) - r0; return true;
    }
    unsigned* pub; unsigned* wait; unsigned need; unsigned* tmo;
    __device__ __forceinline__ void done(const Unit& u, int lane) const {
        if (pub) { asm volatile("s_waitcnt vmcnt(0)" ::: "memory");
            if (lane == 0) __hip_atomic_fetch_add(pub + 16 * u.pm, 1u, __ATOMIC_RELAXED, __HIP_MEMORY_SCOPE_AGENT); }
    }
    __device__ __forceinline__ void a_ready(const Unit& u, int tid) const {
        if (!wait) return;
        if (tid < 64) {
            const unsigned long long t0 = __builtin_amdgcn_s_memrealtime(); unsigned polls = 0;
            while ((unsigned)__builtin_amdgcn_readfirstlane(__hip_atomic_load(wait + 16 * u.pm, __ATOMIC_RELAXED, __HIP_MEMORY_SCOPE_AGENT)) < need) {
                if ((++polls & 255u) == 0u && __builtin_amdgcn_readfirstlane(__hip_atomic_load(tmo, __ATOMIC_RELAXED, __HIP_MEMORY_SCOPE_AGENT)) != 0u) break;
                if (__builtin_amdgcn_s_memrealtime() - t0 > 2000000ull) { if (tid == 0) __hip_atomic_store(tmo, 1u, __ATOMIC_RELAXED, __HIP_MEMORY_SCOPE_AGENT); break; }
                __builtin_amdgcn_s_sleep(2); }
            __builtin_amdgcn_fence(__ATOMIC_ACQUIRE, "agent");
            asm volatile("s_waitcnt vmcnt(0)" ::: "memory");
        }
        asm volatile("" ::: "memory"); __builtin_amdgcn_s_barrier(); asm volatile("" ::: "memory");
    }
};

typedef int i32x8 __attribute__((ext_vector_type(8)));
typedef int i32x4 __attribute__((ext_vector_type(4)));
template <class Epi, class Sched, bool GATHER, bool FP8 = false, int SCW = 0x7f7f7f7f, int SCX = 0x7f7f7f7f, bool IDENT = false, int KSH = 0  >
__device__ __forceinline__ void gemm_phase(LAS unsigned char* lds, const void* Abase, int KB, const Sched& S, const Epi& E) {
    const int tid = opaque_tid(), wid = __builtin_amdgcn_readfirstlane(tid >> 6), lane = tid & 63, wr = wid >> 2, wc = wid & 3, fr = lane & 15, fq = lane >> 4;
    asm volatile("" : "+s"(KB));
    const int nt = KB / 128;
    const size_t kstep = (size_t)(BK * 2);
    const unsigned hstep = (unsigned)HALF * KB;
    unsigned voffB[2]; int RA[2], CA[2];
#pragma unroll
    for (int i = 0; i < 2; ++i) { int R, C; stage_rc(tid * 16 + i * 8192, R, C); const int Rb = Epi::PERM ? ((R & ~31) + perm32(R & 31)) : R;
        RA[i] = R; CA[i] = C; voffB[i] = (unsigned)(Rb * KB + C * 2); }
    const unsigned ldsw = (unsigned)wid * 1024u;
    const int aoff = lds_byte(wr * 64 + fr, fq * 8), boff = lds_byte(wc * 32 + fr, fq * 8);
#define PG8_SA(b, h) (((b) * 2 + (h)) * HTB)
#define PG8_SB(b, h) ((4 + (b) * 2 + (h)) * HTB)
#define PG8_GLDS(src, dstoff) __builtin_amdgcn_global_load_lds((const unsigned*)(src), (LAS unsigned*)(lds + (dstoff)), 16, 0, 0)
#define PG8_STAGE_B(bufoff, gbase, h) do { _Pragma("unroll") for (int _i = 0; _i < 2; ++_i) PG8_GLDS((const char*)(gbase) + (size_t)((h) * hstep) + voffB[_i], (bufoff) + ldsw + _i * 8192); } while (0)
#define PG8_STAGE_A(bufoff, gbase, h) do { _Pragma("unroll") for (int _i = 0; _i < 2; ++_i) { \
        if constexpr (GATHER) PG8_GLDS((const char*)(gbase) + oc[h][_i], (bufoff) + ldsw + _i * 8192); \
        else PG8_GLDS((const char*)(gbase) + (size_t)((h) * hstep) + oc[0][_i], (bufoff) + ldsw + _i * 8192); } } while (0)
#define PG8_LDA(dst, b, h) do { _Pragma("unroll") for (int m = 0; m < 4; ++m) _Pragma("unroll") for (int k = 0; k < 2; ++k) dst[m][k] = *(const LAS bf16x8*)(lds + PG8_SA(b, h) + aoff + m * 2048 + k * 1024); } while (0)
#define PG8_LDB(dst, b, h) do { _Pragma("unroll") for (int n = 0; n < 2; ++n) _Pragma("unroll") for (int k = 0; k < 2; ++k) dst[n][k] = *(const LAS bf16x8*)(lds + PG8_SB(b, h) + boff + n * 2048 + k * 1024); } while (0)
#define PG8_CAT(x) __builtin_shufflevector(__builtin_bit_cast(i32x4, (x)[0]), __builtin_bit_cast(i32x4, (x)[1]), 0, 1, 2, 3, 4, 5, 6, 7)
#define PG8_MMA(ai, bj, At, Bt) do { if ((ai) == 1 ? skipB : skipA) break; __builtin_amdgcn_s_setprio(1); \
        if constexpr (FP8) { _Pragma("unroll") for (int m = 0; m < 4; ++m) _Pragma("unroll") for (int n = 0; n < 2; ++n) \
            acc[ai][bj][m][n] = __builtin_amdgcn_mfma_scale_f32_16x16x128_f8f6f4(PG8_CAT(Bt[n]), PG8_CAT(At[m]), acc[ai][bj][m][n], 0, 0, 0, SCW, 0, SCX); } \
        else { _Pragma("unroll") for (int m = 0; m < 4; ++m) _Pragma("unroll") for (int n = 0; n < 2; ++n) _Pragma("unroll") for (int k = 0; k < 2; ++k) \
            acc[ai][bj][m][n] = __builtin_amdgcn_mfma_f32_16x16x32_bf16(Bt[n][k], At[m][k], acc[ai][bj][m][n], 0, 0, 0); } \
        __builtin_amdgcn_s_setprio(0); } while (0)
#define PG8_WAIT_V(n) asm volatile("s_waitcnt vmcnt(" #n ")" ::: "memory")
#define PG8_WAIT_L(n) asm volatile("s_waitcnt lgkmcnt(" #n ")" ::: "memory")
#define PG8_BAR __builtin_amdgcn_s_barrier()
#define PG8_SCHED __builtin_amdgcn_sched_barrier(0)
#define PG8_AOFF(dst, u) do { if constexpr (GATHER) { _Pragma("unroll") for (int _h = 0; _h < 2; ++_h) _Pragma("unroll") for (int _i = 0; _i < 2; ++_i) { \
            const int _r = _h * HALF + RA[_i]; const int _t = IDENT ? ((u).pm * BM + _r) : ((_r < (u).gcount) ? (u).glist[_r] : 0); dst[_h][_i] = ((unsigned)_t << KSH) + (unsigned)(CA[_i] * 2); } \
            asm volatile("" : "+v"(dst[0][0]), "+v"(dst[0][1]), "+v"(dst[1][0]), "+v"(dst[1][1])); } \
        else { _Pragma("unroll") for (int _h = 0; _h < 2; ++_h) _Pragma("unroll") for (int _i = 0; _i < 2; ++_i) dst[_h][_i] = (unsigned)(RA[_i] * KB + CA[_i] * 2); } } while (0)
    Unit cur, nxt; int ui = 0;
    if (!S.next(0, cur)) return;
    f32x4 acc[2][2][4][2];
#pragma unroll
    for (int a = 0; a < 2; ++a)
#pragma unroll
        for (int b = 0; b < 2; ++b)
#pragma unroll
            for (int m = 0; m < 4; ++m)
#pragma unroll
                for (int n = 0; n < 2; ++n) acc[a][b][m][n] = (f32x4){0.f, 0.f, 0.f, 0.f};
    bf16x8 At[4][2], B0[2][2], B1[2][2];
    unsigned oc[2][2], on[2][2];
    bool skipB = GATHER && cur.gcount <= 128, skipA = GATHER && cur.gcount <= 64 && wr == 1;
    S.a_ready(cur, tid);
    PG8_AOFF(oc, cur);
    const char* cA = GATHER ? (const char*)Abase : cur.a; const char* cB = cur.b;
    PG8_STAGE_B(PG8_SB(0, 0), cB, 0); PG8_STAGE_B(PG8_SB(0, 1), cB, 1); PG8_STAGE_A(PG8_SA(0, 0), cA, 0); PG8_STAGE_A(PG8_SA(0, 1), cA, 1);
    if (wr == 1) PG8_BAR;
    PG8_WAIT_V(2); PG8_BAR;
    PG8_STAGE_B(PG8_SB(1, 0), cB + kstep, 0); PG8_STAGE_A(PG8_SA(1, 0), cA + kstep, 0); PG8_STAGE_B(PG8_SB(1, 1), cB + kstep, 1);
    PG8_WAIT_V(6); PG8_BAR;
    for (;;) {
        const bool has_next = S.next(ui + 1, nxt);
        const char* nA; const char* nB;
        if (has_next) { nA = GATHER ? (const char*)Abase : nxt.a; nB = nxt.b; if constexpr (GATHER) PG8_AOFF(on, nxt); }
        else { nA = cA; nB = cB;
            if constexpr (GATHER) {
#pragma unroll
                for (int h = 0; h < 2; ++h)
#pragma unroll
                    for (int i = 0; i < 2; ++i) on[h][i] = oc[h][i]; } }
#pragma unroll 1
        for (int t = 0; t < nt; t += 2) {
            const bool last = (t == nt - 2);
            if (last && has_next) S.a_ready(nxt, tid);
            const char* a1 = cA + (size_t)(t + 1) * kstep;
            const char* a2 = last ? nA : cA + (size_t)(t + 2) * kstep; const char* b2 = last ? nB : cB + (size_t)(t + 2) * kstep;
            const char* a3 = a2 + kstep; const char* b3 = b2 + kstep;
            PG8_LDB(B0, 0, 0); PG8_LDB(B1, 0, 1); PG8_SCHED; PG8_LDA(At, 0, 0); PG8_STAGE_A(PG8_SA(1, 1), a1, 1);
            if constexpr (GATHER) { if (last) {
#pragma unroll
                for (int h = 0; h < 2; ++h)
#pragma unroll
                    for (int i = 0; i < 2; ++i) oc[h][i] = on[h][i]; } }
            PG8_WAIT_V(8); PG8_WAIT_L(0); PG8_BAR; PG8_MMA(0, 0, At, B0); PG8_MMA(0, 1, At, B1); PG8_BAR; PG8_SCHED;
            PG8_LDA(At, 0, 1); PG8_STAGE_B(PG8_SB(0, 0), b2, 0); PG8_STAGE_B(PG8_SB(0, 1), b2, 1); PG8_STAGE_A(PG8_SA(0, 0), a2, 0);
            PG8_WAIT_V(8); PG8_WAIT_L(0); PG8_BAR; PG8_MMA(1, 0, At, B0); PG8_MMA(1, 1, At, B1); PG8_BAR; PG8_SCHED;
            PG8_LDB(B0, 1, 0); PG8_LDB(B1, 1, 1); PG8_SCHED; PG8_LDA(At, 1, 0); PG8_STAGE_A(PG8_SA(0, 1), a2, 1);
            PG8_WAIT_V(8); PG8_WAIT_L(0); PG8_BAR; PG8_MMA(0, 0, At, B0); PG8_MMA(0, 1, At, B1); PG8_BAR; PG8_SCHED;
            PG8_LDA(At, 1, 1); PG8_STAGE_B(PG8_SB(1, 0), b3, 0); PG8_STAGE_B(PG8_SB(1, 1), b3, 1); PG8_STAGE_A(PG8_SA(1, 0), a3, 0);
            PG8_WAIT_V(8); PG8_WAIT_L(0); PG8_BAR; PG8_MMA(1, 0, At, B0); PG8_MMA(1, 1, At, B1); PG8_BAR; PG8_SCHED;
        }
        if (wr == 0) PG8_BAR;
        E(acc, cur, wr, wc, fr, fq); S.done(cur, lane);
        if (!has_next) break;
#pragma unroll
        for (int a = 0; a < 2; ++a)
#pragma unroll
            for (int b = 0; b < 2; ++b)
#pragma unroll
                for (int m = 0; m < 4; ++m)
#pragma unroll
                    for (int n = 0; n < 2; ++n) acc[a][b][m][n] = (f32x4){0.f, 0.f, 0.f, 0.f};
        cur = nxt; cA = nA; cB = nB; ++ui;
        skipB = GATHER && cur.gcount <= 128; skipA = GATHER && cur.gcount <= 64 && wr == 1;
        if (wr == 1) PG8_BAR;
    }
    PG8_WAIT_V(0);
    PG8_BAR;
#undef PG8_SA
#undef PG8_SB
#undef PG8_STAGE_A
#undef PG8_STAGE_B
#undef PG8_GLDS
#undef PG8_LDA
#undef PG8_LDB
#undef PG8_MMA
#undef PG8_CAT
#undef PG8_WAIT_V
#undef PG8_WAIT_L
#undef PG8_BAR
#undef PG8_SCHED
#undef PG8_AOFF
}


struct EpiQKV {
    static constexpr bool PERM = true;
    bf16_t* ZB; const LAS float* gqk;
    __device__ __forceinline__ void operator()(const f32x4 (&acc)[2][2][4][2], const Unit& u, int wr, int wc, int fr, int fq) const {
        const int type = u.pn >> 1;
        f32x4 g[2][2];
        if (type == 0) {
#pragma unroll
            for (int bj = 0; bj < 2; ++bj)
#pragma unroll
                for (int n = 0; n < 2; ++n) g[bj][n] = *(const LAS f32x4*)(gqk + 32 * bj + 8 * fq + 4 * n);
        }
#pragma unroll
        for (int ai = 0; ai < 2; ++ai)
#pragma unroll
            for (int m = 0; m < 4; ++m) {
                const int row = u.pm * BM + ai * HALF + wr * 64 + m * 16 + fr;
                f32x4 v[2][2];
#pragma unroll
                for (int bj = 0; bj < 2; ++bj)
#pragma unroll
                    for (int n = 0; n < 2; ++n) v[bj][n] = acc[ai][bj][m][n];
                if (type < 2) {
                    float ss = 0.f;
#pragma unroll
                    for (int bj = 0; bj < 2; ++bj)
#pragma unroll
                        for (int n = 0; n < 2; ++n) ss += (v[bj][n][0] * v[bj][n][0] + v[bj][n][1] * v[bj][n][1]) + (v[bj][n][2] * v[bj][n][2] + v[bj][n][3] * v[bj][n][3]);
                    ss += __shfl_xor(ss, 16); ss += __shfl_xor(ss, 32);
                    const float rstd = rsqrtf(ss * (1.0f / 64.0f) + 1e-6f);
#pragma unroll
                    for (int bj = 0; bj < 2; ++bj)
#pragma unroll
                        for (int n = 0; n < 2; ++n) { v[bj][n] = v[bj][n] * rstd; if (type == 0) v[bj][n] = v[bj][n] * g[bj][n]; }
                }
                bf16_t* rowp = ZB + (size_t)row * 2560 + u.pn * BM + wc * 64 + 8 * fq;
#pragma unroll
                for (int bj = 0; bj < 2; ++bj) { u32x4 w; w.x = cvt_pk_bf16(v[bj][0][0], v[bj][0][1]); w.y = cvt_pk_bf16(v[bj][0][2], v[bj][0][3]); w.z = cvt_pk_bf16(v[bj][1][0], v[bj][1][1]); w.w = cvt_pk_bf16(v[bj][1][2], v[bj][1][3]);
                    *(u32x4*)(rowp + 32 * bj) = w; }
            }
    }
};
struct EpiRes {
    static constexpr bool PERM = false;
    const float* base; float* out; int ldc;
    __device__ __forceinline__ void operator()(const f32x4 (&acc)[2][2][4][2], const Unit& u, int wr, int wc, int fr, int fq) const {
        const int row0 = u.pm * BM + wr * 64 + fr, col0 = u.pn * BM + wc * 32 + 4 * fq;
#pragma unroll
        for (int ai = 0; ai < 2; ++ai)
#pragma unroll
            for (int m = 0; m < 4; ++m) { const size_t off = (size_t)(row0 + ai * HALF + m * 16) * ldc + col0;
#pragma unroll
                for (int bj = 0; bj < 2; ++bj)
#pragma unroll
                    for (int n = 0; n < 2; ++n) { const f32x4 bs = *(const f32x4*)(base + off + bj * HALF + n * 16); *(f32x4*)(out + off + bj * HALF + n * 16) = bs + acc[ai][bj][m][n]; }
                asm volatile("" ::: "memory"); }
    }
};
struct EpiSwiGLU {
    static constexpr bool PERM = true;
    bf16_t* ACT;
    __device__ __forceinline__ void operator()(const f32x4 (&acc)[2][2][4][2], const Unit& u, int wr, int wc, int fr, int fq) const {
#pragma unroll
        for (int ai = 0; ai < 2; ++ai)
#pragma unroll
            for (int m = 0; m < 4; ++m) {
                const int row = u.pm * BM + ai * HALF + wr * 64 + m * 16 + fr;
                float o[8];
#pragma unroll
                for (int n = 0; n < 2; ++n)
#pragma unroll
                    for (int j = 0; j < 4; ++j) { const float gv = acc[ai][0][m][n][j], uv = acc[ai][1][m][n][j];
                        o[n * 4 + j] = gv * __builtin_amdgcn_rcpf(1.0f + __builtin_amdgcn_exp2f(-gv * LOG2E)) * uv; }
                u32x4 w; w.x = cvt_pk_bf16(o[0], o[1]); w.y = cvt_pk_bf16(o[2], o[3]); w.z = cvt_pk_bf16(o[4], o[5]); w.w = cvt_pk_bf16(o[6], o[7]);
                *(u32x4*)(ACT + (size_t)row * 512 + u.pn * 128 + wc * 32 + 8 * fq) = w;
            }
    }
};
struct EpiSwiGLU8 {
    static constexpr bool PERM = true;
    unsigned char* ACT;
    __device__ __forceinline__ void operator()(const f32x4 (&acc)[2][2][4][2], const Unit& u, int wr, int wc, int fr, int fq) const {
#pragma unroll
        for (int ai = 0; ai < 2; ++ai)
#pragma unroll
            for (int m = 0; m < 4; ++m) {
                const int row = u.pm * BM + ai * HALF + wr * 64 + m * 16 + fr;
                float o[8];
#pragma unroll
                for (int n = 0; n < 2; ++n)
#pragma unroll
                    for (int j = 0; j < 4; ++j) { const float gv = acc[ai][0][m][n][j], uv = acc[ai][1][m][n][j];
                        o[n * 4 + j] = __builtin_amdgcn_fmed3f(8.0f * gv * __builtin_amdgcn_rcpf(1.0f + __builtin_amdgcn_exp2f(-gv * LOG2E)) * uv, -448.0f, 448.0f); }
                int w0 = 0, w1 = 0;
                w0 = __builtin_amdgcn_cvt_pk_fp8_f32(o[0], o[1], w0, false); w0 = __builtin_amdgcn_cvt_pk_fp8_f32(o[2], o[3], w0, true);
                w1 = __builtin_amdgcn_cvt_pk_fp8_f32(o[4], o[5], w1, false); w1 = __builtin_amdgcn_cvt_pk_fp8_f32(o[6], o[7], w1, true);
                *(u32x2*)(ACT + (size_t)row * 512 + u.pn * 128 + wc * 32 + 8 * fq) = (u32x2){(unsigned)w0, (unsigned)w1};
            }
    }
};
struct EpiBf16 {
    static constexpr bool PERM = true;
    bf16_t* O; int ldc;
    __device__ __forceinline__ void operator()(const f32x4 (&acc)[2][2][4][2], const Unit& u, int wr, int wc, int fr, int fq) const {
        const int row0 = u.pm * BM + wr * 64 + fr, col0 = u.pn * BM + wc * 32 + 8 * fq;
#pragma unroll
        for (int ai = 0; ai < 2; ++ai)
#pragma unroll
            for (int m = 0; m < 4; ++m) { bf16_t* rowp = O + (size_t)(row0 + ai * HALF + m * 16) * ldc + col0;
#pragma unroll
                for (int bj = 0; bj < 2; ++bj) { const f32x4 v0 = acc[ai][bj][m][0], v1 = acc[ai][bj][m][1];
                    u32x4 w; w.x = cvt_pk_bf16(v0[0], v0[1]); w.y = cvt_pk_bf16(v0[2], v0[3]); w.z = cvt_pk_bf16(v1[0], v1[1]); w.w = cvt_pk_bf16(v1[2], v1[3]);
                    *(u32x4*)(rowp + bj * HALF) = w; } }
    }
};
struct EpiResB {
    static constexpr bool PERM = true;
    const bf16_t* base; bf16_t* out; int ldc;
    __device__ __forceinline__ void operator()(const f32x4 (&acc)[2][2][4][2], const Unit& u, int wr, int wc, int fr, int fq) const {
        const int row0 = u.pm * BM + wr * 64 + fr, col0 = u.pn * BM + wc * 32 + 8 * fq;
#pragma unroll
        for (int ai = 0; ai < 2; ++ai)
#pragma unroll
            for (int m = 0; m < 4; ++m) { const size_t off = (size_t)(row0 + ai * HALF + m * 16) * ldc + col0;
#pragma unroll
                for (int bj = 0; bj < 2; ++bj) { const f32x4 v0 = acc[ai][bj][m][0], v1 = acc[ai][bj][m][1]; const u32x4 b = *(const u32x4*)(base + off + bj * HALF);
                    u32x4 w; w.x = cvt_pk_bf16(bf_lo(b.x) + v0[0], bf_hi(b.x) + v0[1]); w.y = cvt_pk_bf16(bf_lo(b.y) + v0[2], bf_hi(b.y) + v0[3]);
                    w.z = cvt_pk_bf16(bf_lo(b.z) + v1[0], bf_hi(b.z) + v1[1]); w.w = cvt_pk_bf16(bf_lo(b.w) + v1[2], bf_hi(b.w) + v1[3]);
                    *(u32x4*)(out + off + bj * HALF) = w; }
                asm volatile("" ::: "memory"); }
    }
};
}

struct Params { const float* in[24]; float* out; unsigned char* ws; };
#define LDS_WAIT() asm volatile("s_waitcnt lgkmcnt(0)" ::: "memory")
constexpr int NTHR = 512, NWAVE = 8;

struct TrItem { const float* W; int K, N; bf16_t* WT; int drow, k0, n0; const float* gain; int f8; };
__device__ __forceinline__ void tr_load(const TrItem& t, int lane, f32x4 (&v)[8], float (&g)[8]) {
    const int r8 = lane >> 3, ch = lane & 7;
#pragma unroll
    for (int i = 0; i < 8; ++i) v[i] = *(const f32x4*)(t.W + (size_t)(t.k0 + 8 * r8 + i) * t.N + t.n0 + 4 * ch);
    if (t.gain) { const f32x4 g0 = *(const f32x4*)(t.gain + t.k0 + 8 * r8), g1 = *(const f32x4*)(t.gain + t.k0 + 8 * r8 + 4);
        g[0] = g0[0]; g[1] = g0[1]; g[2] = g0[2]; g[3] = g0[3]; g[4] = g1[0]; g[5] = g1[1]; g[6] = g1[2]; g[7] = g1[3]; }
    else {
#pragma unroll
        for (int i = 0; i < 8; ++i) g[i] = 1.0f; }
}
__device__ __forceinline__ void tr_store(const TrItem& t, int lane, const f32x4 (&v)[8], const float (&g)[8], LAS float* scr) {
    (void)scr; const int r8 = lane >> 3, ch = lane & 7;
#pragma unroll
    for (int j = 0; j < 4; ++j) {
        u32x4 o; o.x = cvt_pk_bf16(v[0][j] * g[0], v[1][j] * g[1]); o.y = cvt_pk_bf16(v[2][j] * g[2], v[3][j] * g[3]); o.z = cvt_pk_bf16(v[4][j] * g[4], v[5][j] * g[5]); o.w = cvt_pk_bf16(v[6][j] * g[6], v[7][j] * g[7]);
        *(u32x4*)(t.WT + (size_t)(t.drow + 4 * ch + j) * t.K + t.k0 + 8 * r8) = o; }
}
__device__ __forceinline__ void tr_store8(const TrItem& t, int lane, const f32x4 (&v)[8], const float (&g)[8], LAS float* scr) {
    (void)scr; const int r8 = lane >> 3, ch = lane & 7;
#pragma unroll
    for (int j = 0; j < 4; ++j) {
        int w0 = 0, w1 = 0;
        w0 = __builtin_amdgcn_cvt_pk_fp8_f32(v[0][j] * (g[0] * 64.0f), v[1][j] * (g[1] * 64.0f), w0, false); w0 = __builtin_amdgcn_cvt_pk_fp8_f32(v[2][j] * (g[2] * 64.0f), v[3][j] * (g[3] * 64.0f), w0, true);
        w1 = __builtin_amdgcn_cvt_pk_fp8_f32(v[4][j] * (g[4] * 64.0f), v[5][j] * (g[5] * 64.0f), w1, false); w1 = __builtin_amdgcn_cvt_pk_fp8_f32(v[6][j] * (g[6] * 64.0f), v[7][j] * (g[7] * 64.0f), w1, true);
        *(u32x2*)((unsigned char*)t.WT + (size_t)(t.drow + 4 * ch + j) * t.K + t.k0 + 8 * r8) = (u32x2){(unsigned)w0, (unsigned)w1}; }
}
__device__ __forceinline__ int t5_bucket_d(int dist) {
    if (dist < 16) return dist;
    int lb = 16 + (int)(logf((float)dist / 16.f) / logf(128.f) * 16.f);
    return lb < 31 ? lb : 31;
}
constexpr int I_IN = 16 * 80, I_OUT = 16 * 32, I_G = 16 * 16, I_D = 8 * 32, I_E = 2 * I_G + I_D, PER_L = I_IN + I_OUT;
constexpr int CONV_ITEMS = NE * I_E;
#ifndef CONV_Q_WIN
#define CONV_Q_WIN 6
#endif
#ifndef CONV_Q_GU
#define CONV_Q_GU 0
#endif
#ifndef CONV_Q_DN
#define CONV_Q_DN 0
#endif
#ifndef SLOT_RANKS
#define SLOT_RANKS 24
#endif
constexpr int SLOT1 = 8 * SLOT_RANKS * NWAVE;
#ifndef SLOT_CFG
#define SLOT_CFG {1, 3, 2, 2, 3, 2, 2, 1}
#endif
constexpr int SLOT_N[8] = SLOT_CFG;
constexpr int slot_off(int j) { int o = 0; for (int i = 0; i < j; ++i) o += SLOT_N[i] * SLOT1; return o; }
constexpr int CONV_HEAD = slot_off(8);
static_assert(CONV_HEAD == NE * I_E, "the eight barrier slots cover a layer's expert weights exactly");
constexpr int CONV_Q0 = slot_off(3);
constexpr int DSLOT = SLOT1;
__device__ __forceinline__ void dec_dense(const Params& p, unsigned char* ws_, int it, TrItem& t) {
        const int l = it / PER_L; int r = it % PER_L;
        if (r < I_IN) { const int kb = r / 80, nb = r % 80, n0 = nb * 32, o = n0 & 255;
            t.W = p.in[3] + (size_t)l * D * DIN; t.K = D; t.N = DIN; t.WT = (bf16_t*)(ws_ + WS_WIN) + (size_t)l * DIN * D; t.drow = (n0 & ~255) + 128 * ((o >> 5) & 1) + 32 * ((o >> 6) & 3); t.k0 = kb * 64; t.n0 = n0; t.gain = p.in[2] + l * D; }
        else { r -= I_IN; const int kb = r / 32, nb = r % 32;
            t.W = p.in[15] + (size_t)l * D * D; t.K = D; t.N = D; t.WT = (bf16_t*)(ws_ + WS_WOUT) + (size_t)l * D * D; t.drow = nb * 32; t.k0 = kb * 64; t.n0 = nb * 32; t.gain = kb < 8 ? p.in[13] + l * DA : p.in[14] + l * DR - DA; }
}
__device__ __forceinline__ void dec_exp(const Params& p, unsigned char* ws_, int it, TrItem& t) {
        const int le = it / I_E; int r = it % I_E; const int l = le / NE;
        if (r < 2 * I_G) { const int up = r >= I_G; if (up) r -= I_G; const int kb = r / 16, nb = r % 16, n0 = nb * 32;
            t.W = (up ? p.in[22] : p.in[21]) + (size_t)le * D * DE; t.K = D; t.N = DE; t.WT = (bf16_t*)(ws_ + WS_WGU + (size_t)le * D * D); t.drow = 256 * (n0 >> 7) + 128 * up + (n0 & 127); t.k0 = kb * 64; t.n0 = n0; t.gain = p.in[16] + l * D; t.f8 = 1; }
        else { r -= 2 * I_G; const int kb = r / 32, nb = r % 32;
            t.W = p.in[23] + (size_t)le * DE * D; t.K = DE; t.N = D; t.WT = (bf16_t*)(ws_ + WS_WD + (size_t)le * D * DE); t.drow = nb * 32; t.k0 = kb * 64; t.n0 = nb * 32; t.gain = nullptr; t.f8 = 1; }
}
__device__ __forceinline__ void ph_prologue(const Params& p, LAS unsigned char* lds, int which) {
    unsigned char* const ws_ = opaque_ptr(p.ws);
    const int tid = opaque_tid(), lane = tid & 63, wave = tid >> 6;
    LAS float* scr = (LAS float*)(lds + wave * 8704);
    const int gw = blockIdx.x * NWAVE + wave, NGW = gridDim.x * NWAVE;
    if (which & 1) {
        for (int it = gw; it < PER_L; it += 2 * NGW) {
            TrItem ta, tb; dec_dense(p, ws_, it, ta); const bool hb = it + NGW < PER_L; dec_dense(p, ws_, hb ? it + NGW : it, tb);
            f32x4 va[8], vb[8]; float ga[8], gb[8];
            tr_load(ta, lane, va, ga); tr_load(tb, lane, vb, gb);
            tr_store(ta, lane, va, ga, scr); if (hb) tr_store(tb, lane, vb, gb, scr);
        }
        const int gt = blockIdx.x * NTHR + tid, NGT = gridDim.x * NTHR;
        float* BT = (float*)(ws_ + WS_BT);
        for (int i = gt; i < 3 * 8 * 192; i += NGT) { const int br = i / (8 * 192), h = (i / 192) % 8, j = i % 192; const int dil = br == 0 ? 1 : br == 1 ? 4 : 16;
            const int steps = (190 - j) - 31; float v = -1e30f; if (j < 191 && steps >= 0 && steps <= 128) v = p.in[1][t5_bucket_d(steps * dil) * NH + h] * LOG2E; BT[i] = v; }
        float* BND = (float*)(ws_ + WS_BND);
        if (gw < DEPTH * 24) { const int l = gw / 24, bh = gw % 24, br = bh / 8, h = bh % 8; const int dil = br == 0 ? 1 : br == 1 ? 4 : 16;
            float gm = fabsf(p.in[4][l * 64 + lane] * p.in[5][l * 64 + lane] * 0.125f * LOG2E);
            float bm = -1e30f;
            for (int st = lane; st <= 128; st += 64) bm = fmaxf(bm, p.in[1][t5_bucket_d(st * dil) * NH + h] * LOG2E);
#pragma unroll
            for (int o = 1; o < 64; o <<= 1) { gm = fmaxf(gm, __shfl_xor(gm, o)); bm = fmaxf(bm, __shfl_xor(bm, o)); }
            if (lane == 0) BND[gw] = 64.0f * gm * 1.01f + bm; }
        float* GQK = (float*)(ws_ + WS_GQK);
        for (int i = gt; i < DEPTH * 64; i += NGT) GQK[i] = p.in[4][i] * p.in[5][i] * 0.125f * LOG2E;
        float* SPL = (float*)(ws_ + WS_SPL);
        for (int i = gt; i < DEPTH * DR; i += NGT) { const float lm = -p.in[12][i]; SPL[i] = 8.f * LOG2E * (fmaxf(lm, 0.f) + log1pf(expf(-fabsf(lm)))); }
        bf16_t* RTT = (bf16_t*)(ws_ + WS_RTT);
        for (int i = gt; i < DEPTH * 48 * D; i += NGT) { const int l = i / (48 * D), j = (i / D) % 48, k = i % D; float v = 0.f;
            if (j < 36) v = p.in[16][l * D + k] * (j < 4 ? p.in[17][(l * D + k) * 4 + j] : p.in[19][(l * D + k) * 32 + j - 4]);
            const unsigned h = cvt_pk_bf16(v, 0.f) & 0xffffu; const unsigned lo = cvt_pk_bf16(v - bf_lo(h), 0.f) & 0xffffu;
            RTT[(size_t)(l * 2) * 48 * D + (size_t)j * D + k] = (bf16_t)h; RTT[(size_t)(l * 2 + 1) * 48 * D + (size_t)j * D + k] = (bf16_t)lo; }
        bf16_t* WAT = (bf16_t*)(ws_ + WS_WAT);
        for (int i = gt; i < DEPTH * 2 * 8 * 4096; i += NGT) { const int l = i / (2 * 8 * 4096), wh = (i / (8 * 4096)) & 1, g = (i / 4096) & 7, j = (i / 64) & 63, ii = i & 63;
            const float v = (wh ? p.in[10] : p.in[8])[((size_t)(l * 8 + g) * 64 + ii) * 64 + j]; WAT[i] = (bf16_t)(cvt_pk_bf16(v, 0.f) & 0xffffu); }
    }
    (void)scr;
}

__device__ __forceinline__ int conv_idle(int ntiles, int G) { const int rem = (ntiles * 4) % G; return rem == 0 ? 0 : G - rem; }
__device__ __forceinline__ void convert_range(const Params& p, LAS unsigned char* lds, int l, int first, int stride, int npairs, int limit) {
    unsigned char* const ws_ = opaque_ptr(p.ws);
    const int tid = opaque_tid(), lane = tid & 63, wave = tid >> 6;
    LAS float* scr = (LAS float*)(lds + wave * 8704);
#pragma unroll 1
    for (int it = 0; it < npairs; ++it) {
        const int base = first + it * stride;
        if (base >= limit) break;
        TrItem ta, tb; dec_exp(p, ws_, l * CONV_ITEMS + base, ta); dec_exp(p, ws_, l * CONV_ITEMS + base + 1, tb);
        f32x4 va[8], vb[8]; float ga[8], gb[8];
        tr_load(ta, lane, va, ga); tr_load(tb, lane, vb, gb);
        tr_store8(ta, lane, va, ga, scr); tr_store8(tb, lane, vb, gb, scr);
    }
}

__device__ __forceinline__ void convert_queue(const Params& p, LAS unsigned char* lds, int l, bool use_stop) {
    unsigned char* const ws_ = opaque_ptr(p.ws);
    const int tid = opaque_tid(), lane = tid & 63, wave = tid >> 6;
    LAS float* scr = (LAS float*)(lds + wave * 8704);
    volatile LAS unsigned* slot = (volatile LAS unsigned*)(lds + LDS_MISC + 128);
    unsigned* head = (unsigned*)(ws_ + WS_CONV) + l * 64; unsigned* stop = (unsigned*)(ws_ + WS_CONV) + 512 + l * 64;
#pragma unroll 1
    for (;;) {
        __syncthreads();
        if (tid == 0) { unsigned b = 0xffffffffu;
            if (!(use_stop && __hip_atomic_load(stop, __ATOMIC_RELAXED, __HIP_MEMORY_SCOPE_AGENT) != 0u)) b = atomicAdd(head, 16u);
            slot[0] = b; }
        __syncthreads();
        const unsigned b = slot[0];
        if (b >= (unsigned)CONV_Q0) break;
        const int base = (int)b + 2 * wave;
        TrItem ta, tb; dec_exp(p, ws_, l * CONV_ITEMS + base, ta); dec_exp(p, ws_, l * CONV_ITEMS + base + 1, tb);
        f32x4 va[8], vb[8]; float ga[8], gb[8];
        tr_load(ta, lane, va, ga); tr_load(tb, lane, vb, gb);
        tr_store8(ta, lane, va, ga, scr); tr_store8(tb, lane, vb, gb, scr);
    }
}

__device__ __forceinline__ void build_tiles(const int* counts, LAS int* tab) {
    const int tid = opaque_tid();
    __syncthreads();
    if (tid < 64) {
        const int cnt = tid < NE ? counts[tid * CNT_STRIDE] : 0; const int nt = (cnt + 255) >> 8, rem = cnt & 255;
        const int sm = (rem >= 1 && rem <= 128) ? 1 : 0, nm = nt - sm;
        int im = nm, is = sm;
#pragma unroll
        for (int o = 1; o < 32; o <<= 1) { const int v = __shfl_up(im, o), w = __shfl_up(is, o); if (tid >= o) { im += v; is += w; } }
        const int TM = __shfl(im, NE - 1), TS = __shfl(is, NE - 1);
        const int em = im - nm, es = is - sm;
        if (tid < NE) { tab[tid] = cnt; tab[32 + tid] = em; tab[448 + tid] = es; tab[480 + tid] = nm;
#pragma unroll 1
            for (int t = 0; t < nm; ++t) { tab[128 + em + t] = tid; tab[288 + em + t] = t * 256; }
            if (sm) { tab[128 + TM + es] = tid; tab[288 + TM + es] = nm * 256; } }
        if (tid == 0) { tab[66] = TM + TS; tab[67] = TM; }
    }
    __syncthreads();
}
__device__ __forceinline__ int moe_slot(const LAS int* tab, int e, int rk) {
    const int t = rk >> 8; const int gt = (t < tab[480 + e]) ? tab[32 + e] + t : tab[67] + tab[448 + e];
    return gt * 256 + (rk & 255);
}

__device__ __forceinline__ void norm_finish(f32x4 (&v)[4], int row, int lane, float* out32, bf16_t* XB, bf16_t* HN, bool donorm) {
    if (!donorm) { f32x4* xo = (f32x4*)(out32 + (size_t)row * D) + lane;
#pragma unroll
        for (int j = 0; j < 4; ++j) xo[64 * j] = v[j]; }
    else {
        u32x2* xo = (u32x2*)(XB + (size_t)row * D) + lane;
#pragma unroll
        for (int j = 0; j < 4; ++j) { u32x2 w; w.x = cvt_pk_bf16(v[j][0], v[j][1]); w.y = cvt_pk_bf16(v[j][2], v[j][3]); xo[64 * j] = w; }
        float s = 0.f;
#pragma unroll
        for (int j = 0; j < 4; ++j) s += (v[j][0] * v[j][0] + v[j][1] * v[j][1]) + (v[j][2] * v[j][2] + v[j][3] * v[j][3]);
        s = wave_sum(s);
        const float rstd = rsqrtf(s * (1.0f / D) + EPS);
        u32x2* o = (u32x2*)(HN + (size_t)row * D) + lane;
#pragma unroll
        for (int j = 0; j < 4; ++j) { u32x2 w; w.x = cvt_pk_bf16(v[j][0] * rstd, v[j][1] * rstd); w.y = cvt_pk_bf16(v[j][2] * rstd, v[j][3] * rstd); o[64 * j] = w; }
    }
}
__device__ __forceinline__ void norm_add(f32x4 (&v)[4], const u32x2 (&a)[4], const u32x2 (&b)[4], float g0, float g1) {
#pragma unroll
    for (int j = 0; j < 4; ++j) {
        v[j][0] += g0 * bf_lo(a[j].x) + g1 * bf_lo(b[j].x); v[j][1] += g0 * bf_hi(a[j].x) + g1 * bf_hi(b[j].x);
        v[j][2] += g0 * bf_lo(a[j].y) + g1 * bf_lo(b[j].y); v[j][3] += g0 * bf_hi(a[j].y) + g1 * bf_hi(b[j].y); }
}
__device__ __forceinline__ void ph_norm(const Params& p, LAS unsigned char* lds, const float* src32, float* out32, int mode, const int* counts, bool donorm, int conv_l) {
    unsigned char* const ws_ = opaque_ptr(p.ws);
    const int tid = opaque_tid(), lane = tid & 63, wave = __builtin_amdgcn_readfirstlane(tid >> 6);
    LAS int* tab = (LAS int*)(lds + LDS_TAB);
    if (mode) build_tiles(counts, tab);
    const int* eid = (const int*)(ws_ + WS_TOK); const int* rank = eid + M * 2; const float* gate = (const float*)(rank + M * 2);
    const bf16_t* Y = (const bf16_t*)(ws_ + WS_Y); bf16_t* HN = (bf16_t*)(ws_ + WS_HN); bf16_t* XB = (bf16_t*)(ws_ + WS_XB);
    const bool own = gridDim.x == 256;
    const int stride = own ? 1 : gridDim.x * NWAVE;
    for (int base = own ? 64 * xcd_unit(blockIdx.x) + 8 * wave : blockIdx.x * NWAVE + wave; base < M; base += own ? M : 8 * stride) {
        int ms0 = 0, ms1 = 0; float mg0 = 0.f, mg1 = 0.f;
        if (mode && lane < 8) { const int r = base + lane * stride;
            if (r < M) { const int e0 = eid[r * 2], e1 = eid[r * 2 + 1]; ms0 = moe_slot(tab, e0, rank[r * 2]); ms1 = moe_slot(tab, e1, rank[r * 2 + 1]); mg0 = gate[r * 2]; mg1 = gate[r * 2 + 1]; } }
#pragma unroll
        for (int i = 0; i < 8; i += 2) {
            const int ra = base + i * stride, rb = ra + stride;
            if (ra < M) {
                const bool hb = rb < M; const int rbb = hb ? rb : ra;
                f32x4 va[4], vb[4];
                if (mode) { const u32x2* xa = (const u32x2*)(XB + (size_t)ra * D) + lane; const u32x2* xb = (const u32x2*)(XB + (size_t)rbb * D) + lane; u32x2 qa[4], qb[4];
#pragma unroll
                    for (int j = 0; j < 4; ++j) { qa[j] = xa[64 * j]; qb[j] = xb[64 * j]; }
#pragma unroll
                    for (int j = 0; j < 4; ++j) { va[j] = (f32x4){bf_lo(qa[j].x), bf_hi(qa[j].x), bf_lo(qa[j].y), bf_hi(qa[j].y)}; vb[j] = (f32x4){bf_lo(qb[j].x), bf_hi(qb[j].x), bf_lo(qb[j].y), bf_hi(qb[j].y)}; } }
                else { const f32x4* xa = (const f32x4*)(src32 + (size_t)ra * D) + lane; const f32x4* xb = (const f32x4*)(src32 + (size_t)rbb * D) + lane;
#pragma unroll
                    for (int j = 0; j < 4; ++j) { va[j] = xa[64 * j]; vb[j] = xb[64 * j]; } }
                if (mode) {
                    const int sa0 = __builtin_amdgcn_readlane(ms0, i), sa1 = __builtin_amdgcn_readlane(ms1, i), sb0 = __builtin_amdgcn_readlane(ms0, i + 1), sb1 = __builtin_amdgcn_readlane(ms1, i + 1);
                    const float ga0 = __int_as_float(__builtin_amdgcn_readlane(__float_as_int(mg0), i)), ga1 = __int_as_float(__builtin_amdgcn_readlane(__float_as_int(mg1), i)), gb0 = __int_as_float(__builtin_amdgcn_readlane(__float_as_int(mg0), i + 1)), gb1 = __int_as_float(__builtin_amdgcn_readlane(__float_as_int(mg1), i + 1));
                    u32x2 ya0[4], ya1[4], yb0[4], yb1[4];
                    const u32x2* pa0 = (const u32x2*)(Y + (size_t)sa0 * D) + lane; const u32x2* pa1 = (const u32x2*)(Y + (size_t)sa1 * D) + lane;
                    const u32x2* pb0 = (const u32x2*)(Y + (size_t)sb0 * D) + lane; const u32x2* pb1 = (const u32x2*)(Y + (size_t)sb1 * D) + lane;
#pragma unroll
                    for (int j = 0; j < 4; ++j) { ya0[j] = pa0[64 * j]; ya1[j] = pa1[64 * j]; yb0[j] = pb0[64 * j]; yb1[j] = pb1[64 * j]; }
                    norm_add(va, ya0, ya1, ga0, ga1); norm_add(vb, yb0, yb1, gb0, gb1);
                }
                norm_finish(va, ra, lane, out32, XB, HN, donorm);
                if (hb) norm_finish(vb, rb, lane, out32, XB, HN, donorm);
            }
        }
    }
    if (conv_l >= 0) {
        const int T = __builtin_amdgcn_readfirstlane(tab[66]), idle = conv_idle(T, gridDim.x);
        int a3 = 0, lim = CONV_HEAD; (void)idle;
        convert_range(p, lds, conv_l, a3 + 2 * (blockIdx.x * NWAVE + wave), 2 * gridDim.x * NWAVE, 1 << 30, lim);
    }
}

__device__ __forceinline__ void ph_win(const Params& p, LAS unsigned char* lds, int l) {
    unsigned char* const ws_ = opaque_ptr(p.ws);
    LAS float* gq = (LAS float*)(lds + LDS_TAB + 4096);
    { const int t_ = opaque_tid(); if (t_ < 64) gq[t_] = ((const float*)(ws_ + WS_GQK))[l * 64 + t_]; }
    __syncthreads();
    if (((volatile LAS unsigned*)(lds + LDS_MISC))[2] == 0u) {
        const int w_ = opaque_tid() >> 6, gw_ = (int)blockIdx.x * NWAVE + w_, ngw_ = gridDim.x * NWAVE;
        convert_range(p, lds, l, (l == 0 ? CONV_Q0 : 0) + 2 * gw_, 2 * ngw_, 1 << 30, CONV_HEAD);
        if (l + 1 < DEPTH) {
#pragma unroll 1
            for (int it = gw_; it < PER_L; it += ngw_) { TrItem t; dec_dense(p, ws_, (l + 1) * PER_L + it, t); f32x4 v[8]; float g[8]; tr_load(t, opaque_tid() & 63, v, g); tr_store(t, opaque_tid() & 63, v, g, nullptr); } }
        __syncthreads(); }
    pg8::StaticOrder S; S.init((const bf16_t*)(ws_ + WS_HN), (const bf16_t*)(ws_ + WS_WIN) + (size_t)l * DIN * D, M, DIN, D, gridDim.x, opaque_bid());
    pg8::EpiQKV E{(bf16_t*)(ws_ + WS_ZB), gq};
    pg8::gemm_phase<pg8::EpiQKV, pg8::StaticOrder, false>(lds + LDS_STAGE, nullptr, 2 * D, S, E);
    { pg8::Unit u_; const bool third = S.next(2, u_);
      if (third) { if (opaque_tid() == 0) __hip_atomic_store((unsigned*)(ws_ + WS_CONV) + 512 + l * 64, 1u, __ATOMIC_RELAXED, __HIP_MEMORY_SCOPE_AGENT); }
      else if (l == 0) convert_queue(p, lds, l, true); }
}
__device__ __forceinline__ void ph_wout(const Params& p, LAS unsigned char* lds, int l) {
    unsigned char* const ws_ = opaque_ptr(p.ws);
    pg8::StaticOrder S; S.init((const bf16_t*)(ws_ + WS_MIX), (const bf16_t*)(ws_ + WS_WOUT) + (size_t)l * D * D, M, D, D, gridDim.x, opaque_bid());
    pg8::EpiResB E{(const bf16_t*)(ws_ + WS_XB), (bf16_t*)(ws_ + WS_XB), D};
    pg8::gemm_phase<pg8::EpiResB, pg8::StaticOrder, false>(lds + LDS_STAGE, nullptr, 2 * D, S, E);
}

__device__ __forceinline__ void split_hilo(const f32x4& a, const f32x4& b, bf16x8& hi, bf16x8& lo) {
    u32x4 h; h.x = cvt_pk_bf16(a[0], a[1]); h.y = cvt_pk_bf16(a[2], a[3]); h.z = cvt_pk_bf16(b[0], b[1]); h.w = cvt_pk_bf16(b[2], b[3]);
    u32x4 l; l.x = cvt_pk_bf16(a[0] - bf_lo(h.x), a[1] - bf_hi(h.x)); l.y = cvt_pk_bf16(a[2] - bf_lo(h.y), a[3] - bf_hi(h.y));
    l.z = cvt_pk_bf16(b[0] - bf_lo(h.z), b[1] - bf_hi(h.z)); l.w = cvt_pk_bf16(b[2] - bf_lo(h.w), b[3] - bf_hi(h.w));
    hi = __builtin_bit_cast(bf16x8, h); lo = __builtin_bit_cast(bf16x8, l);
}
__device__ __forceinline__ void ph_router(const Params& p, LAS unsigned char* lds, int l) {
    unsigned char* const ws_ = opaque_ptr(p.ws);
    const bf16_t* XB = (const bf16_t*)(ws_ + WS_XB);
    const int tid = opaque_tid(), lane = tid & 63, wave = __builtin_amdgcn_readfirstlane(tid >> 6);
    LAS float* rs = (LAS float*)lds; LAS float* Lg = (LAS float*)(lds + 1024);
    LAS int* hist = (LAS int*)(lds + 110592); LAS int* base = hist + 32;
    LAS int* t_e = hist + 64; LAS int* t_lr = t_e + 128; LAS float* t_g = (LAS float*)(t_lr + 128);
    const bf16_t* RTH = (const bf16_t*)(ws_ + WS_RTT) + (size_t)l * 2 * 48 * D; const bf16_t* RTL = RTH + 48 * D;
    int* counts = (int*)(ws_ + WS_CNT) + l * NE * CNT_STRIDE;
    int* eid = (int*)(ws_ + WS_TOK); int* rank = eid + M * 2; float* gate = (float*)(rank + M * 2);
    int* list = (int*)(ws_ + WS_LIST); bf16_t* HN = (bf16_t*)(ws_ + WS_HN);
    const float* bg = p.in[18] + l * NG; const float* be = p.in[20] + l * NE;
    SP_DECL;
    for (int g0 = blockIdx.x; g0 < M / 64; g0 += gridDim.x) {
        const int grp = xcd_unit(g0);
        __syncthreads();
        if (tid < 32) hist[tid] = 0;
        SP_BEGIN();
        {
            const int ta = grp * 64 + wave * 8;
            const u32x4* xa = (const u32x4*)(XB + (size_t)ta * D) + lane;
            u32x4 v[8][2]; float sq[8];
#pragma unroll
            for (int r = 0; r < 8; ++r)
#pragma unroll
                for (int j = 0; j < 2; ++j) v[r][j] = xa[r * (D / 8) + 64 * j];
#pragma unroll
            for (int r = 0; r < 8; ++r) { float s = 0.f;
#pragma unroll
                for (int j = 0; j < 2; ++j) { const u32x4 q = v[r][j];
                    s += ((bf_lo(q.x) * bf_lo(q.x) + bf_hi(q.x) * bf_hi(q.x)) + (bf_lo(q.y) * bf_lo(q.y) + bf_hi(q.y) * bf_hi(q.y))) + ((bf_lo(q.z) * bf_lo(q.z) + bf_hi(q.z) * bf_hi(q.z)) + (bf_lo(q.w) * bf_lo(q.w) + bf_hi(q.w) * bf_hi(q.w))); }
                sq[r] = s; }
#pragma unroll
            for (int r = 0; r < 8; ++r) sq[r] = wave_sum(sq[r]);
#pragma unroll
            for (int r = 0; r < 8; ++r) { const float rr = rsqrtf(sq[r] * (1.0f / D) + EPS);
                u32x2* o = (u32x2*)((unsigned char*)HN + (size_t)(ta + r) * D) + lane;
#pragma unroll
                for (int j = 0; j < 2; ++j) { const u32x4 q = v[r][j]; int w0 = 0, w1 = 0;
                    w0 = __builtin_amdgcn_cvt_pk_fp8_f32(bf_lo(q.x) * rr, bf_hi(q.x) * rr, w0, false); w0 = __builtin_amdgcn_cvt_pk_fp8_f32(bf_lo(q.y) * rr, bf_hi(q.y) * rr, w0, true);
                    w1 = __builtin_amdgcn_cvt_pk_fp8_f32(bf_lo(q.z) * rr, bf_hi(q.z) * rr, w1, false); w1 = __builtin_amdgcn_cvt_pk_fp8_f32(bf_lo(q.w) * rr, bf_hi(q.w) * rr, w1, true);
                    o[64 * j] = (u32x2){(unsigned)w0, (unsigned)w1}; }
                if (lane == 0) rs[wave * 8 + r] = rr; }
        }
        SP_SYNC(); SP_END(3); SP_BEGIN();
        { const int fr = lane & 15, kq = lane >> 4;
          const bf16_t* xrow = XB + (size_t)(grp * 64 + fr) * D + wave * 128 + 8 * kq;
          const bf16_t* bh = RTH + (size_t)fr * D + wave * 128 + 8 * kq; const bf16_t* bl = RTL + (size_t)fr * D + wave * 128 + 8 * kq;
          f32x4 acc[4][3];
#pragma unroll
          for (int tb = 0; tb < 4; ++tb)
#pragma unroll
              for (int ob = 0; ob < 3; ++ob) acc[tb][ob] = (f32x4){0.f, 0.f, 0.f, 0.f};
#pragma unroll 2
          for (int ks = 0; ks < 4; ++ks) {
              bf16x8 wh[3], wl[3];
#pragma unroll
              for (int ob = 0; ob < 3; ++ob) { wh[ob] = *(const bf16x8*)(bh + (size_t)ob * 16 * D + 32 * ks); wl[ob] = *(const bf16x8*)(bl + (size_t)ob * 16 * D + 32 * ks); }
              bf16x8 xa[4];
#pragma unroll
              for (int tb = 0; tb < 4; ++tb) xa[tb] = *(const bf16x8*)(xrow + (size_t)tb * 16 * D + 32 * ks);
#pragma unroll
              for (int tb = 0; tb < 4; ++tb)
#pragma unroll
                  for (int ob = 0; ob < 3; ++ob) {
                      acc[tb][ob] = __builtin_amdgcn_mfma_f32_16x16x32_bf16(xa[tb], wh[ob], acc[tb][ob], 0, 0, 0);
                      acc[tb][ob] = __builtin_amdgcn_mfma_f32_16x16x32_bf16(xa[tb], wl[ob], acc[tb][ob], 0, 0, 0); } }
#pragma unroll
          for (int tb = 0; tb < 4; ++tb)
#pragma unroll
              for (int ob = 0; ob < 3; ++ob)
#pragma unroll
                  for (int r = 0; r < 4; ++r) Lg[(wave * 64 + tb * 16 + 4 * kq + r) * 52 + ob * 16 + fr] = acc[tb][ob][r];
        }
        __syncthreads(); SP_END(4); SP_BEGIN();
        if (tid < 64) {
            const float rstd = rs[tid];
            f32x4 l4[9];
#pragma unroll
            for (int q = 0; q < 9; ++q) l4[q] = *(const LAS f32x4*)(Lg + tid * 52 + 4 * q);
#pragma unroll 1
            for (int sl = 1; sl < 8; ++sl) {
#pragma unroll
                for (int q = 0; q < 9; ++q) l4[q] += *(const LAS f32x4*)(Lg + (sl * 64 + tid) * 52 + 4 * q); }
            float lg[36];
#pragma unroll
            for (int q = 0; q < 9; ++q) { lg[4 * q] = l4[q][0] * rstd; lg[4 * q + 1] = l4[q][1] * rstd; lg[4 * q + 2] = l4[q][2] * rstd; lg[4 * q + 3] = l4[q][3] * rstd; }
            float gl[4];
#pragma unroll
            for (int j = 0; j < 4; ++j) gl[j] = lg[j] + bg[j];
            int gs = 0; float gm = gl[0];
#pragma unroll
            for (int j = 1; j < 4; ++j) if (gl[j] > gm) { gm = gl[j]; gs = j; }
            float den = 0.f;
#pragma unroll
            for (int j = 0; j < 4; ++j) den += expf(gl[j] - gm);
            const float gw = 1.f / den;
            float el[8];
#pragma unroll
            for (int j = 0; j < 8; ++j) el[j] = (gs == 0 ? lg[4 + j] : gs == 1 ? lg[12 + j] : gs == 2 ? lg[20 + j] : lg[28 + j]) + be[gs * 8 + j];
            int i0 = 0; float m0 = el[0];
#pragma unroll
            for (int j = 1; j < 8; ++j) if (el[j] > m0) { m0 = el[j]; i0 = j; }
            int i1 = -1; float m1 = -3.0e38f;
#pragma unroll
            for (int j = 0; j < 8; ++j) if (j != i0 && el[j] > m1) { m1 = el[j]; i1 = j; }
            const float e1 = expf(m1 - m0); const float p0 = 1.f / (1.f + e1), p1 = e1 / (1.f + e1);
            const int ex0 = gs * 8 + i0, ex1 = gs * 8 + i1;
            t_e[tid * 2] = ex0; t_e[tid * 2 + 1] = ex1; t_g[tid * 2] = gw * p0; t_g[tid * 2 + 1] = gw * p1;
            t_lr[tid * 2] = __hip_atomic_fetch_add(hist + ex0, 1, __ATOMIC_RELAXED, __HIP_MEMORY_SCOPE_WORKGROUP); t_lr[tid * 2 + 1] = __hip_atomic_fetch_add(hist + ex1, 1, __ATOMIC_RELAXED, __HIP_MEMORY_SCOPE_WORKGROUP);
        }
        __syncthreads();
        if (tid < 32) { const int hcount = hist[tid]; base[tid] = hcount > 0 ? atomicAdd(&counts[tid * CNT_STRIDE], hcount) : 0; }
        __syncthreads();
        if (tid < 128) { const int tok = grp * 64 + (tid >> 1); const int e = t_e[tid]; const int r = base[e] + t_lr[tid];
            eid[tok * 2 + (tid & 1)] = e; rank[tok * 2 + (tid & 1)] = r; gate[tok * 2 + (tid & 1)] = t_g[tid]; list[(size_t)e * M + r] = tok; }
        SP_SYNC(); SP_END(5);
    }
}
__device__ __forceinline__ void ph_gateup(const Params& p, LAS unsigned char* lds, int l) {
    unsigned char* const ws_ = opaque_ptr(p.ws);
    LAS int* tab = (LAS int*)(lds + LDS_TAB);
    build_tiles((const int*)(ws_ + WS_CNT) + l * NE * CNT_STRIDE, tab);
    pg8::MoeOrder S; S.G = gridDim.x; S.c = opaque_bid(); S.ntiles = __builtin_amdgcn_readfirstlane(tab[66]); S.tile_e = tab + 128; S.tile_r0 = tab + 288; S.cnt = tab;
    S.A = nullptr; S.tA = 0; S.W = (const char*)(ws_ + WS_WGU) + (size_t)l * NE * D * D; S.estride = (size_t)D * D; S.tB = (size_t)256 * D;
    S.list = (const int*)(ws_ + WS_LIST); S.Mrows = M;
    S.pub = nullptr; S.wait = nullptr; S.need = 0u; S.tmo = nullptr;
    pg8::EpiSwiGLU8 E{(unsigned char*)(ws_ + WS_ACT)};
    pg8::gemm_phase<pg8::EpiSwiGLU8, pg8::MoeOrder, true, true, 0x79797979, 0x7f7f7f7f, false, 10>(lds + LDS_STAGE, (const void*)(ws_ + WS_HN), D, S, E);
    if (l + 1 < DEPTH && gridDim.x == 256 && CONV_Q_GU > 0) { const int rem = (S.ntiles * 4) % S.G;
        if (rem != 0 && (int)blockIdx.x >= rem) { const int wv = opaque_tid() >> 6;
            convert_range(p, lds, l + 1, (((int)blockIdx.x - rem) * NWAVE + wv) * 2 * CONV_Q_GU, 2, CONV_Q_GU, CONV_HEAD); } }
}
__device__ __forceinline__ void ph_down(const Params& p, LAS unsigned char* lds, int l) {
    unsigned char* const ws_ = opaque_ptr(p.ws);
    LAS int* tab = (LAS int*)(lds + LDS_TAB);
    build_tiles((const int*)(ws_ + WS_CNT) + l * NE * CNT_STRIDE, tab);
    pg8::MoeOrder S; S.G = gridDim.x; S.c = opaque_bid(); S.ntiles = __builtin_amdgcn_readfirstlane(tab[66]); S.tile_e = tab + 128; S.tile_r0 = tab + 288; S.cnt = tab;
    S.A = (const char*)(ws_ + WS_ACT); S.tA = (size_t)256 * DE; S.W = (const char*)(ws_ + WS_WD) + (size_t)l * NE * D * DE; S.estride = (size_t)D * DE; S.tB = (size_t)256 * DE;
    S.list = (const int*)(ws_ + WS_LIST); S.Mrows = M;
    S.pub = nullptr; S.wait = nullptr; S.need = 0u; S.tmo = nullptr;
    pg8::EpiBf16 E{(bf16_t*)(ws_ + WS_Y), D};
    pg8::gemm_phase<pg8::EpiBf16, pg8::MoeOrder, true, true, 0x79797979, 0x7c7c7c7c, true, 9>(lds + LDS_STAGE, (const void*)(ws_ + WS_ACT), DE, S, E);
    if (l + 1 < DEPTH && gridDim.x == 256 && CONV_Q_DN > 0) { const int rem = (S.ntiles * 4) % S.G;
        if (rem != 0 && (int)blockIdx.x >= rem) { const int wv = opaque_tid() >> 6; const int a2 = (S.G - rem) * 8 * 2 * CONV_Q_GU;
            convert_range(p, lds, l + 1, a2 + (((int)blockIdx.x - rem) * NWAVE + wv) * 2 * CONV_Q_DN, 2, CONV_Q_DN, CONV_HEAD); } }
}

#define TRREAD(dst, addr, off) asm volatile("ds_read_b64_tr_b16 %0, %1 offset:%2" : "=&v"(dst) : "v"(addr), "i"(off) : "memory")
struct AttnPf { u32x4 k[6], v[6]; bf16x8 q[4]; };
__device__ __forceinline__ void attn_issue(const bf16_t* ZB, int item, int tid, AttnPf& pf, int which) {
    const int br = item >> 9, rem = item & 511, b = rem >> 8, h = (rem >> 5) & 7, j = rem & 31;
    const int dsh = br * 2, dil = 1 << dsh, nblk = 32 >> dsh, r = j / nblk, blk = j % nblk, i0 = blk * 256;
    if (which & 3) {
#pragma unroll
        for (int jj = 0; jj < 6; ++jj) {
            const int idx = tid + 512 * jj, key = idx >> 3, ch = idx & 7, sub = i0 - 128 + key;
            const bf16_t* rp = ZB + (size_t)(b * SEQ + (sub >= 0 ? sub : 0) * dil + r) * DIN + h * HD + ch * 8;
            if (which & 1) { pf.k[jj] = (u32x4){0u, 0u, 0u, 0u}; if (sub >= 0) pf.k[jj] = *(const u32x4*)(rp + DA); }
            if (which & 2) { pf.v[jj] = (u32x4){0u, 0u, 0u, 0u}; if (sub >= 0) pf.v[jj] = *(const u32x4*)(rp + 2 * DA); }
        }
    }
    if (which & 4) {
        const int lane = tid & 63, w = tid >> 6, hh = lane >> 5, ql = lane & 31;
        const size_t qtok = (size_t)(b * SEQ + (i0 + 32 * w + ql) * dil + r);
#pragma unroll
        for (int ks = 0; ks < 4; ++ks) pf.q[ks] = *(const bf16x8*)(ZB + qtok * DIN + h * HD + 16 * ks + 8 * hh);
    }
}
__device__ __forceinline__ void attn_item(const Params& p, LAS unsigned char* lds, int l, int item, AttnPf& pf, int next_item) {
    unsigned char* const ws_ = opaque_ptr(p.ws);
    const int tid = opaque_tid(), lane = tid & 63, w = __builtin_amdgcn_readfirstlane(tid >> 6), hh = lane >> 5, ql = lane & 31;
    const int br = item >> 9, rem = item & 511, b = rem >> 8, h = (rem >> 5) & 7, j = rem & 31;
    const int dsh = br * 2, dil = 1 << dsh, nblk = 32 >> dsh, r = j / nblk, blk = j % nblk, i0 = blk * 256;
    const bf16_t* ZB = (const bf16_t*)(ws_ + WS_ZB);
    LAS unsigned char* Kl = lds; LAS unsigned char* Vl = lds + 49152; LAS float* Tl = (LAS float*)(lds + 98304) + (br * 8 + h) * 192;
    LAS unsigned char* Ost = lds + 116736 + w * 4096;
    SP_DECL;
    __syncthreads();
    SP_BEGIN();
#pragma unroll
    for (int jj = 0; jj < 6; ++jj) {
        const int idx = tid + 512 * jj, key = idx >> 3, ch = idx & 7;
        *(LAS u32x4*)(Kl + key * 128 + ((ch ^ ((key >> 1) & 7)) << 4)) = pf.k[jj];
        *(LAS u32x4*)(Vl + ((key >> 2) * 2 + (ch >> 2)) * 256 + (key & 3) * 64 + (ch & 3) * 16) = pf.v[jj];
    }
    bf16x8 qf[4];
#pragma unroll
    for (int ks = 0; ks < 4; ++ks) qf[ks] = pf.q[ks];
    __syncthreads();
    SP_END(11); SP_BEGIN();
    const int sw = (ql >> 1) & 7;
    int koff[4];
#pragma unroll
    for (int ks = 0; ks < 4; ++ks) koff[ks] = ((2 * ks + hh) ^ sw) << 4;
    const LAS unsigned char* kbase = Kl + (32 * w + ql) * 128;
    const LAS float* tl = Tl + (31 - ql + 4 * hh);
    if (next_item >= 0) attn_issue(ZB, next_item, tid, pf, 1);
    __builtin_amdgcn_sched_barrier(0);
    f32x16 S[5];
#pragma unroll
    for (int kb = 0; kb < 5; ++kb) {
#pragma unroll
        for (int rr = 0; rr < 16; ++rr) S[kb][rr] = tl[32 * kb + (rr & 3) + 8 * (rr >> 2)];
#pragma unroll
        for (int ks = 0; ks < 4; ++ks) { const bf16x8 kf = *(const LAS bf16x8*)(kbase + kb * 4096 + koff[ks]);
            S[kb] = __builtin_amdgcn_mfma_f32_32x32x16_bf16(kf, qf[ks], S[kb], 0, 0, 0); }
    }
    __builtin_amdgcn_sched_barrier(0);
    if (next_item >= 0) attn_issue(ZB, next_item, tid, pf, 2);
    __builtin_amdgcn_sched_barrier(0);
    const int thr = 128 - i0 - 32 * w;
    if (thr > 0) {
        asm volatile("" ::: "memory");
#pragma unroll
        for (int kb = 0; kb < 5; ++kb)
#pragma unroll
            for (int rr = 0; rr < 16; ++rr) { const int c = 32 * kb + (rr & 3) + 8 * (rr >> 2); if (c + 4 * hh < thr) S[kb][rr] = -1e30f; }
    }
    float ls = 0.f;
#pragma unroll
    for (int kb = 0; kb < 5; ++kb)
#pragma unroll
        for (int rr = 0; rr < 16; ++rr) { const float e = __builtin_amdgcn_exp2f(S[kb][rr]); S[kb][rr] = e; ls += e; }
    ls += __shfl_xor(ls, 32);
    __builtin_amdgcn_sched_barrier(0);
    if (next_item >= 0) attn_issue(ZB, next_item, tid, pf, 4);
    __builtin_amdgcn_sched_barrier(0);
    f32x16 O[2];
    O[0] = (f32x16){0.f, 0.f, 0.f, 0.f, 0.f, 0.f, 0.f, 0.f, 0.f, 0.f, 0.f, 0.f, 0.f, 0.f, 0.f, 0.f}; O[1] = O[0];
    const unsigned vaddr = (unsigned)(size_t)(Vl) + (unsigned)(w * 4096 + hh * 512 + ((lane >> 2) & 3) * 64 + ((lane >> 4) & 1) * 32 + (lane & 3) * 8);
#define PV_READ(V0, V1, kb) do { \
        TRREAD(V0[0][0], vaddr, (8 * (kb) + 0) * 512 + 0);   TRREAD(V1[0][0], vaddr, (8 * (kb) + 2) * 512 + 0); \
        TRREAD(V0[0][1], vaddr, (8 * (kb) + 0) * 512 + 256); TRREAD(V1[0][1], vaddr, (8 * (kb) + 2) * 512 + 256); \
        TRREAD(V0[1][0], vaddr, (8 * (kb) + 4) * 512 + 0);   TRREAD(V1[1][0], vaddr, (8 * (kb) + 6) * 512 + 0); \
        TRREAD(V0[1][1], vaddr, (8 * (kb) + 4) * 512 + 256); TRREAD(V1[1][1], vaddr, (8 * (kb) + 6) * 512 + 256); } while (0)
#define PV_MMA(V0, V1, kb) do { _Pragma("unroll") for (int s2 = 0; s2 < 2; ++s2) { \
            u32x4 pw; pw.x = cvt_pk_bf16(S[kb][8 * s2 + 0], S[kb][8 * s2 + 1]); pw.y = cvt_pk_bf16(S[kb][8 * s2 + 2], S[kb][8 * s2 + 3]); \
            pw.z = cvt_pk_bf16(S[kb][8 * s2 + 4], S[kb][8 * s2 + 5]); pw.w = cvt_pk_bf16(S[kb][8 * s2 + 6], S[kb][8 * s2 + 7]); \
            const bf16x8 pb = __builtin_bit_cast(bf16x8, pw); \
            _Pragma("unroll") for (int db = 0; db < 2; ++db) { const bf16x8 va = (bf16x8){V0[s2][db][0], V0[s2][db][1], V0[s2][db][2], V0[s2][db][3], V1[s2][db][0], V1[s2][db][1], V1[s2][db][2], V1[s2][db][3]}; \
                O[db] = __builtin_amdgcn_mfma_f32_32x32x16_bf16(va, pb, O[db], 0, 0, 0); } } } while (0)
    {
        s16x4 va0[2][2], va1[2][2], vb0[2][2], vb1[2][2];
        PV_READ(va0, va1, 0);
        PV_READ(vb0, vb1, 1); asm volatile("s_waitcnt lgkmcnt(8)" ::: "memory"); __builtin_amdgcn_sched_barrier(0); PV_MMA(va0, va1, 0); __builtin_amdgcn_sched_barrier(0);
        PV_READ(va0, va1, 2); asm volatile("s_waitcnt lgkmcnt(8)" ::: "memory"); __builtin_amdgcn_sched_barrier(0); PV_MMA(vb0, vb1, 1); __builtin_amdgcn_sched_barrier(0);
        PV_READ(vb0, vb1, 3); asm volatile("s_waitcnt lgkmcnt(8)" ::: "memory"); __builtin_amdgcn_sched_barrier(0); PV_MMA(va0, va1, 2); __builtin_amdgcn_sched_barrier(0);
        PV_READ(va0, va1, 4); asm volatile("s_waitcnt lgkmcnt(8)" ::: "memory"); __builtin_amdgcn_sched_barrier(0); PV_MMA(vb0, vb1, 3); __builtin_amdgcn_sched_barrier(0);
        asm volatile("s_waitcnt lgkmcnt(0)" ::: "memory"); __builtin_amdgcn_sched_barrier(0); PV_MMA(va0, va1, 4);
    }
#undef PV_READ
#undef PV_MMA
    asm volatile("s_waitcnt lgkmcnt(0)" ::: "memory"); SP_END(12); SP_BEGIN();
    const float inv = 1.0f / ls;
#pragma unroll
    for (int db = 0; db < 2; ++db)
#pragma unroll
        for (int rg = 0; rg < 4; ++rg) { u32x2 o; o.x = cvt_pk_bf16(O[db][4 * rg] * inv, O[db][4 * rg + 1] * inv); o.y = cvt_pk_bf16(O[db][4 * rg + 2] * inv, O[db][4 * rg + 3] * inv);
            *(LAS u32x2*)(Ost + ql * 128 + (((4 * db + rg) ^ (ql & 7)) << 4) + 8 * hh) = o; }
    const float bound = ((const float*)(ws_ + WS_BND))[l * 24 + br * 8 + h];
    const size_t qtok = (size_t)(b * SEQ + (i0 + 32 * w + ql) * dil + r);
    if (hh == 0) ((float*)(ws_ + WS_LSE))[((size_t)br * M + qtok) * NH + h] = __builtin_amdgcn_logf(ls) + bound;
    asm volatile("s_waitcnt lgkmcnt(0)" ::: "memory");
    bf16_t* obase = (bf16_t*)(ws_ + WS_OB) + (size_t)br * M * DA + h * HD;
#pragma unroll
    for (int i = 0; i < 4; ++i) { const int row = (lane >> 3) + 8 * i, cp = lane & 7;
        const u32x4 d = *(const LAS u32x4*)(Ost + row * 128 + cp * 16);
        const size_t tok = (size_t)(b * SEQ + (i0 + 32 * w + row) * dil + r);
        *(u32x4*)(obase + tok * DA + ((cp ^ (row & 7)) << 3)) = d; }
#if SUBPROBE == 13
    asm volatile("s_waitcnt vmcnt(0)" ::: "memory");
#endif
    SP_END(13);
}

__device__ __forceinline__ float sigm(float x) { return __builtin_amdgcn_rcpf(1.0f + __builtin_amdgcn_exp2f(-x * LOG2E)); }
__device__ __forceinline__ void rnn_agg_unit(const Params& p, LAS unsigned char* lds, int l, int unit) {
    unsigned char* const ws_ = opaque_ptr(p.ws);
    const int tid = opaque_tid(), lane = tid & 63, g = __builtin_amdgcn_readfirstlane(tid >> 6), hh = lane >> 5, ql = lane & 31;
    const int b = unit >> 7, chunk = unit & 127, t0 = chunk * 64;
    const bf16_t* ZB = (const bf16_t*)(ws_ + WS_ZB);
    LAS float* ut = (LAS float*)(lds + g * 17408); LAS float* at = ut + 32 * 68;
    float* AGG = (float*)(ws_ + WS_AGG); unsigned* AD = (unsigned*)(ws_ + WS_AD);
    const int c = g * 64 + lane;
    float hst = 0.f, Ap = 1.f;
    const float* cw = p.in[6] + l * 4 * DR; const float w0 = cw[c], w1 = cw[DR + c], w2 = cw[2 * DR + c], w3 = cw[3 * DR + c], cbv = p.in[7][l * DR + c];
    float bav[2], bxv[2], splv[2];
#pragma unroll
    for (int nb = 0; nb < 2; ++nb) { const int cd = g * 64 + 32 * nb + ql; bav[nb] = p.in[9][l * DR + cd]; bxv[nb] = p.in[11][l * DR + cd]; splv[nb] = ((const float*)(ws_ + WS_SPL))[l * DR + cd]; }
    bf16x8 Wa[2][4], Wx[2][4];
    { const bf16_t* wat = (const bf16_t*)(ws_ + WS_WAT) + (size_t)((l * 2) * 8 + g) * 4096;
#pragma unroll
      for (int nb = 0; nb < 2; ++nb)
#pragma unroll
          for (int ks = 0; ks < 4; ++ks) { const int off = (32 * nb + ql) * 64 + 16 * ks + 8 * hh; Wa[nb][ks] = *(const bf16x8*)(wat + off); Wx[nb][ks] = *(const bf16x8*)(wat + 8 * 4096 + off); } }
    const size_t tokb = (size_t)b * SEQ + t0;
    float xm3 = 0.f, xm2 = 0.f, xm1 = 0.f;
    if (t0 > 0) { xm3 = bf2f(ZB[(tokb - 3) * DIN + 1536 + c]); xm2 = bf2f(ZB[(tokb - 2) * DIN + 1536 + c]); xm1 = bf2f(ZB[(tokb - 1) * DIN + 1536 + c]); }
    __syncthreads();
#pragma unroll 1
    for (int hf = 0; hf < 2; ++hf) {
        const size_t tk0 = tokb + 32 * hf;
        { bf16_t xr_[32];
#pragma unroll
          for (int tt = 0; tt < 32; ++tt) xr_[tt] = ZB[(tk0 + tt) * DIN + 1536 + c];
#pragma unroll
          for (int tt = 0; tt < 32; ++tt) { const float xv = bf2f(xr_[tt]); ut[tt * 68 + lane] = cbv + w0 * xm3 + w1 * xm2 + w2 * xm1 + w3 * xv; xm3 = xm2; xm2 = xm1; xm1 = xv; } }
        asm volatile("s_waitcnt lgkmcnt(0)" ::: "memory");
        bf16x8 Af[4];
#pragma unroll
        for (int ks = 0; ks < 4; ++ks) { const LAS f32x4* s = (const LAS f32x4*)(ut + ql * 68 + 16 * ks + 8 * hh); const f32x4 x0 = s[0], x1 = s[1];
            u32x4 pw; pw.x = cvt_pk_bf16(x0[0], x0[1]); pw.y = cvt_pk_bf16(x0[2], x0[3]); pw.z = cvt_pk_bf16(x1[0], x1[1]); pw.w = cvt_pk_bf16(x1[2], x1[3]); Af[ks] = __builtin_bit_cast(bf16x8, pw); }
        f32x16 Dr[2], Dx[2];
#pragma unroll
        for (int nb = 0; nb < 2; ++nb) { Dr[nb] = (f32x16){0.f, 0.f, 0.f, 0.f, 0.f, 0.f, 0.f, 0.f, 0.f, 0.f, 0.f, 0.f, 0.f, 0.f, 0.f, 0.f}; Dx[nb] = Dr[nb];
#pragma unroll
            for (int ks = 0; ks < 4; ++ks) { Dr[nb] = __builtin_amdgcn_mfma_f32_32x32x16_bf16(Af[ks], Wa[nb][ks], Dr[nb], 0, 0, 0); Dx[nb] = __builtin_amdgcn_mfma_f32_32x32x16_bf16(Af[ks], Wx[nb][ks], Dx[nb], 0, 0, 0); } }
#pragma unroll
        for (int nb = 0; nb < 2; ++nb)
#pragma unroll
            for (int rr = 0; rr < 16; ++rr) { const int row = (rr & 3) + 8 * (rr >> 2) + 4 * hh; const int o = row * 68 + 32 * nb + ql;
                const float rs = sigm(Dr[nb][rr] + bav[nb]), is = sigm(Dx[nb][rr] + bxv[nb]);
                const float a = __builtin_amdgcn_exp2f(-splv[nb] * rs); const float uv = ut[o];
                const unsigned pk = cvt_pk_bf16(1.0f - a, __builtin_amdgcn_sqrtf(fmaxf(1.0f - a * a, 0.f)) * (is * uv));
                AD[(tk0 + row) * DR + g * 64 + 32 * nb + ql] = pk;
                at[o] = 1.0f - bf_lo(pk); ut[o] = bf_hi(pk); }
        asm volatile("s_waitcnt lgkmcnt(0)" ::: "memory");
#pragma unroll 8
        for (int tt = 0; tt < 32; ++tt) { const float a = at[tt * 68 + lane], d = ut[tt * 68 + lane]; hst = a * hst + d; Ap *= a; }
    }
    { float* ag = AGG + (size_t)(b * 128 + chunk) * 1024 + c; ag[0] = Ap; ag[512] = hst; }
}
__device__ __forceinline__ void rnn_final_unit(const Params& p, LAS unsigned char* lds, int l, int unit) {
    unsigned char* const ws_ = opaque_ptr(p.ws);
    const int tid = opaque_tid(), lane = tid & 63, g = __builtin_amdgcn_readfirstlane(tid >> 6), hh = lane >> 5, ql = lane & 31;
    const int b = unit >> 7, chunk = unit & 127, t0 = chunk * 64;
    const bf16_t* ZB = (const bf16_t*)(ws_ + WS_ZB); const unsigned* AD = (const unsigned*)(ws_ + WS_AD);
    LAS float* at = (LAS float*)(lds + g * 17408);
    LAS float* part = (LAS float*)(lds + 139264);
    const float* AGG = (const float*)(ws_ + WS_AGG);
    const int c = g * 64 + lane;
    const size_t tokb = (size_t)b * SEQ + t0;
    unsigned ad0[32]; bf16_t gr0[32];
#pragma unroll
    for (int tt = 0; tt < 32; ++tt) { ad0[tt] = AD[(tokb + tt) * DR + c]; gr0[tt] = ZB[(tokb + tt) * DIN + 2048 + c]; }
    float hst = 0.f;
    {
        const float* ag = AGG + (size_t)(b * 128) * 1024 + c;
        int cc = 0;
        if (chunk >= 16) {
            float A0[16], H0[16];
#pragma unroll
            for (int q = 0; q < 16; ++q) { A0[q] = ag[(size_t)q * 1024]; H0[q] = ag[(size_t)q * 1024 + 512]; }
            for (cc = 16; cc + 16 <= chunk; cc += 16) { float A1[16], H1[16];
#pragma unroll
                for (int q = 0; q < 16; ++q) { A1[q] = ag[(size_t)(cc + q) * 1024]; H1[q] = ag[(size_t)(cc + q) * 1024 + 512]; }
#pragma unroll
                for (int q = 0; q < 16; ++q) hst = A0[q] * hst + H0[q];
#pragma unroll
                for (int q = 0; q < 16; ++q) { A0[q] = A1[q]; H0[q] = H1[q]; } }
#pragma unroll
            for (int q = 0; q < 16; ++q) hst = A0[q] * hst + H0[q];
        }
        for (; cc + 8 <= chunk; cc += 8) { float A[8], H[8];
#pragma unroll
            for (int q = 0; q < 8; ++q) { A[q] = ag[(size_t)(cc + q) * 1024]; H[q] = ag[(size_t)(cc + q) * 1024 + 512]; }
#pragma unroll
            for (int q = 0; q < 8; ++q) hst = A[q] * hst + H[q]; }
        for (; cc < chunk; ++cc) { const float A = ag[(size_t)cc * 1024], H = ag[(size_t)cc * 1024 + 512]; hst = A * hst + H; }
    }
    __syncthreads();
#pragma unroll
    for (int hf = 0; hf < 2; ++hf) {
        const size_t tk0 = tokb + 32 * hf;
        unsigned ad1[32]; bf16_t gr1[32];
        if (hf == 0) {
#pragma unroll
            for (int tt = 0; tt < 32; ++tt) { ad1[tt] = AD[(tokb + 32 + tt) * DR + c]; gr1[tt] = ZB[(tokb + 32 + tt) * DIN + 2048 + c]; } }
#pragma unroll
        for (int tt = 0; tt < 32; ++tt) { const unsigned pk = ad0[tt]; hst = (1.0f - bf_lo(pk)) * hst + bf_hi(pk);
            const float gv = bf2f(gr0[tt]); const float y2 = 1.5957691216057308f * (gv + 0.044715f * gv * gv * gv);
            at[tt * 68 + lane] = hst * gv * sigm(y2); }
        asm volatile("s_waitcnt lgkmcnt(0)" ::: "memory");
        f32x4 ov[8]; float ss = 0.f;
#pragma unroll
        for (int q = 0; q < 8; ++q) { ov[q] = *(const LAS f32x4*)(at + ql * 68 + 32 * hh + 4 * q); ss += (ov[q][0] * ov[q][0] + ov[q][1] * ov[q][1]) + (ov[q][2] * ov[q][2] + ov[q][3] * ov[q][3]); }
        ss += __shfl_xor(ss, 32);
        if (hh == 0) part[(hf * 32 + ql) * 8 + g] = ss;
        __syncthreads();
        const LAS f32x4* pp = (const LAS f32x4*)(part + (hf * 32 + ql) * 8); const f32x4 p0 = pp[0], p1 = pp[1];
        const float rstd = rsqrtf(((p0[0] + p0[1]) + (p0[2] + p0[3]) + (p1[0] + p1[1]) + (p1[2] + p1[3])) * (1.0f / DR) + EPS);
        bf16_t* mo = (bf16_t*)(ws_ + WS_MIX) + (tk0 + ql) * D + DA + g * 64 + 32 * hh;
#pragma unroll
        for (int q = 0; q < 4; ++q) { u32x4 wv; wv.x = cvt_pk_bf16(ov[2 * q][0] * rstd, ov[2 * q][1] * rstd); wv.y = cvt_pk_bf16(ov[2 * q][2] * rstd, ov[2 * q][3] * rstd);
            wv.z = cvt_pk_bf16(ov[2 * q + 1][0] * rstd, ov[2 * q + 1][1] * rstd); wv.w = cvt_pk_bf16(ov[2 * q + 1][2] * rstd, ov[2 * q + 1][3] * rstd); *(u32x4*)(mo + 8 * q) = wv; }
        if (hf == 0) {
#pragma unroll
            for (int tt = 0; tt < 32; ++tt) { ad0[tt] = ad1[tt]; gr0[tt] = gr1[tt]; } }
    }
}

__device__ __forceinline__ void attn_merge_unit(const Params& p, int unit) {
    unsigned char* const ws_ = opaque_ptr(p.ws);
    const int tid = opaque_tid(), lane = tid & 63, w = tid >> 6;
    const bf16_t* OB = (const bf16_t*)(ws_ + WS_OB); const float* LSE = (const float*)(ws_ + WS_LSE);
#pragma unroll 1
    for (int tg = 0; tg < 8; tg += 4) {
        float ls[4][3]; u32x4 ov[4][3];
#pragma unroll
        for (int t4 = 0; t4 < 4; ++t4) { const size_t tok = (size_t)unit * 64 + w * 8 + tg + t4;
#pragma unroll
            for (int br = 0; br < 3; ++br) { ls[t4][br] = LSE[((size_t)br * M + tok) * NH + (lane >> 3)]; ov[t4][br] = *(const u32x4*)(OB + ((size_t)br * M + tok) * DA + 8 * lane); } }
#pragma unroll
        for (int t4 = 0; t4 < 4; ++t4) { const size_t tok = (size_t)unit * 64 + w * 8 + tg + t4;
            const float mx = fmaxf(ls[t4][0], fmaxf(ls[t4][1], ls[t4][2]));
            float wb[3];
#pragma unroll
            for (int br = 0; br < 3; ++br) wb[br] = __builtin_amdgcn_exp2f(ls[t4][br] - mx);
            const float wi = 1.0f / (wb[0] + wb[1] + wb[2]);
            float o[8];
#pragma unroll
            for (int q = 0; q < 4; ++q) { float lo = 0.f, hi = 0.f;
#pragma unroll
                for (int br = 0; br < 3; ++br) { lo += wb[br] * bf_lo(ov[t4][br][q]); hi += wb[br] * bf_hi(ov[t4][br][q]); }
                o[2 * q] = lo * wi; o[2 * q + 1] = hi * wi; }
            float ss = 0.f;
#pragma unroll
            for (int q = 0; q < 8; ++q) ss += o[q] * o[q];
            ss = wave_sum(ss);
            const float rstd = rsqrtf(ss * (1.0f / DA) + EPS);
            u32x4 wv; wv.x = cvt_pk_bf16(o[0] * rstd, o[1] * rstd); wv.y = cvt_pk_bf16(o[2] * rstd, o[3] * rstd); wv.z = cvt_pk_bf16(o[4] * rstd, o[5] * rstd); wv.w = cvt_pk_bf16(o[6] * rstd, o[7] * rstd);
            *(u32x4*)((bf16_t*)(ws_ + WS_MIX) + tok * D + 8 * lane) = wv; }
    }
}
__device__ __forceinline__ void ph_mix1(const Params& p, LAS unsigned char* lds, int l) {
    SP_DECL;
    SP_BEGIN();
    { unsigned char* const ws_ = opaque_ptr(p.ws); const int tid = opaque_tid();
      { LAS float* T = (LAS float*)(lds + 98304); const float* BT = (const float*)(ws_ + WS_BT); const float* BND = (const float*)(ws_ + WS_BND) + l * 24;
        for (int i = tid; i < 24 * 192; i += NTHR) T[i] = BT[i] - BND[i / 192]; }
      AttnPf pf;
      if (gridDim.x == 256) {
          const int xcd = blockIdx.x & 7, rank = blockIdx.x >> 3;
#define ATT_ITEM(k) ((((k) % 3) << 9) + ((2 * xcd + (k) / 3) << 5) + rank)
          attn_issue((const bf16_t*)(ws_ + WS_ZB), ATT_ITEM(0), tid, pf, 7);
#pragma unroll 1
          for (int k = 0; k < 6; ++k) attn_item(p, lds, l, ATT_ITEM(k), pf, k < 5 ? ATT_ITEM(k + 1) : -1);
#undef ATT_ITEM
      } else {
          int it = blockIdx.x;
          if (it < 1536) attn_issue((const bf16_t*)(ws_ + WS_ZB), it, tid, pf, 7);
          for (; it < 1536; it += gridDim.x) { const int nx = it + (int)gridDim.x; attn_item(p, lds, l, it, pf, nx < 1536 ? nx : -1); }
      } }
    SP_SYNC(); SP_END(1); SP_BEGIN();
    for (int u = blockIdx.x; u < 256; u += gridDim.x) rnn_agg_unit(p, lds, l, xcd_unit(u));
    SP_SYNC(); SP_END(2);
    if (l == 0) convert_queue(p, lds, l, false);
}
__device__ __forceinline__ void ph_mix2(const Params& p, LAS unsigned char* lds, int l) {
    SP_DECL;
    for (int u = blockIdx.x; u < 256; u += gridDim.x) { SP_BEGIN(); rnn_final_unit(p, lds, l, xcd_unit(u)); SP_SYNC(); SP_END(6); SP_BEGIN(); attn_merge_unit(p, xcd_unit(u)); SP_SYNC(); SP_END(7); }
}
#define DYN_LDS extern __shared__ __attribute__((aligned(16))) unsigned char smem_[]; LAS unsigned char* lds = (LAS unsigned char*)smem_

#define XB_TMO      128
#define XB_XCNT(j)  (256  + 64 * (j))
#define XB_XSUB(j)  (1280 + 64 * (j))
#define XB_XGEN(j)  (2304 + 64 * (j))
#define XB_TOP      3328
#define XB_TOPGEN   3392
#define XCD_BAR_WORDS 3456
#define XB_SPIN_CAP (1u << 18)
__device__ __forceinline__ unsigned xb_ld(unsigned* p)              { return __hip_atomic_load(p, __ATOMIC_RELAXED, __HIP_MEMORY_SCOPE_AGENT); }
__device__ __forceinline__ unsigned xb_add(unsigned* p, unsigned v) { return __hip_atomic_fetch_add(p, v, __ATOMIC_RELAXED, __HIP_MEMORY_SCOPE_AGENT); }
__device__ __forceinline__ unsigned xb_xcc_id() { return (unsigned)__builtin_amdgcn_s_getreg((3 << 11) | 20) & 0xFu; }
#define XB_SPIN(cond, bar) do { unsigned _sp = 0; while (cond) { __builtin_amdgcn_s_sleep(1); \
    if ((++_sp & 255u) == 0u) { if (xb_ld(&(bar)[XB_TMO])) break; if (_sp > XB_SPIN_CAP) { atomicAdd(&(bar)[XB_TMO], 1u); break; } } } } while (0)
struct XcdBarrier { unsigned* bar; unsigned x; volatile LAS unsigned* st; };
__device__ __forceinline__ XcdBarrier xcd_barrier_post(unsigned* bar, volatile LAS unsigned* st) {
    XcdBarrier b; b.bar = bar; b.x = xb_xcc_id(); b.st = st;
    if (threadIdx.x == 0) (void)xb_add(&bar[XB_XCNT(b.x)], 1u);
    return b;
}
__device__ __forceinline__ void xcd_barrier_complete(unsigned* bar, unsigned x, unsigned& nloc, unsigned& nx, unsigned& stdc) {
    const unsigned G = gridDim.x * gridDim.y * gridDim.z;
    unsigned sum, cnt, mine, sd, sp = 0u;
    for (;;) {
        sum = 0u; cnt = 0u; mine = 0u; sd = 1u;
#pragma unroll
        for (unsigned j = 0; j < 16; ++j) { const unsigned c = xb_ld(&bar[XB_XCNT(j)]); sum += c; cnt += (c > 0u) ? 1u : 0u; mine = (j == x) ? c : mine; sd = (c == (j < 8u ? 32u : 0u)) ? sd : 0u; }
        if (sum == G) break;
        __builtin_amdgcn_s_sleep(1);
        if ((++sp & 255u) == 0u) { if (xb_ld(&bar[XB_TMO])) break; if (sp > XB_SPIN_CAP) { atomicAdd(&bar[XB_TMO], 1u); break; } }
    }
    nloc = mine > 0u ? mine : 1u; nx = cnt > 0u ? cnt : 1u; stdc = sd;
}
template <int NPW>
__device__ __forceinline__ void xcd_barrier(const XcdBarrier& b, const Params& p, int item_base, int dense_first = 0, int dense_lim = 0) {
    asm volatile("s_waitcnt vmcnt(0)" ::: "memory");
    __syncthreads();
    const int tid = opaque_tid();
    unsigned* bar = b.bar; unsigned old = 0u, gen = 0u, tg = 0u; bool last = false, fin = false;
    const unsigned bx = xb_xcc_id();
    if (tid == 0) {
        size_t zb_ = 0; asm volatile("" : "+s"(zb_)); bar = b.bar + zb_;
        __builtin_amdgcn_s_waitcnt(0);
        unsigned nloc = b.st[0], nx = b.st[1];
        if (nloc == 0u) { unsigned sd; xcd_barrier_complete(bar, bx, nloc, nx, sd); b.st[0] = nloc; b.st[1] = nx; b.st[2] = sd; }
        old = xb_add(&bar[XB_XSUB(bx)], 1u);
        gen = old / nloc;
        last = old + 1u == (gen + 1u) * nloc;
        b.st[3] = b.st[2] ? old - gen * nloc : 0xffffu;
        if (last) {
            __builtin_amdgcn_fence(__ATOMIC_RELEASE, "agent");
            asm volatile("s_waitcnt vmcnt(0)" ::: "memory");
            const unsigned og = xb_add(&bar[XB_TOP], 1u);
            tg = og / nx;
            fin = og + 1u == (tg + 1u) * nx;
            if (fin) xb_add(&bar[XB_TOPGEN], 1u);
        }
    }
    if (item_base >= 0) {
        __syncthreads();
        const unsigned rank = b.st[3];
        if (rank < (unsigned)SLOT_RANKS) {
            unsigned char* const ws_ = opaque_ptr(p.ws);
            const int lane = tid & 63, wave = tid >> 6;
            const int it0 = item_base + ((int)(bx * SLOT_RANKS + rank) * NWAVE + wave) * NPW;
#pragma unroll
            for (int i = 0; i + 2 <= NPW; i += 2) {
                TrItem ta, tb; dec_exp(p, ws_, it0 + i, ta); dec_exp(p, ws_, it0 + i + 1, tb);
                f32x4 va[8], vb[8]; float ga[8], gb[8];
                tr_load(ta, lane, va, ga); tr_load(tb, lane, vb, gb);
                tr_store8(ta, lane, va, ga, nullptr); tr_store8(tb, lane, vb, gb, nullptr); }
            if constexpr (NPW & 1) {
                TrItem t; dec_exp(p, ws_, it0 + NPW - 1, t);
                f32x4 v[8]; float g[8];
                tr_load(t, lane, v, g); tr_store8(t, lane, v, g, nullptr); }
            { const int di = dense_first + ((int)(bx * SLOT_RANKS + rank) * NWAVE + wave);
              if (di < dense_lim) { TrItem t; dec_dense(p, ws_, di, t); f32x4 v[8]; float g[8]; tr_load(t, lane, v, g); tr_store(t, lane, v, g, nullptr); } }
        }
    }
    if (tid == 0) {
        if (last) {
            if (!fin) XB_SPIN(xb_ld(&bar[XB_TOPGEN]) == tg, bar);
            __builtin_amdgcn_fence(__ATOMIC_ACQUIRE, "agent");
            xb_add(&bar[XB_XGEN(bx)], 1u);
            asm volatile("s_waitcnt vmcnt(0)" ::: "memory");
        } else {
            XB_SPIN(xb_ld(&bar[XB_XGEN(bx)]) == gen, bar);
            __builtin_amdgcn_fence(__ATOMIC_ACQUIRE, "agent");
            asm volatile("s_waitcnt vmcnt(0)" ::: "memory");
        }
    }
    __syncthreads();
}

__global__ void __launch_bounds__(512, 2) k_fused(Params p) {
    DYN_LDS;
    if (threadIdx.x < 64) ((LAS unsigned*)(lds + LDS_MISC))[threadIdx.x] = 0u;
    __syncthreads();
    XcdBarrier bar = xcd_barrier_post((unsigned*)(p.ws + WS_CTL), (volatile LAS unsigned*)(lds + LDS_MISC));
    const float* x_in = p.in[0]; float* X = p.out;
    const int* counts = (const int*)(p.ws + WS_CNT);
#ifndef PROBE_MASK
#define PROBE_MASK 0
#endif
#ifndef BARPROBE
#define BARPROBE 0
#endif
#if BARPROBE
#define BAR(id, j, ...) do { const unsigned long long tb_ = __builtin_amdgcn_s_memrealtime(); xcd_barrier<SLOT_N[j]>(bar, p, __VA_ARGS__); if (BARPROBE == (id)) bacc += __builtin_amdgcn_s_memrealtime() - tb_; } while (0)
#else
#define BAR(id, j, ...) xcd_barrier<SLOT_N[j]>(bar, p, __VA_ARGS__)
#endif
#if PROBE_MASK
    unsigned long long tacc = 0, tp = 0;
#define PH_BEGIN() tp = __builtin_amdgcn_s_memrealtime()
#define PH_END(g) do { if (PROBE_MASK & (1 << (g))) tacc += __builtin_amdgcn_s_memrealtime() - tp; } while (0)
#else
#define PH_BEGIN() do {} while (0)
#define PH_END(g) do {} while (0)
#endif
#if BARPROBE
    unsigned long long bacc = 0;
#endif
    PH_BEGIN();
    ph_prologue(p, lds, 3);
    ph_norm(p, lds, x_in, nullptr, 0, nullptr, true, -1);
    BAR(0, 3, slot_off(3)); PH_END(0);
    for (int l = 0; l < DEPTH; ++l) {
        const int cur = l * CONV_ITEMS, nxt = l + 1 < DEPTH ? (l + 1) * CONV_ITEMS : -(1 << 28);
        const int dn = l + 1 < DEPTH ? (l + 1) * PER_L : 0, dl = l + 1 < DEPTH ? dn + PER_L : 0;
        PH_BEGIN(); ph_win(p, lds, l);                               BAR(1, 4, cur + slot_off(4), dn, dl); PH_END(1);
        PH_BEGIN(); ph_mix1(p, lds, l);                              BAR(2, 5, cur + slot_off(5), dn + DSLOT, dl); PH_END(2);
        PH_BEGIN(); ph_mix2(p, lds, l);                              BAR(3, 6, cur + slot_off(6)); PH_END(3);
        PH_BEGIN(); ph_wout(p, lds, l);                              BAR(4, 7, cur + slot_off(7)); PH_END(1);
        PH_BEGIN(); ph_router(p, lds, l);                            BAR(5, 0, nxt + slot_off(0)); PH_END(4);
        PH_BEGIN(); ph_gateup(p, lds, l);                            BAR(6, 1, nxt + slot_off(1)); PH_END(5);
        PH_BEGIN(); ph_down(p, lds, l);                              BAR(7, 2, nxt + slot_off(2)); PH_END(5);
        PH_BEGIN(); ph_norm(p, lds, nullptr, X, 1, counts + l * NE * CNT_STRIDE, l < DEPTH - 1, -1);
        if (l < DEPTH - 1) BAR(8, 3, nxt + slot_off(3));
        PH_END(6);
    }
#if PROBE_MASK
    { const unsigned long long t0 = __builtin_amdgcn_s_memrealtime(); while (__builtin_amdgcn_s_memrealtime() - t0 < tacc) __builtin_amdgcn_s_sleep(8); }
#endif
#if BARPROBE
    { const unsigned long long t0 = __builtin_amdgcn_s_memrealtime(); while (__builtin_amdgcn_s_memrealtime() - t0 < bacc) __builtin_amdgcn_s_sleep(8); }
#endif
#if SUBPROBE
    { __syncthreads(); const unsigned long long tw = *(volatile LAS unsigned*)(lds + LDS_MISC + 64); const unsigned long long t0 = __builtin_amdgcn_s_memrealtime(); while (__builtin_amdgcn_s_memrealtime() - t0 < tw) __builtin_amdgcn_s_sleep(8); }
#endif
}
}

extern "C" void kernel_launch(void* const* d_in, const int* in_sizes, int n_in, void* d_out, int out_size, void* d_ws, size_t ws_size, hipStream_t stream) {
    static int grid = 0;
    if (!grid) {
        (void)hipFuncSetAttribute((const void*)k_fused, hipFuncAttributeMaxDynamicSharedMemorySize, LDS_BYTES);
        int dev = 0, cus = 0, per_cu = 0;
        (void)hipGetDevice(&dev); (void)hipDeviceGetAttribute(&cus, hipDeviceAttributeMultiprocessorCount, dev);
        (void)hipOccupancyMaxActiveBlocksPerMultiprocessor(&per_cu, (const void*)k_fused, 512, LDS_BYTES);
        if (per_cu < 1) fprintf(stderr, "kernel_launch: occupancy query reports %d blocks per CU\n", per_cu);
        (void)hipGetLastError();
        grid = cus > 0 ? cus : 256;
        if (ws_size < WS_END) fprintf(stderr, "kernel_launch: ws_size %zu smaller than expected\n", ws_size);
    }
    Params p{}; for (int i = 0; i < 24; ++i) p.in[i] = (const float*)d_in[i]; p.out = (float*)d_out; p.ws = (unsigned char*)d_ws;
    (void)hipMemsetAsync((unsigned char*)d_ws + WS_CTL, 0, CTL_ZERO, stream);
    k_fused<<<grid, 512, LDS_BYTES, stream>>>(p);
}
```

```cpp
#include <hip/hip_runtime.h>
#include <cstdio>
#include <cstdint>
#include <cmath>

namespace {
constexpr int BATCH = 2, SEQ = 8192, M = BATCH * SEQ, D = 1024, DEPTH = 4;
constexpr int NH = 8, HD = 64, DA = 512, DR = 512, DIN = 2560;
constexpr int NE = 32, EPG = 8, NG = 4, DE = 512;
constexpr float EPS = 1e-6f;

__device__ __forceinline__ float wave_sum(float v) {
#pragma unroll
    for (int o = 1; o < 64; o <<= 1) v += __shfl_xor(v, o);
    return v;
}

#define LAS __attribute__((address_space(3)))
typedef unsigned short bf16_t;
typedef short bf16x8 __attribute__((ext_vector_type(8)));
typedef short s16x4 __attribute__((ext_vector_type(4)));
typedef float f32x4 __attribute__((ext_vector_type(4)));
typedef float f32x16 __attribute__((ext_vector_type(16)));
typedef unsigned u32x4 __attribute__((ext_vector_type(4)));
typedef unsigned u32x2 __attribute__((ext_vector_type(2)));
__device__ __forceinline__ unsigned cvt_pk_bf16(float lo, float hi) { unsigned r; asm volatile("v_cvt_pk_bf16_f32 %0, %1, %2" : "=v"(r) : "v"(lo), "v"(hi)); return r; }
__device__ __forceinline__ float bf_lo(unsigned w) { return __uint_as_float(w << 16); }
__device__ __forceinline__ float bf_hi(unsigned w) { return __uint_as_float(w & 0xffff0000u); }
__device__ __forceinline__ float bf2f(bf16_t v) { return __uint_as_float(((unsigned)v) << 16); }

__device__ __forceinline__ int opaque_tid() { int t = threadIdx.x; asm volatile("" : "+v"(t)); return t; }
__device__ __forceinline__ unsigned char* opaque_ptr(unsigned char* w) { size_t z = 0; asm volatile("" : "+s"(z)); return w + z; }
__device__ __forceinline__ int opaque_bid() { int b = blockIdx.x; asm volatile("" : "+s"(b)); return b; }
__device__ __forceinline__ int xcd_unit(int c) { return gridDim.x == 256 ? 32 * (c & 7) + (c >> 3) : c; }
constexpr float LOG2E = 1.4426950408889634f;
constexpr size_t MiB = 1ull << 20;
constexpr size_t WS_CTL = 0, CTL_ZERO = 128 * 1024;
constexpr size_t WS_TCNT = 16 * 1024;
constexpr size_t WS_CONV = 60 * 1024;
constexpr size_t WS_CNT = 64 * 1024;
constexpr int CNT_STRIDE = 64;
constexpr size_t WS_BT = 1 * MiB;
constexpr size_t WS_BND = 1 * MiB + 32 * 1024;
constexpr size_t WS_GQK = 1 * MiB + 64 * 1024;
constexpr size_t WS_SPL = 1 * MiB + 128 * 1024;
constexpr size_t WS_RTT = 2 * MiB;
constexpr size_t WS_WAT = 3 * MiB;
constexpr size_t WS_WIN = 4 * MiB;
constexpr size_t WS_WOUT = 24 * MiB;
constexpr size_t WS_WGU = 32 * MiB;
constexpr size_t WS_WD = 288 * MiB;
constexpr size_t WS_HN = 416 * MiB;
constexpr size_t WS_ZB = 448 * MiB;
constexpr size_t WS_OB = 528 * MiB;
constexpr size_t WS_LSE = 576 * MiB;
constexpr size_t WS_AGG = 578 * MiB;
constexpr size_t WS_MIX = 580 * MiB;
constexpr size_t WS_TOK = 612 * MiB;
constexpr size_t WS_LIST = 613 * MiB;
constexpr size_t WS_ACT = 616 * MiB;
constexpr size_t WS_Y = 656 * MiB;
constexpr size_t WS_AD = 736 * MiB;
constexpr size_t WS_RSTD = 1 * MiB + 256 * 1024;
constexpr size_t WS_XB = 768 * MiB;
constexpr size_t WS_END = 800 * MiB;
constexpr int MAXTILES = 160;
constexpr int LDS_BYTES = 160 * 1024;
constexpr int LDS_STAGE = 0;
constexpr int LDS_TAB = 131072;
constexpr int LDS_MISC = LDS_BYTES - 256;

#ifndef SUBPROBE
#define SUBPROBE 0
#endif
#if SUBPROBE
#define SP_DECL unsigned long long sp_t0_ = 0
#define SP_BEGIN() sp_t0_ = __builtin_amdgcn_s_memrealtime()
#define SP_SYNC() __syncthreads()
#define SP_END(id) do { if (SUBPROBE == (id) && threadIdx.x == 0) { volatile LAS unsigned* w_ = (volatile LAS unsigned*)(lds + LDS_MISC + 64); *w_ = *w_ + (unsigned)(__builtin_amdgcn_s_memrealtime() - sp_t0_); } } while (0)
#else
#define SP_DECL do {} while (0)
#define SP_SYNC() do {} while (0)
#define SP_BEGIN() do {} while (0)
#define SP_END(id) do {} while (0)
#endif
namespace pg8 {
constexpr int BM = 256, BK = 64, HALF = 128, HTB = HALF * BK * 2, STAGE_BYTES = 8 * HTB, NXCD = 8, WGM = 8;
__host__ __device__ __forceinline__ int lds_byte(int r, int c) { const int st = (r >> 4) * 2 + (c >> 5), rr = r & 15, cc = c & 31, ob = rr * 64 + cc * 2; return st * 1024 + (ob ^ (((ob >> 9) & 1) << 5)); }
__host__ __device__ __forceinline__ void stage_rc(int b, int& R, int& C) { const int st = b / 1024, sb = b % 1024, swz = sb ^ (((sb >> 9) & 1) << 5); R = (st >> 1) * 16 + swz / 64; C = (st & 1) * 32 + (swz % 64) / 2; }
__host__ __device__ __forceinline__ int perm32(int rho) { const int n = rho >> 4, i = rho & 15; return 8 * (i >> 2) + 4 * n + (i & 3); }

struct Unit { int pm, pn; const char* a; const char* b; const int* glist; int gcount; };

struct StaticOrder {
    int nM, nN, nwg, G, c; const char* A; const char* Bt; size_t tA, tB;
    __device__ void init(const bf16_t* A_, const bf16_t* Bt_, int M_, int N_, int K_, int G_, int c_) { nM = M_ / BM; nN = N_ / BM; nwg = nM * nN; G = G_; c = c_; A = (const char*)A_; Bt = (const char*)Bt_; tA = (size_t)BM * K_ * 2; tB = tA; }
    __device__ bool next(int i, Unit& u) const {
        const long L = (long)i * G + c; if (L >= nwg) return false;
        int wgid = (int)L; { const int q = nwg / NXCD, r = nwg % NXCD, xcd = wgid % NXCD, off = wgid / NXCD; wgid = (xcd < r ? xcd * (q + 1) : r * (q + 1) + (xcd - r) * q) + off; }
        const int nig = WGM * nN, gid = wgid / nig, fm = gid * WGM, gsz = (nM - fm) < WGM ? (nM - fm) : WGM;
        u.pm = fm + ((wgid % nig) % gsz); u.pn = (wgid % nig) / gsz; u.a = A + (size_t)u.pm * tA; u.b = Bt + (size_t)u.pn * tB; u.glist = nullptr; u.gcount = 0; return true;
    }    __device__ __forceinline__ void a_ready(const Unit&, int) const {}
    __device__ __forceinline__ void done(const Unit&, int) const {}
};
struct MoeOrder {
    int G, c, ntiles; const LAS int* tile_e; const LAS int* tile_r0; const LAS int* cnt;
    const char* A; size_t tA; const char* W; size_t estride, tB; const int* list; int Mrows;
    __device__ bool next(int i, Unit& u) const {
        const int L = i * G + c; if (L >= ntiles * 4) return false;
        const int gt = L >> 2, e = __builtin_amdgcn_readfirstlane(tile_e[gt]), r0 = __builtin_amdgcn_readfirstlane(tile_r0[gt]);
        u.pm = gt; u.pn = L & 3; u.a = A + (size_t)gt * tA; u.b = W + (size_t)e * estride + (size_t)u.pn * tB;
        u.glist = list + (size_t)e * Mrows + r0; u.gcount = __builtin_amdgcn_readfirstlane(cnt[e]) - r0; return true;
    }
    unsigned* pub; unsigned* wait; unsigned need; unsigned* tmo;
    __device__ __forceinline__ void done(const Unit& u, int lane) const {
        if (pub) { asm volatile("s_waitcnt vmcnt(0)" ::: "memory");
            if (lane == 0) __hip_atomic_fetch_add(pub + 16 * u.pm, 1u, __ATOMIC_RELAXED, __HIP_MEMORY_SCOPE_AGENT); }
    }
    __device__ __forceinline__ void a_ready(const Unit& u, int tid) const {
        if (!wait) return;
        if (tid < 64) {
            const unsigned long long t0 = __builtin_amdgcn_s_memrealtime(); unsigned polls = 0;
            while ((unsigned)__builtin_amdgcn_readfirstlane(__hip_atomic_load(wait + 16 * u.pm, __ATOMIC_RELAXED, __HIP_MEMORY_SCOPE_AGENT)) < need) {
                if ((++polls & 255u) == 0u && __builtin_amdgcn_readfirstlane(__hip_atomic_load(tmo, __ATOMIC_RELAXED, __HIP_MEMORY_SCOPE_AGENT)) != 0u) break;
                if (__builtin_amdgcn_s_memrealtime() - t0 > 2000000ull) { if (tid == 0) __hip_atomic_store(tmo, 1u, __ATOMIC_RELAXED, __HIP_MEMORY_SCOPE_AGENT); break; }
                __builtin_amdgcn_s_sleep(2); }
            __builtin_amdgcn_fence(__ATOMIC_ACQUIRE, "agent");
            asm volatile("s_waitcnt vmcnt(0)" ::: "memory");
        }
        asm volatile("" ::: "memory"); __builtin_amdgcn_s_barrier(); asm volatile("" ::: "memory");
    }
};

typedef int i32x8 __attribute__((ext_vector_type(8)));
typedef int i32x4 __attribute__((ext_vector_type(4)));
template <class Epi, class Sched, bool GATHER, bool FP8 = false, int SCW = 0x7f7f7f7f, int SCX = 0x7f7f7f7f, bool IDENT = false, int KSH = 0  >
__device__ __forceinline__ void gemm_phase(LAS unsigned char* lds, const void* Abase, int KB, const Sched& S, const Epi& E) {
    const int tid = opaque_tid(), wid = __builtin_amdgcn_readfirstlane(tid >> 6), lane = tid & 63, wr = wid >> 2, wc = wid & 3, fr = lane & 15, fq = lane >> 4;
    asm volatile("" : "+s"(KB));
    const int nt = KB / 128;
    const size_t kstep = (size_t)(BK * 2);
    const unsigned hstep = (unsigned)HALF * KB;
    unsigned voffB[2]; int RA[2], CA[2];
#pragma unroll
    for (int i = 0; i < 2; ++i) { int R, C; stage_rc(tid * 16 + i * 8192, R, C); const int Rb = Epi::PERM ? ((R & ~31) + perm32(R & 31)) : R;
        RA[i] = R; CA[i] = C; voffB[i] = (unsigned)(Rb * KB + C * 2); }
    const unsigned ldsw = (unsigned)wid * 1024u;
    const int aoff = lds_byte(wr * 64 + fr, fq * 8), boff = lds_byte(wc * 32 + fr, fq * 8);
#define PG8_SA(b, h) (((b) * 2 + (h)) * HTB)
#define PG8_SB(b, h) ((4 + (b) * 2 + (h)) * HTB)
#define PG8_GLDS(src, dstoff) __builtin_amdgcn_global_load_lds((const unsigned*)(src), (LAS unsigned*)(lds + (dstoff)), 16, 0, 0)
#define PG8_STAGE_B(bufoff, gbase, h) do { _Pragma("unroll") for (int _i = 0; _i < 2; ++_i) PG8_GLDS((const char*)(gbase) + (size_t)((h) * hstep) + voffB[_i], (bufoff) + ldsw + _i * 8192); } while (0)
#define PG8_STAGE_A(bufoff, gbase, h) do { _Pragma("unroll") for (int _i = 0; _i < 2; ++_i) { \
        if constexpr (GATHER) PG8_GLDS((const char*)(gbase) + oc[h][_i], (bufoff) + ldsw + _i * 8192); \
        else PG8_GLDS((const char*)(gbase) + (size_t)((h) * hstep) + oc[0][_i], (bufoff) + ldsw + _i * 8192); } } while (0)
#define PG8_LDA(dst, b, h) do { _Pragma("unroll") for (int m = 0; m < 4; ++m) _Pragma("unroll") for (int k = 0; k < 2; ++k) dst[m][k] = *(const LAS bf16x8*)(lds + PG8_SA(b, h) + aoff + m * 2048 + k * 1024); } while (0)
#define PG8_LDB(dst, b, h) do { _Pragma("unroll") for (int n = 0; n < 2; ++n) _Pragma("unroll") for (int k = 0; k < 2; ++k) dst[n][k] = *(const LAS bf16x8*)(lds + PG8_SB(b, h) + boff + n * 2048 + k * 1024); } while (0)
#define PG8_CAT(x) __builtin_shufflevector(__builtin_bit_cast(i32x4, (x)[0]), __builtin_bit_cast(i32x4, (x)[1]), 0, 1, 2, 3, 4, 5, 6, 7)
#define PG8_MMA(ai, bj, At, Bt) do { if ((ai) == 1 ? skipB : skipA) break; __builtin_amdgcn_s_setprio(1); \
        if constexpr (FP8) { _Pragma("unroll") for (int m = 0; m < 4; ++m) _Pragma("unroll") for (int n = 0; n < 2; ++n) \
            acc[ai][bj][m][n] = __builtin_amdgcn_mfma_scale_f32_16x16x128_f8f6f4(PG8_CAT(Bt[n]), PG8_CAT(At[m]), acc[ai][bj][m][n], 0, 0, 0, SCW, 0, SCX); } \
        else { _Pragma("unroll") for (int m = 0; m < 4; ++m) _Pragma("unroll") for (int n = 0; n < 2; ++n) _Pragma("unroll") for (int k = 0; k < 2; ++k) \
            acc[ai][bj][m][n] = __builtin_amdgcn_mfma_f32_16x16x32_bf16(Bt[n][k], At[m][k], acc[ai][bj][m][n], 0, 0, 0); } \
        __builtin_amdgcn_s_setprio(0); } while (0)
#define PG8_WAIT_V(n) asm volatile("s_waitcnt vmcnt(" #n ")" ::: "memory")
#define PG8_WAIT_L(n) asm volatile("s_waitcnt lgkmcnt(" #n ")" ::: "memory")
#define PG8_BAR __builtin_amdgcn_s_barrier()
#define PG8_SCHED __builtin_amdgcn_sched_barrier(0)
#define PG8_AOFF(dst, u) do { if constexpr (GATHER) { _Pragma("unroll") for (int _h = 0; _h < 2; ++_h) _Pragma("unroll") for (int _i = 0; _i < 2; ++_i) { \
            const int _r = _h * HALF + RA[_i]; const int _t = IDENT ? ((u).pm * BM + _r) : ((_r < (u).gcount) ? (u).glist[_r] : 0); dst[_h][_i] = ((unsigned)_t << KSH) + (unsigned)(CA[_i] * 2); } \
            asm volatile("" : "+v"(dst[0][0]), "+v"(dst[0][1]), "+v"(dst[1][0]), "+v"(dst[1][1])); } \
        else { _Pragma("unroll") for (int _h = 0; _h < 2; ++_h) _Pragma("unroll") for (int _i = 0; _i < 2; ++_i) dst[_h][_i] = (unsigned)(RA[_i] * KB + CA[_i] * 2); } } while (0)
    Unit cur, nxt; int ui = 0;
    if (!S.next(0, cur)) return;
    f32x4 acc[2][2][4][2];
#pragma unroll
    for (int a = 0; a < 2; ++a)
#pragma unroll
        for (int b = 0; b < 2; ++b)
#pragma unroll
            for (int m = 0; m < 4; ++m)
#pragma unroll
                for (int n = 0; n < 2; ++n) acc[a][b][m][n] = (f32x4){0.f, 0.f, 0.f, 0.f};
    bf16x8 At[4][2], B0[2][2], B1[2][2];
    unsigned oc[2][2], on[2][2];
    bool skipB = GATHER && cur.gcount <= 128, skipA = GATHER && cur.gcount <= 64 && wr == 1;
    S.a_ready(cur, tid);
    PG8_AOFF(oc, cur);
    const char* cA = GATHER ? (const char*)Abase : cur.a; const char* cB = cur.b;
    PG8_STAGE_B(PG8_SB(0, 0), cB, 0); PG8_STAGE_B(PG8_SB(0, 1), cB, 1); PG8_STAGE_A(PG8_SA(0, 0), cA, 0); PG8_STAGE_A(PG8_SA(0, 1), cA, 1);
    if (wr == 1) PG8_BAR;
    PG8_WAIT_V(2); PG8_BAR;
    PG8_STAGE_B(PG8_SB(1, 0), cB + kstep, 0); PG8_STAGE_A(PG8_SA(1, 0), cA + kstep, 0); PG8_STAGE_B(PG8_SB(1, 1), cB + kstep, 1);
    PG8_WAIT_V(6); PG8_BAR;
    for (;;) {
        const bool has_next = S.next(ui + 1, nxt);
        const char* nA; const char* nB;
        if (has_next) { nA = GATHER ? (const char*)Abase : nxt.a; nB = nxt.b; if constexpr (GATHER) PG8_AOFF(on, nxt); }
        else { nA = cA; nB = cB;
            if constexpr (GATHER) {
#pragma unroll
                for (int h = 0; h < 2; ++h)
#pragma unroll
                    for (int i = 0; i < 2; ++i) on[h][i] = oc[h][i]; } }
#pragma unroll 1
        for (int t = 0; t < nt; t += 2) {
            const bool last = (t == nt - 2);
            if (last && has_next) S.a_ready(nxt, tid);
            const char* a1 = cA + (size_t)(t + 1) * kstep;
            const char* a2 = last ? nA : cA + (size_t)(t + 2) * kstep; const char* b2 = last ? nB : cB + (size_t)(t + 2) * kstep;
            const char* a3 = a2 + kstep; const char* b3 = b2 + kstep;
            PG8_LDB(B0, 0, 0); PG8_LDB(B1, 0, 1); PG8_SCHED; PG8_LDA(At, 0, 0); PG8_STAGE_A(PG8_SA(1, 1), a1, 1);
            if constexpr (GATHER) { if (last) {
#pragma unroll
                for (int h = 0; h < 2; ++h)
#pragma unroll
                    for (int i = 0; i < 2; ++i) oc[h][i] = on[h][i]; } }
            PG8_WAIT_V(8); PG8_WAIT_L(0); PG8_BAR; PG8_MMA(0, 0, At, B0); PG8_MMA(0, 1, At, B1); PG8_BAR; PG8_SCHED;
            PG8_LDA(At, 0, 1); PG8_STAGE_B(PG8_SB(0, 0), b2, 0); PG8_STAGE_B(PG8_SB(0, 1), b2, 1); PG8_STAGE_A(PG8_SA(0, 0), a2, 0);
            PG8_WAIT_V(8); PG8_WAIT_L(0); PG8_BAR; PG8_MMA(1, 0, At, B0); PG8_MMA(1, 1, At, B1); PG8_BAR; PG8_SCHED;
            PG8_LDB(B0, 1, 0); PG8_LDB(B1, 1, 1); PG8_SCHED; PG8_LDA(At, 1, 0); PG8_STAGE_A(PG8_SA(0, 1), a2, 1);
            PG8_WAIT_V(8); PG8_WAIT_L(0); PG8_BAR; PG8_MMA(0, 0, At, B0); PG8_MMA(0, 1, At, B1); PG8_BAR; PG8_SCHED;
            PG8_LDA(At, 1, 1); PG8_STAGE_B(PG8_SB(1, 0), b3, 0); PG8_STAGE_B(PG8_SB(1, 1), b3, 1); PG8_STAGE_A(PG8_SA(1, 0), a3, 0);
            PG8_WAIT_V(8); PG8_WAIT_L(0); PG8_BAR; PG8_MMA(1, 0, At, B0); PG8_MMA(1, 1, At, B1); PG8_BAR; PG8_SCHED;
        }
        if (wr == 0) PG8_BAR;
        E(acc, cur, wr, wc, fr, fq); S.done(cur, lane);
        if (!has_next) break;
#pragma unroll
        for (int a = 0; a < 2; ++a)
#pragma unroll
            for (int b = 0; b < 2; ++b)
#pragma unroll
                for (int m = 0; m < 4; ++m)
#pragma unroll
                    for (int n = 0; n < 2; ++n) acc[a][b][m][n] = (f32x4){0.f, 0.f, 0.f, 0.f};
        cur = nxt; cA = nA; cB = nB; ++ui;
        skipB = GATHER && cur.gcount <= 128; skipA = GATHER && cur.gcount <= 64 && wr == 1;
        if (wr == 1) PG8_BAR;
    }
    PG8_WAIT_V(0);
    PG8_BAR;
#undef PG8_SA
#undef PG8_SB
#undef PG8_STAGE_A
#undef PG8_STAGE_B
#undef PG8_GLDS
#undef PG8_LDA
#undef PG8_LDB
#undef PG8_MMA
#undef PG8_CAT
#undef PG8_WAIT_V
#undef PG8_WAIT_L
#undef PG8_BAR
#undef PG8_SCHED
#undef PG8_AOFF
}


struct EpiQKV {
    static constexpr bool PERM = true;
    bf16_t* ZB; const LAS float* gqk; const float* rstd;
    __device__ __forceinline__ void operator()(const f32x4 (&acc)[2][2][4][2], const Unit& u, int wr, int wc, int fr, int fq) const {
        const int type = u.pn >> 1;
        f32x4 g[2][2];
        if (type == 0) {
#pragma unroll
            for (int bj = 0; bj < 2; ++bj)
#pragma unroll
                for (int n = 0; n < 2; ++n) g[bj][n] = *(const LAS f32x4*)(gqk + 32 * bj + 8 * fq + 4 * n);
        }
#pragma unroll
        for (int ai = 0; ai < 2; ++ai)
#pragma unroll
            for (int m = 0; m < 4; ++m) {
                const int row = u.pm * BM + ai * HALF + wr * 64 + m * 16 + fr;
                f32x4 v[2][2]; const float rs = rstd[row];
#pragma unroll
                for (int bj = 0; bj < 2; ++bj)
#pragma unroll
                    for (int n = 0; n < 2; ++n) v[bj][n] = acc[ai][bj][m][n] * rs;
                if (type < 2) {
                    float ss = 0.f;
#pragma unroll
                    for (int bj = 0; bj < 2; ++bj)
#pragma unroll
                        for (int n = 0; n < 2; ++n) ss += (v[bj][n][0] * v[bj][n][0] + v[bj][n][1] * v[bj][n][1]) + (v[bj][n][2] * v[bj][n][2] + v[bj][n][3] * v[bj][n][3]);
                    ss += __shfl_xor(ss, 16); ss += __shfl_xor(ss, 32);
                    const float rstd = rsqrtf(ss * (1.0f / 64.0f) + 1e-6f);
#pragma unroll
                    for (int bj = 0; bj < 2; ++bj)
#pragma unroll
                        for (int n = 0; n < 2; ++n) { v[bj][n] = v[bj][n] * rstd; if (type == 0) v[bj][n] = v[bj][n] * g[bj][n]; }
                }
                bf16_t* rowp = ZB + (size_t)row * 2560 + u.pn * BM + wc * 64 + 8 * fq;
#pragma unroll
                for (int bj = 0; bj < 2; ++bj) { u32x4 w; w.x = cvt_pk_bf16(v[bj][0][0], v[bj][0][1]); w.y = cvt_pk_bf16(v[bj][0][2], v[bj][0][3]); w.z = cvt_pk_bf16(v[bj][1][0], v[bj][1][1]); w.w = cvt_pk_bf16(v[bj][1][2], v[bj][1][3]);
                    *(u32x4*)(rowp + 32 * bj) = w; }
            }
    }
};
struct EpiRes {
    static constexpr bool PERM = false;
    const float* base; float* out; int ldc;
    __device__ __forceinline__ void operator()(const f32x4 (&acc)[2][2][4][2], const Unit& u, int wr, int wc, int fr, int fq) const {
        const int row0 = u.pm * BM + wr * 64 + fr, col0 = u.pn * BM + wc * 32 + 4 * fq;
#pragma unroll
        for (int ai = 0; ai < 2; ++ai)
#pragma unroll
            for (int m = 0; m < 4; ++m) { const size_t off = (size_t)(row0 + ai * HALF + m * 16) * ldc + col0;
#pragma unroll
                for (int bj = 0; bj < 2; ++bj)
#pragma unroll
                    for (int n = 0; n < 2; ++n) { const f32x4 bs = *(const f32x4*)(base + off + bj * HALF + n * 16); *(f32x4*)(out + off + bj * HALF + n * 16) = bs + acc[ai][bj][m][n]; }
                asm volatile("" ::: "memory"); }
    }
};
struct EpiSwiGLU {
    static constexpr bool PERM = true;
    bf16_t* ACT;
    __device__ __forceinline__ void operator()(const f32x4 (&acc)[2][2][4][2], const Unit& u, int wr, int wc, int fr, int fq) const {
#pragma unroll
        for (int ai = 0; ai < 2; ++ai)
#pragma unroll
            for (int m = 0; m < 4; ++m) {
                const int row = u.pm * BM + ai * HALF + wr * 64 + m * 16 + fr;
                float o[8];
#pragma unroll
                for (int n = 0; n < 2; ++n)
#pragma unroll
                    for (int j = 0; j < 4; ++j) { const float gv = acc[ai][0][m][n][j], uv = acc[ai][1][m][n][j];
                        o[n * 4 + j] = gv * __builtin_amdgcn_rcpf(1.0f + __builtin_amdgcn_exp2f(-gv * LOG2E)) * uv; }
                u32x4 w; w.x = cvt_pk_bf16(o[0], o[1]); w.y = cvt_pk_bf16(o[2], o[3]); w.z = cvt_pk_bf16(o[4], o[5]); w.w = cvt_pk_bf16(o[6], o[7]);
                *(u32x4*)(ACT + (size_t)row * 512 + u.pn * 128 + wc * 32 + 8 * fq) = w;
            }
    }
};
struct EpiSwiGLU8 {
    static constexpr bool PERM = true;
    unsigned char* ACT;
    __device__ __forceinline__ void operator()(const f32x4 (&acc)[2][2][4][2], const Unit& u, int wr, int wc, int fr, int fq) const {
#pragma unroll
        for (int ai = 0; ai < 2; ++ai)
#pragma unroll
            for (int m = 0; m < 4; ++m) {
                const int row = u.pm * BM + ai * HALF + wr * 64 + m * 16 + fr;
                float o[8];
#pragma unroll
                for (int n = 0; n < 2; ++n)
#pragma unroll
                    for (int j = 0; j < 4; ++j) { const float gv = acc[ai][0][m][n][j], uv = acc[ai][1][m][n][j];
                        o[n * 4 + j] = __builtin_amdgcn_fmed3f(8.0f * gv * __builtin_amdgcn_rcpf(1.0f + __builtin_amdgcn_exp2f(-gv * LOG2E)) * uv, -448.0f, 448.0f); }
                int w0 = 0, w1 = 0;
                w0 = __builtin_amdgcn_cvt_pk_fp8_f32(o[0], o[1], w0, false); w0 = __builtin_amdgcn_cvt_pk_fp8_f32(o[2], o[3], w0, true);
                w1 = __builtin_amdgcn_cvt_pk_fp8_f32(o[4], o[5], w1, false); w1 = __builtin_amdgcn_cvt_pk_fp8_f32(o[6], o[7], w1, true);
                *(u32x2*)(ACT + (size_t)row * 512 + u.pn * 128 + wc * 32 + 8 * fq) = (u32x2){(unsigned)w0, (unsigned)w1};
            }
    }
};
struct EpiBf16 {
    static constexpr bool PERM = true;
    bf16_t* O; int ldc;
    __device__ __forceinline__ void operator()(const f32x4 (&acc)[2][2][4][2], const Unit& u, int wr, int wc, int fr, int fq) const {
        const int row0 = u.pm * BM + wr * 64 + fr, col0 = u.pn * BM + wc * 32 + 8 * fq;
#pragma unroll
        for (int ai = 0; ai < 2; ++ai)
#pragma unroll
            for (int m = 0; m < 4; ++m) { bf16_t* rowp = O + (size_t)(row0 + ai * HALF + m * 16) * ldc + col0;
#pragma unroll
                for (int bj = 0; bj < 2; ++bj) { const f32x4 v0 = acc[ai][bj][m][0], v1 = acc[ai][bj][m][1];
                    u32x4 w; w.x = cvt_pk_bf16(v0[0], v0[1]); w.y = cvt_pk_bf16(v0[2], v0[3]); w.z = cvt_pk_bf16(v1[0], v1[1]); w.w = cvt_pk_bf16(v1[2], v1[3]);
                    *(u32x4*)(rowp + bj * HALF) = w; } }
    }
};
struct EpiResB {
    static constexpr bool PERM = true;
    const bf16_t* base; bf16_t* out; int ldc;
    __device__ __forceinline__ void operator()(const f32x4 (&acc)[2][2][4][2], const Unit& u, int wr, int wc, int fr, int fq) const {
        const int row0 = u.pm * BM + wr * 64 + fr, col0 = u.pn * BM + wc * 32 + 8 * fq;
#pragma unroll
        for (int ai = 0; ai < 2; ++ai)
#pragma unroll
            for (int m = 0; m < 4; ++m) { const size_t off = (size_t)(row0 + ai * HALF + m * 16) * ldc + col0;
#pragma unroll
                for (int bj = 0; bj < 2; ++bj) { const f32x4 v0 = acc[ai][bj][m][0], v1 = acc[ai][bj][m][1]; const u32x4 b = *(const u32x4*)(base + off + bj * HALF);
                    u32x4 w; w.x = cvt_pk_bf16(bf_lo(b.x) + v0[0], bf_hi(b.x) + v0[1]); w.y = cvt_pk_bf16(bf_lo(b.y) + v0[2], bf_hi(b.y) + v0[3]);
                    w.z = cvt_pk_bf16(bf_lo(b.z) + v1[0], bf_hi(b.z) + v1[1]); w.w = cvt_pk_bf16(bf_lo(b.w) + v1[2], bf_hi(b.w) + v1[3]);
                    *(u32x4*)(out + off + bj * HALF) = w; }
                asm volatile("" ::: "memory"); }
    }
};
}

struct Params { const float* in[24]; float* out; unsigned char* ws; };
#define LDS_WAIT() asm volatile("s_waitcnt lgkmcnt(0)" ::: "memory")
constexpr int NTHR = 512, NWAVE = 8;

struct TrItem { const float* W; int K, N; bf16_t* WT; int drow, k0, n0; const float* gain; int f8; };
__device__ __forceinline__ void tr_load(const TrItem& t, int lane, f32x4 (&v)[8], float (&g)[8]) {
    const int r8 = lane >> 3, ch = lane & 7;
#pragma unroll
    for (int i = 0; i < 8; ++i) v[i] = *(const f32x4*)(t.W + (size_t)(t.k0 + 8 * r8 + i) * t.N + t.n0 + 4 * ch);
    if (t.gain) { const f32x4 g0 = *(const f32x4*)(t.gain + t.k0 + 8 * r8), g1 = *(const f32x4*)(t.gain + t.k0 + 8 * r8 + 4);
        g[0] = g0[0]; g[1] = g0[1]; g[2] = g0[2]; g[3] = g0[3]; g[4] = g1[0]; g[5] = g1[1]; g[6] = g1[2]; g[7] = g1[3]; }
    else {
#pragma unroll
        for (int i = 0; i < 8; ++i) g[i] = 1.0f; }
}
__device__ __forceinline__ void tr_store(const TrItem& t, int lane, const f32x4 (&v)[8], const float (&g)[8], LAS float* scr) {
    (void)scr; const int r8 = lane >> 3, ch = lane & 7;
#pragma unroll
    for (int j = 0; j < 4; ++j) {
        u32x4 o; o.x = cvt_pk_bf16(v[0][j] * g[0], v[1][j] * g[1]); o.y = cvt_pk_bf16(v[2][j] * g[2], v[3][j] * g[3]); o.z = cvt_pk_bf16(v[4][j] * g[4], v[5][j] * g[5]); o.w = cvt_pk_bf16(v[6][j] * g[6], v[7][j] * g[7]);
        *(u32x4*)(t.WT + (size_t)(t.drow + 4 * ch + j) * t.K + t.k0 + 8 * r8) = o; }
}
__device__ __forceinline__ void tr_store8(const TrItem& t, int lane, const f32x4 (&v)[8], const float (&g)[8], LAS float* scr) {
    (void)scr; const int r8 = lane >> 3, ch = lane & 7;
#pragma unroll
    for (int j = 0; j < 4; ++j) {
        int w0 = 0, w1 = 0;
        w0 = __builtin_amdgcn_cvt_pk_fp8_f32(v[0][j] * (g[0] * 64.0f), v[1][j] * (g[1] * 64.0f), w0, false); w0 = __builtin_amdgcn_cvt_pk_fp8_f32(v[2][j] * (g[2] * 64.0f), v[3][j] * (g[3] * 64.0f), w0, true);
        w1 = __builtin_amdgcn_cvt_pk_fp8_f32(v[4][j] * (g[4] * 64.0f), v[5][j] * (g[5] * 64.0f), w1, false); w1 = __builtin_amdgcn_cvt_pk_fp8_f32(v[6][j] * (g[6] * 64.0f), v[7][j] * (g[7] * 64.0f), w1, true);
        *(u32x2*)((unsigned char*)t.WT + (size_t)(t.drow + 4 * ch + j) * t.K + t.k0 + 8 * r8) = (u32x2){(unsigned)w0, (unsigned)w1}; }
}
__device__ __forceinline__ int t5_bucket_d(int dist) {
    if (dist < 16) return dist;
    int lb = 16 + (int)(logf((float)dist / 16.f) / logf(128.f) * 16.f);
    return lb < 31 ? lb : 31;
}
constexpr int I_IN = 16 * 80, I_OUT = 16 * 32, I_G = 16 * 16, I_D = 8 * 32, I_E = 2 * I_G + I_D, PER_L = I_IN + I_OUT;
constexpr int CONV_ITEMS = NE * I_E;
#ifndef CONV_Q_WIN
#define CONV_Q_WIN 6
#endif
#ifndef CONV_Q_GU
#define CONV_Q_GU 0
#endif
#ifndef CONV_Q_DN
#define CONV_Q_DN 0
#endif
#ifndef SLOT_RANKS
#define SLOT_RANKS 24
#endif
constexpr int SLOT1 = 8 * SLOT_RANKS * NWAVE;
#ifndef SLOT_CFG
#define SLOT_CFG {1, 3, 2, 2, 3, 2, 2, 1}
#endif
constexpr int SLOT_N[8] = SLOT_CFG;
constexpr int slot_off(int j) { int o = 0; for (int i = 0; i < j; ++i) o += SLOT_N[i] * SLOT1; return o; }
constexpr int CONV_HEAD = slot_off(8);
static_assert(CONV_HEAD == NE * I_E, "the eight barrier slots cover a layer's expert weights exactly");
constexpr int CONV_Q0 = slot_off(3);
constexpr int DSLOT = SLOT1;
__device__ __forceinline__ void dec_dense(const Params& p, unsigned char* ws_, int it, TrItem& t) {
        const int l = it / PER_L; int r = it % PER_L;
        if (r < I_IN) { const int kb = r / 80, nb = r % 80, n0 = nb * 32, o = n0 & 255;
            t.W = p.in[3] + (size_t)l * D * DIN; t.K = D; t.N = DIN; t.WT = (bf16_t*)(ws_ + WS_WIN) + (size_t)l * DIN * D; t.drow = (n0 & ~255) + 128 * ((o >> 5) & 1) + 32 * ((o >> 6) & 3); t.k0 = kb * 64; t.n0 = n0; t.gain = p.in[2] + l * D; }
        else { r -= I_IN; const int kb = r / 32, nb = r % 32;
            t.W = p.in[15] + (size_t)l * D * D; t.K = D; t.N = D; t.WT = (bf16_t*)(ws_ + WS_WOUT) + (size_t)l * D * D; t.drow = nb * 32; t.k0 = kb * 64; t.n0 = nb * 32; t.gain = kb < 8 ? p.in[13] + l * DA : p.in[14] + l * DR - DA; }
}
__device__ __forceinline__ void dec_exp(const Params& p, unsigned char* ws_, int it, TrItem& t) {
        const int le = it / I_E; int r = it % I_E; const int l = le / NE;
        if (r < 2 * I_G) { const int up = r >= I_G; if (up) r -= I_G; const int kb = r / 16, nb = r % 16, n0 = nb * 32;
            t.W = (up ? p.in[22] : p.in[21]) + (size_t)le * D * DE; t.K = D; t.N = DE; t.WT = (bf16_t*)(ws_ + WS_WGU + (size_t)le * D * D); t.drow = 256 * (n0 >> 7) + 128 * up + (n0 & 127); t.k0 = kb * 64; t.n0 = n0; t.gain = p.in[16] + l * D; t.f8 = 1; }
        else { r -= 2 * I_G; const int kb = r / 32, nb = r % 32;
            t.W = p.in[23] + (size_t)le * DE * D; t.K = DE; t.N = D; t.WT = (bf16_t*)(ws_ + WS_WD + (size_t)le * D * DE); t.drow = nb * 32; t.k0 = kb * 64; t.n0 = nb * 32; t.gain = nullptr; t.f8 = 1; }
}
__device__ __forceinline__ void ph_prologue(const Params& p, LAS unsigned char* lds, int which) {
    unsigned char* const ws_ = opaque_ptr(p.ws);
    const int tid = opaque_tid(), lane = tid & 63, wave = tid >> 6;
    LAS float* scr = (LAS float*)(lds + wave * 8704);
    const int gw = blockIdx.x * NWAVE + wave, NGW = gridDim.x * NWAVE;
    if (which & 1) {
        for (int it = gw; it < PER_L; it += 2 * NGW) {
            TrItem ta, tb; dec_dense(p, ws_, it, ta); const bool hb = it + NGW < PER_L; dec_dense(p, ws_, hb ? it + NGW : it, tb);
            f32x4 va[8], vb[8]; float ga[8], gb[8];
            tr_load(ta, lane, va, ga); tr_load(tb, lane, vb, gb);
            tr_store(ta, lane, va, ga, scr); if (hb) tr_store(tb, lane, vb, gb, scr);
        }
        const int gt = blockIdx.x * NTHR + tid, NGT = gridDim.x * NTHR;
        float* BT = (float*)(ws_ + WS_BT);
        for (int i = gt; i < 3 * 8 * 192; i += NGT) { const int br = i / (8 * 192), h = (i / 192) % 8, j = i % 192; const int dil = br == 0 ? 1 : br == 1 ? 4 : 16;
            const int steps = (190 - j) - 31; float v = -1e30f; if (j < 191 && steps >= 0 && steps <= 128) v = p.in[1][t5_bucket_d(steps * dil) * NH + h] * LOG2E; BT[i] = v; }
        float* BND = (float*)(ws_ + WS_BND);
        if (gw < DEPTH * 24) { const int l = gw / 24, bh = gw % 24, br = bh / 8, h = bh % 8; const int dil = br == 0 ? 1 : br == 1 ? 4 : 16;
            float gm = fabsf(p.in[4][l * 64 + lane] * p.in[5][l * 64 + lane] * 0.125f * LOG2E);
            float bm = -1e30f;
            for (int st = lane; st <= 128; st += 64) bm = fmaxf(bm, p.in[1][t5_bucket_d(st * dil) * NH + h] * LOG2E);
#pragma unroll
            for (int o = 1; o < 64; o <<= 1) { gm = fmaxf(gm, __shfl_xor(gm, o)); bm = fmaxf(bm, __shfl_xor(bm, o)); }
            if (lane == 0) BND[gw] = 64.0f * gm * 1.01f + bm; }
        float* GQK = (float*)(ws_ + WS_GQK);
        for (int i = gt; i < DEPTH * 64; i += NGT) GQK[i] = p.in[4][i] * p.in[5][i] * 0.125f * LOG2E;
        float* SPL = (float*)(ws_ + WS_SPL);
        for (int i = gt; i < DEPTH * DR; i += NGT) { const float lm = -p.in[12][i]; SPL[i] = 8.f * LOG2E * (fmaxf(lm, 0.f) + log1pf(expf(-fabsf(lm)))); }
        bf16_t* RTT = (bf16_t*)(ws_ + WS_RTT);
        for (int i = gt; i < DEPTH * 48 * D; i += NGT) { const int l = i / (48 * D), j = (i / D) % 48, k = i % D; float v = 0.f;
            if (j < 36) v = p.in[16][l * D + k] * (j < 4 ? p.in[17][(l * D + k) * 4 + j] : p.in[19][(l * D + k) * 32 + j - 4]);
            const unsigned h = cvt_pk_bf16(v, 0.f) & 0xffffu; const unsigned lo = cvt_pk_bf16(v - bf_lo(h), 0.f) & 0xffffu;
            RTT[(size_t)(l * 2) * 48 * D + (size_t)j * D + k] = (bf16_t)h; RTT[(size_t)(l * 2 + 1) * 48 * D + (size_t)j * D + k] = (bf16_t)lo; }
        bf16_t* WAT = (bf16_t*)(ws_ + WS_WAT);
        for (int i = gt; i < DEPTH * 2 * 8 * 4096; i += NGT) { const int l = i / (2 * 8 * 4096), wh = (i / (8 * 4096)) & 1, g = (i / 4096) & 7, j = (i / 64) & 63, ii = i & 63;
            const float v = (wh ? p.in[10] : p.in[8])[((size_t)(l * 8 + g) * 64 + ii) * 64 + j]; WAT[i] = (bf16_t)(cvt_pk_bf16(v, 0.f) & 0xffffu); }
    }
    (void)scr;
}

__device__ __forceinline__ int conv_idle(int ntiles, int G) { const int rem = (ntiles * 4) % G; return rem == 0 ? 0 : G - rem; }
__device__ __forceinline__ void convert_range(const Params& p, LAS unsigned char* lds, int l, int first, int stride, int npairs, int limit) {
    unsigned char* const ws_ = opaque_ptr(p.ws);
    const int tid = opaque_tid(), lane = tid & 63, wave = tid >> 6;
    LAS float* scr = (LAS float*)(lds + wave * 8704);
#pragma unroll 1
    for (int it = 0; it < npairs; ++it) {
        const int base = first + it * stride;
        if (base >= limit) break;
        TrItem ta, tb; dec_exp(p, ws_, l * CONV_ITEMS + base, ta); dec_exp(p, ws_, l * CONV_ITEMS + base + 1, tb);
        f32x4 va[8], vb[8]; float ga[8], gb[8];
        tr_load(ta, lane, va, ga); tr_load(tb, lane, vb, gb);
        tr_store8(ta, lane, va, ga, scr); tr_store8(tb, lane, vb, gb, scr);
    }
}

__device__ __forceinline__ void convert_queue(const Params& p, LAS unsigned char* lds, int l, bool use_stop) {
    unsigned char* const ws_ = opaque_ptr(p.ws);
    const int tid = opaque_tid(), lane = tid & 63, wave = tid >> 6;
    LAS float* scr = (LAS float*)(lds + wave * 8704);
    volatile LAS unsigned* slot = (volatile LAS unsigned*)(lds + LDS_MISC + 128);
    unsigned* head = (unsigned*)(ws_ + WS_CONV) + l * 64; unsigned* stop = (unsigned*)(ws_ + WS_CONV) + 512 + l * 64;
#pragma unroll 1
    for (;;) {
        __syncthreads();
        if (tid == 0) { unsigned b = 0xffffffffu;
            if (!(use_stop && __hip_atomic_load(stop, __ATOMIC_RELAXED, __HIP_MEMORY_SCOPE_AGENT) != 0u)) b = atomicAdd(head, 16u);
            slot[0] = b; }
        __syncthreads();
        const unsigned b = slot[0];
        if (b >= (unsigned)CONV_Q0) break;
        const int base = (int)b + 2 * wave;
        TrItem ta, tb; dec_exp(p, ws_, l * CONV_ITEMS + base, ta); dec_exp(p, ws_, l * CONV_ITEMS + base + 1, tb);
        f32x4 va[8], vb[8]; float ga[8], gb[8];
        tr_load(ta, lane, va, ga); tr_load(tb, lane, vb, gb);
        tr_store8(ta, lane, va, ga, scr); tr_store8(tb, lane, vb, gb, scr);
    }
}

__device__ __forceinline__ void build_tiles(const int* counts, LAS int* tab) {
    const int tid = opaque_tid();
    __syncthreads();
    if (tid < 64) {
        const int cnt = tid < NE ? counts[tid * CNT_STRIDE] : 0; const int nt = (cnt + 255) >> 8, rem = cnt & 255;
        const int sm = (rem >= 1 && rem <= 128) ? 1 : 0, nm = nt - sm;
        int im = nm, is = sm;
#pragma unroll
        for (int o = 1; o < 32; o <<= 1) { const int v = __shfl_up(im, o), w = __shfl_up(is, o); if (tid >= o) { im += v; is += w; } }
        const int TM = __shfl(im, NE - 1), TS = __shfl(is, NE - 1);
        const int em = im - nm, es = is - sm;
        if (tid < NE) { tab[tid] = cnt; tab[32 + tid] = em; tab[448 + tid] = es; tab[480 + tid] = nm;
#pragma unroll 1
            for (int t = 0; t < nm; ++t) { tab[128 + em + t] = tid; tab[288 + em + t] = t * 256; }
            if (sm) { tab[128 + TM + es] = tid; tab[288 + TM + es] = nm * 256; } }
        if (tid == 0) { tab[66] = TM + TS; tab[67] = TM; }
    }
    __syncthreads();
}
__device__ __forceinline__ int moe_slot(const LAS int* tab, int e, int rk) {
    const int t = rk >> 8; const int gt = (t < tab[480 + e]) ? tab[32 + e] + t : tab[67] + tab[448 + e];
    return gt * 256 + (rk & 255);
}

__device__ __forceinline__ void norm_finish(f32x4 (&v)[4], int row, int lane, float* out32, bf16_t* XB, float* RS, bool donorm) {
    if (!donorm) { f32x4* xo = (f32x4*)(out32 + (size_t)row * D) + lane;
#pragma unroll
        for (int j = 0; j < 4; ++j) xo[64 * j] = v[j]; }
    else {
        u32x2* xo = (u32x2*)(XB + (size_t)row * D) + lane;
#pragma unroll
        for (int j = 0; j < 4; ++j) { u32x2 w; w.x = cvt_pk_bf16(v[j][0], v[j][1]); w.y = cvt_pk_bf16(v[j][2], v[j][3]); xo[64 * j] = w; }
        float s = 0.f;
#pragma unroll
        for (int j = 0; j < 4; ++j) s += (v[j][0] * v[j][0] + v[j][1] * v[j][1]) + (v[j][2] * v[j][2] + v[j][3] * v[j][3]);
        s = wave_sum(s);
        if (lane == 0) RS[row] = rsqrtf(s * (1.0f / D) + EPS);
    }
}
__device__ __forceinline__ void norm_add(f32x4 (&v)[4], const u32x2 (&a)[4], const u32x2 (&b)[4], float g0, float g1) {
#pragma unroll
    for (int j = 0; j < 4; ++j) {
        v[j][0] += g0 * bf_lo(a[j].x) + g1 * bf_lo(b[j].x); v[j][1] += g0 * bf_hi(a[j].x) + g1 * bf_hi(b[j].x);
        v[j][2] += g0 * bf_lo(a[j].y) + g1 * bf_lo(b[j].y); v[j][3] += g0 * bf_hi(a[j].y) + g1 * bf_hi(b[j].y); }
}
__device__ __forceinline__ void ph_norm(const Params& p, LAS unsigned char* lds, const float* src32, float* out32, int mode, const int* counts, bool donorm, int conv_l) {
    unsigned char* const ws_ = opaque_ptr(p.ws);
    const int tid = opaque_tid(), lane = tid & 63, wave = __builtin_amdgcn_readfirstlane(tid >> 6);
    LAS int* tab = (LAS int*)(lds + LDS_TAB);
    if (mode) build_tiles(counts, tab);
    const int* eid = (const int*)(ws_ + WS_TOK); const int* rank = eid + M * 2; const float* gate = (const float*)(rank + M * 2);
    const bf16_t* Y = (const bf16_t*)(ws_ + WS_Y); float* RS = (float*)(ws_ + WS_RSTD); bf16_t* XB = (bf16_t*)(ws_ + WS_XB);
    const bool own = gridDim.x == 256;
    const int stride = own ? 1 : gridDim.x * NWAVE;
    for (int base = own ? 64 * xcd_unit(blockIdx.x) + 8 * wave : blockIdx.x * NWAVE + wave; base < M; base += own ? M : 8 * stride) {
        int ms0 = 0, ms1 = 0; float mg0 = 0.f, mg1 = 0.f;
        if (mode && lane < 8) { const int r = base + lane * stride;
            if (r < M) { const int e0 = eid[r * 2], e1 = eid[r * 2 + 1]; ms0 = moe_slot(tab, e0, rank[r * 2]); ms1 = moe_slot(tab, e1, rank[r * 2 + 1]); mg0 = gate[r * 2]; mg1 = gate[r * 2 + 1]; } }
#pragma unroll
        for (int i = 0; i < 8; i += 2) {
            const int ra = base + i * stride, rb = ra + stride;
            if (ra < M) {
                const bool hb = rb < M; const int rbb = hb ? rb : ra;
                f32x4 va[4], vb[4];
                if (mode) { const u32x2* xa = (const u32x2*)(XB + (size_t)ra * D) + lane; const u32x2* xb = (const u32x2*)(XB + (size_t)rbb * D) + lane; u32x2 qa[4], qb[4];
#pragma unroll
                    for (int j = 0; j < 4; ++j) { qa[j] = xa[64 * j]; qb[j] = xb[64 * j]; }
#pragma unroll
                    for (int j = 0; j < 4; ++j) { va[j] = (f32x4){bf_lo(qa[j].x), bf_hi(qa[j].x), bf_lo(qa[j].y), bf_hi(qa[j].y)}; vb[j] = (f32x4){bf_lo(qb[j].x), bf_hi(qb[j].x), bf_lo(qb[j].y), bf_hi(qb[j].y)}; } }
                else { const f32x4* xa = (const f32x4*)(src32 + (size_t)ra * D) + lane; const f32x4* xb = (const f32x4*)(src32 + (size_t)rbb * D) + lane;
#pragma unroll
                    for (int j = 0; j < 4; ++j) { va[j] = xa[64 * j]; vb[j] = xb[64 * j]; } }
                if (mode) {
                    const int sa0 = __builtin_amdgcn_readlane(ms0, i), sa1 = __builtin_amdgcn_readlane(ms1, i), sb0 = __builtin_amdgcn_readlane(ms0, i + 1), sb1 = __builtin_amdgcn_readlane(ms1, i + 1);
                    const float ga0 = __int_as_float(__builtin_amdgcn_readlane(__float_as_int(mg0), i)), ga1 = __int_as_float(__builtin_amdgcn_readlane(__float_as_int(mg1), i)), gb0 = __int_as_float(__builtin_amdgcn_readlane(__float_as_int(mg0), i + 1)), gb1 = __int_as_float(__builtin_amdgcn_readlane(__float_as_int(mg1), i + 1));
                    u32x2 ya0[4], ya1[4], yb0[4], yb1[4];
                    const u32x2* pa0 = (const u32x2*)(Y + (size_t)sa0 * D) + lane; const u32x2* pa1 = (const u32x2*)(Y + (size_t)sa1 * D) + lane;
                    const u32x2* pb0 = (const u32x2*)(Y + (size_t)sb0 * D) + lane; const u32x2* pb1 = (const u32x2*)(Y + (size_t)sb1 * D) + lane;
#pragma unroll
                    for (int j = 0; j < 4; ++j) { ya0[j] = pa0[64 * j]; ya1[j] = pa1[64 * j]; yb0[j] = pb0[64 * j]; yb1[j] = pb1[64 * j]; }
                    norm_add(va, ya0, ya1, ga0, ga1); norm_add(vb, yb0, yb1, gb0, gb1);
                }
                norm_finish(va, ra, lane, out32, XB, RS, donorm);
                if (hb) norm_finish(vb, rb, lane, out32, XB, RS, donorm);
            }
        }
    }
    if (conv_l >= 0) {
        const int T = __builtin_amdgcn_readfirstlane(tab[66]), idle = conv_idle(T, gridDim.x);
        int a3 = 0, lim = CONV_HEAD; (void)idle;
        convert_range(p, lds, conv_l, a3 + 2 * (blockIdx.x * NWAVE + wave), 2 * gridDim.x * NWAVE, 1 << 30, lim);
    }
}

__device__ __forceinline__ void ph_win(const Params& p, LAS unsigned char* lds, int l) {
    unsigned char* const ws_ = opaque_ptr(p.ws);
    LAS float* gq = (LAS float*)(lds + LDS_TAB + 4096);
    { const int t_ = opaque_tid(); if (t_ < 64) gq[t_] = ((const float*)(ws_ + WS_GQK))[l * 64 + t_]; }
    __syncthreads();
    if (((volatile LAS unsigned*)(lds + LDS_MISC))[2] == 0u) {
        const int w_ = opaque_tid() >> 6, gw_ = (int)blockIdx.x * NWAVE + w_, ngw_ = gridDim.x * NWAVE;
        convert_range(p, lds, l, (l == 0 ? CONV_Q0 : 0) + 2 * gw_, 2 * ngw_, 1 << 30, CONV_HEAD);
        if (l + 1 < DEPTH) {
#pragma unroll 1
            for (int it = gw_; it < PER_L; it += ngw_) { TrItem t; dec_dense(p, ws_, (l + 1) * PER_L + it, t); f32x4 v[8]; float g[8]; tr_load(t, opaque_tid() & 63, v, g); tr_store(t, opaque_tid() & 63, v, g, nullptr); } }
        __syncthreads(); }
    pg8::StaticOrder S; S.init((const bf16_t*)(ws_ + WS_XB), (const bf16_t*)(ws_ + WS_WIN) + (size_t)l * DIN * D, M, DIN, D, gridDim.x, opaque_bid());
    pg8::EpiQKV E{(bf16_t*)(ws_ + WS_ZB), gq, (const float*)(ws_ + WS_RSTD)};
    pg8::gemm_phase<pg8::EpiQKV, pg8::StaticOrder, false>(lds + LDS_STAGE, nullptr, 2 * D, S, E);
    { pg8::Unit u_; const bool third = S.next(2, u_);
      if (third) { if (opaque_tid() == 0) __hip_atomic_store((unsigned*)(ws_ + WS_CONV) + 512 + l * 64, 1u, __ATOMIC_RELAXED, __HIP_MEMORY_SCOPE_AGENT); }
      else if (l == 0) convert_queue(p, lds, l, true); }
}
__device__ __forceinline__ void ph_wout(const Params& p, LAS unsigned char* lds, int l) {
    unsigned char* const ws_ = opaque_ptr(p.ws);
    pg8::StaticOrder S; S.init((const bf16_t*)(ws_ + WS_MIX), (const bf16_t*)(ws_ + WS_WOUT) + (size_t)l * D * D, M, D, D, gridDim.x, opaque_bid());
    pg8::EpiResB E{(const bf16_t*)(ws_ + WS_XB), (bf16_t*)(ws_ + WS_XB), D};
    pg8::gemm_phase<pg8::EpiResB, pg8::StaticOrder, false>(lds + LDS_STAGE, nullptr, 2 * D, S, E);
}

__device__ __forceinline__ void split_hilo(const f32x4& a, const f32x4& b, bf16x8& hi, bf16x8& lo) {
    u32x4 h; h.x = cvt_pk_bf16(a[0], a[1]); h.y = cvt_pk_bf16(a[2], a[3]); h.z = cvt_pk_bf16(b[0], b[1]); h.w = cvt_pk_bf16(b[2], b[3]);
    u32x4 l; l.x = cvt_pk_bf16(a[0] - bf_lo(h.x), a[1] - bf_hi(h.x)); l.y = cvt_pk_bf16(a[2] - bf_lo(h.y), a[3] - bf_hi(h.y));
    l.z = cvt_pk_bf16(b[0] - bf_lo(h.z), b[1] - bf_hi(h.z)); l.w = cvt_pk_bf16(b[2] - bf_lo(h.w), b[3] - bf_hi(h.w));
    hi = __builtin_bit_cast(bf16x8, h); lo = __builtin_bit_cast(bf16x8, l);
}
__device__ __forceinline__ void ph_router(const Params& p, LAS unsigned char* lds, int l) {
    unsigned char* const ws_ = opaque_ptr(p.ws);
    const bf16_t* XB = (const bf16_t*)(ws_ + WS_XB);
    const int tid = opaque_tid(), lane = tid & 63, wave = __builtin_amdgcn_readfirstlane(tid >> 6);
    LAS float* rs = (LAS float*)lds; LAS float* Lg = (LAS float*)(lds + 1024);
    LAS int* hist = (LAS int*)(lds + 110592); LAS int* base = hist + 32;
    LAS int* t_e = hist + 64; LAS int* t_lr = t_e + 128; LAS float* t_g = (LAS float*)(t_lr + 128);
    const bf16_t* RTH = (const bf16_t*)(ws_ + WS_RTT) + (size_t)l * 2 * 48 * D; const bf16_t* RTL = RTH + 48 * D;
    int* counts = (int*)(ws_ + WS_CNT) + l * NE * CNT_STRIDE;
    int* eid = (int*)(ws_ + WS_TOK); int* rank = eid + M * 2; float* gate = (float*)(rank + M * 2);
    int* list = (int*)(ws_ + WS_LIST); bf16_t* HN = (bf16_t*)(ws_ + WS_HN);
    const float* bg = p.in[18] + l * NG; const float* be = p.in[20] + l * NE;
    SP_DECL;
    for (int g0 = blockIdx.x; g0 < M / 64; g0 += gridDim.x) {
        const int grp = xcd_unit(g0);
        __syncthreads();
        if (tid < 32) hist[tid] = 0;
        SP_BEGIN();
        {
            const int ta = grp * 64 + wave * 8;
            const u32x4* xa = (const u32x4*)(XB + (size_t)ta * D) + lane;
            u32x4 v[8][2]; float sq[8];
#pragma unroll
            for (int r = 0; r < 8; ++r)
#pragma unroll
                for (int j = 0; j < 2; ++j) v[r][j] = xa[r * (D / 8) + 64 * j];
#pragma unroll
            for (int r = 0; r < 8; ++r) { float s = 0.f;
#pragma unroll
                for (int j = 0; j < 2; ++j) { const u32x4 q = v[r][j];
                    s += ((bf_lo(q.x) * bf_lo(q.x) + bf_hi(q.x) * bf_hi(q.x)) + (bf_lo(q.y) * bf_lo(q.y) + bf_hi(q.y) * bf_hi(q.y))) + ((bf_lo(q.z) * bf_lo(q.z) + bf_hi(q.z) * bf_hi(q.z)) + (bf_lo(q.w) * bf_lo(q.w) + bf_hi(q.w) * bf_hi(q.w))); }
                sq[r] = s; }
#pragma unroll
            for (int r = 0; r < 8; ++r) sq[r] = wave_sum(sq[r]);
#pragma unroll
            for (int r = 0; r < 8; ++r) { const float rr = rsqrtf(sq[r] * (1.0f / D) + EPS);
                u32x2* o = (u32x2*)((unsigned char*)HN + (size_t)(ta + r) * D) + lane;
#pragma unroll
                for (int j = 0; j < 2; ++j) { const u32x4 q = v[r][j]; int w0 = 0, w1 = 0;
                    w0 = __builtin_amdgcn_cvt_pk_fp8_f32(bf_lo(q.x) * rr, bf_hi(q.x) * rr, w0, false); w0 = __builtin_amdgcn_cvt_pk_fp8_f32(bf_lo(q.y) * rr, bf_hi(q.y) * rr, w0, true);
                    w1 = __builtin_amdgcn_cvt_pk_fp8_f32(bf_lo(q.z) * rr, bf_hi(q.z) * rr, w1, false); w1 = __builtin_amdgcn_cvt_pk_fp8_f32(bf_lo(q.w) * rr, bf_hi(q.w) * rr, w1, true);
                    o[64 * j] = (u32x2){(unsigned)w0, (unsigned)w1}; }
                if (lane == 0) rs[wave * 8 + r] = rr; }
        }
        SP_SYNC(); SP_END(3); SP_BEGIN();
        { const int fr = lane & 15, kq = lane >> 4;
          const bf16_t* xrow = XB + (size_t)(grp * 64 + fr) * D + wave * 128 + 8 * kq;
          const bf16_t* bh = RTH + (size_t)fr * D + wave * 128 + 8 * kq; const bf16_t* bl = RTL + (size_t)fr * D + wave * 128 + 8 * kq;
          f32x4 acc[4][3];
#pragma unroll
          for (int tb = 0; tb < 4; ++tb)
#pragma unroll
              for (int ob = 0; ob < 3; ++ob) acc[tb][ob] = (f32x4){0.f, 0.f, 0.f, 0.f};
#pragma unroll 2
          for (int ks = 0; ks < 4; ++ks) {
              bf16x8 wh[3], wl[3];
#pragma unroll
              for (int ob = 0; ob < 3; ++ob) { wh[ob] = *(const bf16x8*)(bh + (size_t)ob * 16 * D + 32 * ks); wl[ob] = *(const bf16x8*)(bl + (size_t)ob * 16 * D + 32 * ks); }
              bf16x8 xa[4];
#pragma unroll
              for (int tb = 0; tb < 4; ++tb) xa[tb] = *(const bf16x8*)(xrow + (size_t)tb * 16 * D + 32 * ks);
#pragma unroll
              for (int tb = 0; tb < 4; ++tb)
#pragma unroll
                  for (int ob = 0; ob < 3; ++ob) {
                      acc[tb][ob] = __builtin_amdgcn_mfma_f32_16x16x32_bf16(xa[tb], wh[ob], acc[tb][ob], 0, 0, 0);
                      acc[tb][ob] = __builtin_amdgcn_mfma_f32_16x16x32_bf16(xa[tb], wl[ob], acc[tb][ob], 0, 0, 0); } }
#pragma unroll
          for (int tb = 0; tb < 4; ++tb)
#pragma unroll
              for (int ob = 0; ob < 3; ++ob)
#pragma unroll
                  for (int r = 0; r < 4; ++r) Lg[(wave * 64 + tb * 16 + 4 * kq + r) * 52 + ob * 16 + fr] = acc[tb][ob][r];
        }
        __syncthreads(); SP_END(4); SP_BEGIN();
        if (tid < 64) {
            const float rstd = rs[tid];
            f32x4 l4[9];
#pragma unroll
            for (int q = 0; q < 9; ++q) l4[q] = *(const LAS f32x4*)(Lg + tid * 52 + 4 * q);
#pragma unroll 1
            for (int sl = 1; sl < 8; ++sl) {
#pragma unroll
                for (int q = 0; q < 9; ++q) l4[q] += *(const LAS f32x4*)(Lg + (sl * 64 + tid) * 52 + 4 * q); }
            float lg[36];
#pragma unroll
            for (int q = 0; q < 9; ++q) { lg[4 * q] = l4[q][0] * rstd; lg[4 * q + 1] = l4[q][1] * rstd; lg[4 * q + 2] = l4[q][2] * rstd; lg[4 * q + 3] = l4[q][3] * rstd; }
            float gl[4];
#pragma unroll
            for (int j = 0; j < 4; ++j) gl[j] = lg[j] + bg[j];
            int gs = 0; float gm = gl[0];
#pragma unroll
            for (int j = 1; j < 4; ++j) if (gl[j] > gm) { gm = gl[j]; gs = j; }
            float den = 0.f;
#pragma unroll
            for (int j = 0; j < 4; ++j) den += expf(gl[j] - gm);
            const float gw = 1.f / den;
            float el[8];
#pragma unroll
            for (int j = 0; j < 8; ++j) el[j] = (gs == 0 ? lg[4 + j] : gs == 1 ? lg[12 + j] : gs == 2 ? lg[20 + j] : lg[28 + j]) + be[gs * 8 + j];
            int i0 = 0; float m0 = el[0];
#pragma unroll
            for (int j = 1; j < 8; ++j) if (el[j] > m0) { m0 = el[j]; i0 = j; }
            int i1 = -1; float m1 = -3.0e38f;
#pragma unroll
            for (int j = 0; j < 8; ++j) if (j != i0 && el[j] > m1) { m1 = el[j]; i1 = j; }
            const float e1 = expf(m1 - m0); const float p0 = 1.f / (1.f + e1), p1 = e1 / (1.f + e1);
            const int ex0 = gs * 8 + i0, ex1 = gs * 8 + i1;
            t_e[tid * 2] = ex0; t_e[tid * 2 + 1] = ex1; t_g[tid * 2] = gw * p0; t_g[tid * 2 + 1] = gw * p1;
            t_lr[tid * 2] = __hip_atomic_fetch_add(hist + ex0, 1, __ATOMIC_RELAXED, __HIP_MEMORY_SCOPE_WORKGROUP); t_lr[tid * 2 + 1] = __hip_atomic_fetch_add(hist + ex1, 1, __ATOMIC_RELAXED, __HIP_MEMORY_SCOPE_WORKGROUP);
        }
        __syncthreads();
        if (tid < 32) { const int hcount = hist[tid]; base[tid] = hcount > 0 ? atomicAdd(&counts[tid * CNT_STRIDE], hcount) : 0; }
        __syncthreads();
        if (tid < 128) { const int tok = grp * 64 + (tid >> 1); const int e = t_e[tid]; const int r = base[e] + t_lr[tid];
            eid[tok * 2 + (tid & 1)] = e; rank[tok * 2 + (tid & 1)] = r; gate[tok * 2 + (tid & 1)] = t_g[tid]; list[(size_t)e * M + r] = tok; }
        SP_SYNC(); SP_END(5);
    }
}
__device__ __forceinline__ void ph_gateup(const Params& p, LAS unsigned char* lds, int l) {
    unsigned char* const ws_ = opaque_ptr(p.ws);
    LAS int* tab = (LAS int*)(lds + LDS_TAB);
    build_tiles((const int*)(ws_ + WS_CNT) + l * NE * CNT_STRIDE, tab);
    pg8::MoeOrder S; S.G = gridDim.x; S.c = opaque_bid(); S.ntiles = __builtin_amdgcn_readfirstlane(tab[66]); S.tile_e = tab + 128; S.tile_r0 = tab + 288; S.cnt = tab;
    S.A = nullptr; S.tA = 0; S.W = (const char*)(ws_ + WS_WGU) + (size_t)l * NE * D * D; S.estride = (size_t)D * D; S.tB = (size_t)256 * D;
    S.list = (const int*)(ws_ + WS_LIST); S.Mrows = M;
    S.pub = nullptr; S.wait = nullptr; S.need = 0u; S.tmo = nullptr;
    pg8::EpiSwiGLU8 E{(unsigned char*)(ws_ + WS_ACT)};
    pg8::gemm_phase<pg8::EpiSwiGLU8, pg8::MoeOrder, true, true, 0x79797979, 0x7f7f7f7f, false, 10>(lds + LDS_STAGE, (const void*)(ws_ + WS_HN), D, S, E);
    if (l + 1 < DEPTH && gridDim.x == 256 && CONV_Q_GU > 0) { const int rem = (S.ntiles * 4) % S.G;
        if (rem != 0 && (int)blockIdx.x >= rem) { const int wv = opaque_tid() >> 6;
            convert_range(p, lds, l + 1, (((int)blockIdx.x - rem) * NWAVE + wv) * 2 * CONV_Q_GU, 2, CONV_Q_GU, CONV_HEAD); } }
}
__device__ __forceinline__ void ph_down(const Params& p, LAS unsigned char* lds, int l) {
    unsigned char* const ws_ = opaque_ptr(p.ws);
    LAS int* tab = (LAS int*)(lds + LDS_TAB);
    build_tiles((const int*)(ws_ + WS_CNT) + l * NE * CNT_STRIDE, tab);
    pg8::MoeOrder S; S.G = gridDim.x; S.c = opaque_bid(); S.ntiles = __builtin_amdgcn_readfirstlane(tab[66]); S.tile_e = tab + 128; S.tile_r0 = tab + 288; S.cnt = tab;
    S.A = (const char*)(ws_ + WS_ACT); S.tA = (size_t)256 * DE; S.W = (const char*)(ws_ + WS_WD) + (size_t)l * NE * D * DE; S.estride = (size_t)D * DE; S.tB = (size_t)256 * DE;
    S.list = (const int*)(ws_ + WS_LIST); S.Mrows = M;
    S.pub = nullptr; S.wait = nullptr; S.need = 0u; S.tmo = nullptr;
    pg8::EpiBf16 E{(bf16_t*)(ws_ + WS_Y), D};
    pg8::gemm_phase<pg8::EpiBf16, pg8::MoeOrder, true, true, 0x79797979, 0x7c7c7c7c, true, 9>(lds + LDS_STAGE, (const void*)(ws_ + WS_ACT), DE, S, E);
    if (l + 1 < DEPTH && gridDim.x == 256 && CONV_Q_DN > 0) { const int rem = (S.ntiles * 4) % S.G;
        if (rem != 0 && (int)blockIdx.x >= rem) { const int wv = opaque_tid() >> 6; const int a2 = (S.G - rem) * 8 * 2 * CONV_Q_GU;
            convert_range(p, lds, l + 1, a2 + (((int)blockIdx.x - rem) * NWAVE + wv) * 2 * CONV_Q_DN, 2, CONV_Q_DN, CONV_HEAD); } }
}

#define TRREAD(dst, addr, off) asm volatile("ds_read_b64_tr_b16 %0, %1 offset:%2" : "=&v"(dst) : "v"(addr), "i"(off) : "memory")
struct AttnPf { u32x4 k[6], v[6]; bf16x8 q[4]; };
__device__ __forceinline__ void attn_issue(const bf16_t* ZB, int item, int tid, AttnPf& pf, int which) {
    const int br = item >> 9, rem = item & 511, b = rem >> 8, h = (rem >> 5) & 7, j = rem & 31;
    const int dsh = br * 2, dil = 1 << dsh, nblk = 32 >> dsh, r = j / nblk, blk = j % nblk, i0 = blk * 256;
    if (which & 3) {
#pragma unroll
        for (int jj = 0; jj < 6; ++jj) {
            const int idx = tid + 512 * jj, key = idx >> 3, ch = idx & 7, sub = i0 - 128 + key;
            const bf16_t* rp = ZB + (size_t)(b * SEQ + (sub >= 0 ? sub : 0) * dil + r) * DIN + h * HD + ch * 8;
            if (which & 1) { pf.k[jj] = (u32x4){0u, 0u, 0u, 0u}; if (sub >= 0) pf.k[jj] = *(const u32x4*)(rp + DA); }
            if (which & 2) { pf.v[jj] = (u32x4){0u, 0u, 0u, 0u}; if (sub >= 0) pf.v[jj] = *(const u32x4*)(rp + 2 * DA); }
        }
    }
    if (which & 4) {
        const int lane = tid & 63, w = tid >> 6, hh = lane >> 5, ql = lane & 31;
        const size_t qtok = (size_t)(b * SEQ + (i0 + 32 * w + ql) * dil + r);
#pragma unroll
        for (int ks = 0; ks < 4; ++ks) pf.q[ks] = *(const bf16x8*)(ZB + qtok * DIN + h * HD + 16 * ks + 8 * hh);
    }
}
__device__ __forceinline__ void attn_item(const Params& p, LAS unsigned char* lds, int l, int item, AttnPf& pf, int next_item) {
    unsigned char* const ws_ = opaque_ptr(p.ws);
    const int tid = opaque_tid(), lane = tid & 63, w = __builtin_amdgcn_readfirstlane(tid >> 6), hh = lane >> 5, ql = lane & 31;
    const int br = item >> 9, rem = item & 511, b = rem >> 8, h = (rem >> 5) & 7, j = rem & 31;
    const int dsh = br * 2, dil = 1 << dsh, nblk = 32 >> dsh, r = j / nblk, blk = j % nblk, i0 = blk * 256;
    const bf16_t* ZB = (const bf16_t*)(ws_ + WS_ZB);
    LAS unsigned char* Kl = lds; LAS unsigned char* Vl = lds + 49152; LAS float* Tl = (LAS float*)(lds + 98304) + (br * 8 + h) * 192;
    LAS unsigned char* Ost = lds + 116736 + w * 4096;
    SP_DECL;
    __syncthreads();
    SP_BEGIN();
#pragma unroll
    for (int jj = 0; jj < 6; ++jj) {
        const int idx = tid + 512 * jj, key = idx >> 3, ch = idx & 7;
        *(LAS u32x4*)(Kl + key * 128 + ((ch ^ ((key >> 1) & 7)) << 4)) = pf.k[jj];
        *(LAS u32x4*)(Vl + ((key >> 2) * 2 + (ch >> 2)) * 256 + (key & 3) * 64 + (ch & 3) * 16) = pf.v[jj];
    }
    bf16x8 qf[4];
#pragma unroll
    for (int ks = 0; ks < 4; ++ks) qf[ks] = pf.q[ks];
    __syncthreads();
    SP_END(11); SP_BEGIN();
    const int sw = (ql >> 1) & 7;
    int koff[4];
#pragma unroll
    for (int ks = 0; ks < 4; ++ks) koff[ks] = ((2 * ks + hh) ^ sw) << 4;
    const LAS unsigned char* kbase = Kl + (32 * w + ql) * 128;
    const LAS float* tl = Tl + (31 - ql + 4 * hh);
    if (next_item >= 0) attn_issue(ZB, next_item, tid, pf, 1);
    __builtin_amdgcn_sched_barrier(0);
    f32x16 S[5];
#pragma unroll
    for (int kb = 0; kb < 5; ++kb) {
#pragma unroll
        for (int rr = 0; rr < 16; ++rr) S[kb][rr] = tl[32 * kb + (rr & 3) + 8 * (rr >> 2)];
#pragma unroll
        for (int ks = 0; ks < 4; ++ks) { const bf16x8 kf = *(const LAS bf16x8*)(kbase + kb * 4096 + koff[ks]);
            S[kb] = __builtin_amdgcn_mfma_f32_32x32x16_bf16(kf, qf[ks], S[kb], 0, 0, 0); }
    }
    __builtin_amdgcn_sched_barrier(0);
    if (next_item >= 0) attn_issue(ZB, next_item, tid, pf, 2);
    __builtin_amdgcn_sched_barrier(0);
    const int thr = 128 - i0 - 32 * w;
    if (thr > 0) {
        asm volatile("" ::: "memory");
#pragma unroll
        for (int kb = 0; kb < 5; ++kb)
#pragma unroll
            for (int rr = 0; rr < 16; ++rr) { const int c = 32 * kb + (rr & 3) + 8 * (rr >> 2); if (c + 4 * hh < thr) S[kb][rr] = -1e30f; }
    }
    float ls = 0.f;
#pragma unroll
    for (int kb = 0; kb < 5; ++kb)
#pragma unroll
        for (int rr = 0; rr < 16; ++rr) { const float e = __builtin_amdgcn_exp2f(S[kb][rr]); S[kb][rr] = e; ls += e; }
    ls += __shfl_xor(ls, 32);
    __builtin_amdgcn_sched_barrier(0);
    if (next_item >= 0) attn_issue(ZB, next_item, tid, pf, 4);
    __builtin_amdgcn_sched_barrier(0);
    f32x16 O[2];
    O[0] = (f32x16){0.f, 0.f, 0.f, 0.f, 0.f, 0.f, 0.f, 0.f, 0.f, 0.f, 0.f, 0.f, 0.f, 0.f, 0.f, 0.f}; O[1] = O[0];
    const unsigned vaddr = (unsigned)(size_t)(Vl) + (unsigned)(w * 4096 + hh * 512 + ((lane >> 2) & 3) * 64 + ((lane >> 4) & 1) * 32 + (lane & 3) * 8);
#define PV_READ(V0, V1, kb) do { \
        TRREAD(V0[0][0], vaddr, (8 * (kb) + 0) * 512 + 0);   TRREAD(V1[0][0], vaddr, (8 * (kb) + 2) * 512 + 0); \
        TRREAD(V0[0][1], vaddr, (8 * (kb) + 0) * 512 + 256); TRREAD(V1[0][1], vaddr, (8 * (kb) + 2) * 512 + 256); \
        TRREAD(V0[1][0], vaddr, (8 * (kb) + 4) * 512 + 0);   TRREAD(V1[1][0], vaddr, (8 * (kb) + 6) * 512 + 0); \
        TRREAD(V0[1][1], vaddr, (8 * (kb) + 4) * 512 + 256); TRREAD(V1[1][1], vaddr, (8 * (kb) + 6) * 512 + 256); } while (0)
#define PV_MMA(V0, V1, kb) do { _Pragma("unroll") for (int s2 = 0; s2 < 2; ++s2) { \
            u32x4 pw; pw.x = cvt_pk_bf16(S[kb][8 * s2 + 0], S[kb][8 * s2 + 1]); pw.y = cvt_pk_bf16(S[kb][8 * s2 + 2], S[kb][8 * s2 + 3]); \
            pw.z = cvt_pk_bf16(S[kb][8 * s2 + 4], S[kb][8 * s2 + 5]); pw.w = cvt_pk_bf16(S[kb][8 * s2 + 6], S[kb][8 * s2 + 7]); \
            const bf16x8 pb = __builtin_bit_cast(bf16x8, pw); \
            _Pragma("unroll") for (int db = 0; db < 2; ++db) { const bf16x8 va = (bf16x8){V0[s2][db][0], V0[s2][db][1], V0[s2][db][2], V0[s2][db][3], V1[s2][db][0], V1[s2][db][1], V1[s2][db][2], V1[s2][db][3]}; \
                O[db] = __builtin_amdgcn_mfma_f32_32x32x16_bf16(va, pb, O[db], 0, 0, 0); } } } while (0)
    {
        s16x4 va0[2][2], va1[2][2], vb0[2][2], vb1[2][2];
        PV_READ(va0, va1, 0);
        PV_READ(vb0, vb1, 1); asm volatile("s_waitcnt lgkmcnt(8)" ::: "memory"); __builtin_amdgcn_sched_barrier(0); PV_MMA(va0, va1, 0); __builtin_amdgcn_sched_barrier(0);
        PV_READ(va0, va1, 2); asm volatile("s_waitcnt lgkmcnt(8)" ::: "memory"); __builtin_amdgcn_sched_barrier(0); PV_MMA(vb0, vb1, 1); __builtin_amdgcn_sched_barrier(0);
        PV_READ(vb0, vb1, 3); asm volatile("s_waitcnt lgkmcnt(8)" ::: "memory"); __builtin_amdgcn_sched_barrier(0); PV_MMA(va0, va1, 2); __builtin_amdgcn_sched_barrier(0);
        PV_READ(va0, va1, 4); asm volatile("s_waitcnt lgkmcnt(8)" ::: "memory"); __builtin_amdgcn_sched_barrier(0); PV_MMA(vb0, vb1, 3); __builtin_amdgcn_sched_barrier(0);
        asm volatile("s_waitcnt lgkmcnt(0)" ::: "memory"); __builtin_amdgcn_sched_barrier(0); PV_MMA(va0, va1, 4);
    }
#undef PV_READ
#undef PV_MMA
    asm volatile("s_waitcnt lgkmcnt(0)" ::: "memory"); SP_END(12); SP_BEGIN();
    const float inv = 1.0f / ls;
#pragma unroll
    for (int db = 0; db < 2; ++db)
#pragma unroll
        for (int rg = 0; rg < 4; ++rg) { u32x2 o; o.x = cvt_pk_bf16(O[db][4 * rg] * inv, O[db][4 * rg + 1] * inv); o.y = cvt_pk_bf16(O[db][4 * rg + 2] * inv, O[db][4 * rg + 3] * inv);
            *(LAS u32x2*)(Ost + ql * 128 + (((4 * db + rg) ^ (ql & 7)) << 4) + 8 * hh) = o; }
    const float bound = ((const float*)(ws_ + WS_BND))[l * 24 + br * 8 + h];
    const size_t qtok = (size_t)(b * SEQ + (i0 + 32 * w + ql) * dil + r);
    if (hh == 0) ((float*)(ws_ + WS_LSE))[((size_t)br * M + qtok) * NH + h] = __builtin_amdgcn_logf(ls) + bound;
    asm volatile("s_waitcnt lgkmcnt(0)" ::: "memory");
    bf16_t* obase = (bf16_t*)(ws_ + WS_OB) + (size_t)br * M * DA + h * HD;
#pragma unroll
    for (int i = 0; i < 4; ++i) { const int row = (lane >> 3) + 8 * i, cp = lane & 7;
        const u32x4 d = *(const LAS u32x4*)(Ost + row * 128 + cp * 16);
        const size_t tok = (size_t)(b * SEQ + (i0 + 32 * w + row) * dil + r);
        *(u32x4*)(obase + tok * DA + ((cp ^ (row & 7)) << 3)) = d; }
#if SUBPROBE == 13
    asm volatile("s_waitcnt vmcnt(0)" ::: "memory");
#endif
    SP_END(13);
}

__device__ __forceinline__ float sigm(float x) { return __builtin_amdgcn_rcpf(1.0f + __builtin_amdgcn_exp2f(-x * LOG2E)); }
__device__ __forceinline__ void rnn_agg_unit(const Params& p, LAS unsigned char* lds, int l, int unit) {
    unsigned char* const ws_ = opaque_ptr(p.ws);
    const int tid = opaque_tid(), lane = tid & 63, g = __builtin_amdgcn_readfirstlane(tid >> 6), hh = lane >> 5, ql = lane & 31;
    const int b = unit >> 7, chunk = unit & 127, t0 = chunk * 64;
    const bf16_t* ZB = (const bf16_t*)(ws_ + WS_ZB);
    LAS float* ut = (LAS float*)(lds + g * 17408); LAS float* at = ut + 32 * 68;
    float* AGG = (float*)(ws_ + WS_AGG); unsigned* AD = (unsigned*)(ws_ + WS_AD);
    const int c = g * 64 + lane;
    float hst = 0.f, Ap = 1.f;
    const float* cw = p.in[6] + l * 4 * DR; const float w0 = cw[c], w1 = cw[DR + c], w2 = cw[2 * DR + c], w3 = cw[3 * DR + c], cbv = p.in[7][l * DR + c];
    float bav[2], bxv[2], splv[2];
#pragma unroll
    for (int nb = 0; nb < 2; ++nb) { const int cd = g * 64 + 32 * nb + ql; bav[nb] = p.in[9][l * DR + cd]; bxv[nb] = p.in[11][l * DR + cd]; splv[nb] = ((const float*)(ws_ + WS_SPL))[l * DR + cd]; }
    bf16x8 Wa[2][4], Wx[2][4];
    { const bf16_t* wat = (const bf16_t*)(ws_ + WS_WAT) + (size_t)((l * 2) * 8 + g) * 4096;
#pragma unroll
      for (int nb = 0; nb < 2; ++nb)
#pragma unroll
          for (int ks = 0; ks < 4; ++ks) { const int off = (32 * nb + ql) * 64 + 16 * ks + 8 * hh; Wa[nb][ks] = *(const bf16x8*)(wat + off); Wx[nb][ks] = *(const bf16x8*)(wat + 8 * 4096 + off); } }
    const size_t tokb = (size_t)b * SEQ + t0;
    float xm3 = 0.f, xm2 = 0.f, xm1 = 0.f;
    if (t0 > 0) { xm3 = bf2f(ZB[(tokb - 3) * DIN + 1536 + c]); xm2 = bf2f(ZB[(tokb - 2) * DIN + 1536 + c]); xm1 = bf2f(ZB[(tokb - 1) * DIN + 1536 + c]); }
    __syncthreads();
#pragma unroll 1
    for (int hf = 0; hf < 2; ++hf) {
        const size_t tk0 = tokb + 32 * hf;
        { bf16_t xr_[32];
#pragma unroll
          for (int tt = 0; tt < 32; ++tt) xr_[tt] = ZB[(tk0 + tt) * DIN + 1536 + c];
#pragma unroll
          for (int tt = 0; tt < 32; ++tt) { const float xv = bf2f(xr_[tt]); ut[tt * 68 + lane] = cbv + w0 * xm3 + w1 * xm2 + w2 * xm1 + w3 * xv; xm3 = xm2; xm2 = xm1; xm1 = xv; } }
        asm volatile("s_waitcnt lgkmcnt(0)" ::: "memory");
        bf16x8 Af[4];
#pragma unroll
        for (int ks = 0; ks < 4; ++ks) { const LAS f32x4* s = (const LAS f32x4*)(ut + ql * 68 + 16 * ks + 8 * hh); const f32x4 x0 = s[0], x1 = s[1];
            u32x4 pw; pw.x = cvt_pk_bf16(x0[0], x0[1]); pw.y = cvt_pk_bf16(x0[2], x0[3]); pw.z = cvt_pk_bf16(x1[0], x1[1]); pw.w = cvt_pk_bf16(x1[2], x1[3]); Af[ks] = __builtin_bit_cast(bf16x8, pw); }
        f32x16 Dr[2], Dx[2];
#pragma unroll
        for (int nb = 0; nb < 2; ++nb) { Dr[nb] = (f32x16){0.f, 0.f, 0.f, 0.f, 0.f, 0.f, 0.f, 0.f, 0.f, 0.f, 0.f, 0.f, 0.f, 0.f, 0.f, 0.f}; Dx[nb] = Dr[nb];
#pragma unroll
            for (int ks = 0; ks < 4; ++ks) { Dr[nb] = __builtin_amdgcn_mfma_f32_32x32x16_bf16(Af[ks], Wa[nb][ks], Dr[nb], 0, 0, 0); Dx[nb] = __builtin_amdgcn_mfma_f32_32x32x16_bf16(Af[ks], Wx[nb][ks], Dx[nb], 0, 0, 0); } }
#pragma unroll
        for (int nb = 0; nb < 2; ++nb)
#pragma unroll
            for (int rr = 0; rr < 16; ++rr) { const int row = (rr & 3) + 8 * (rr >> 2) + 4 * hh; const int o = row * 68 + 32 * nb + ql;
                const float rs = sigm(Dr[nb][rr] + bav[nb]), is = sigm(Dx[nb][rr] + bxv[nb]);
                const float a = __builtin_amdgcn_exp2f(-splv[nb] * rs); const float uv = ut[o];
                const unsigned pk = cvt_pk_bf16(1.0f - a, __builtin_amdgcn_sqrtf(fmaxf(1.0f - a * a, 0.f)) * (is * uv));
                AD[(tk0 + row) * DR + g * 64 + 32 * nb + ql] = pk;
                at[o] = 1.0f - bf_lo(pk); ut[o] = bf_hi(pk); }
        asm volatile("s_waitcnt lgkmcnt(0)" ::: "memory");
#pragma unroll 8
        for (int tt = 0; tt < 32; ++tt) { const float a = at[tt * 68 + lane], d = ut[tt * 68 + lane]; hst = a * hst + d; Ap *= a; }
    }
    { float* ag = AGG + (size_t)(b * 128 + chunk) * 1024 + c; ag[0] = Ap; ag[512] = hst; }
}
__device__ __forceinline__ void rnn_final_unit(const Params& p, LAS unsigned char* lds, int l, int unit) {
    unsigned char* const ws_ = opaque_ptr(p.ws);
    const int tid = opaque_tid(), lane = tid & 63, g = __builtin_amdgcn_readfirstlane(tid >> 6), hh = lane >> 5, ql = lane & 31;
    const int b = unit >> 7, chunk = unit & 127, t0 = chunk * 64;
    const bf16_t* ZB = (const bf16_t*)(ws_ + WS_ZB); const unsigned* AD = (const unsigned*)(ws_ + WS_AD);
    LAS float* at = (LAS float*)(lds + g * 17408);
    LAS float* part = (LAS float*)(lds + 139264);
    const float* AGG = (const float*)(ws_ + WS_AGG);
    const int c = g * 64 + lane;
    const size_t tokb = (size_t)b * SEQ + t0;
    unsigned ad0[32]; bf16_t gr0[32];
#pragma unroll
    for (int tt = 0; tt < 32; ++tt) { ad0[tt] = AD[(tokb + tt) * DR + c]; gr0[tt] = ZB[(tokb + tt) * DIN + 2048 + c]; }
    float hst = 0.f;
    {
        const float* ag = AGG + (size_t)(b * 128) * 1024 + c;
        int cc = 0;
        if (chunk >= 16) {
            float A0[16], H0[16];
#pragma unroll
            for (int q = 0; q < 16; ++q) { A0[q] = ag[(size_t)q * 1024]; H0[q] = ag[(size_t)q * 1024 + 512]; }
            for (cc = 16; cc + 16 <= chunk; cc += 16) { float A1[16], H1[16];
#pragma unroll
                for (int q = 0; q < 16; ++q) { A1[q] = ag[(size_t)(cc + q) * 1024]; H1[q] = ag[(size_t)(cc + q) * 1024 + 512]; }
#pragma unroll
                for (int q = 0; q < 16; ++q) hst = A0[q] * hst + H0[q];
#pragma unroll
                for (int q = 0; q < 16; ++q) { A0[q] = A1[q]; H0[q] = H1[q]; } }
#pragma unroll
            for (int q = 0; q < 16; ++q) hst = A0[q] * hst + H0[q];
        }
        for (; cc + 8 <= chunk; cc += 8) { float A[8], H[8];
#pragma unroll
            for (int q = 0; q < 8; ++q) { A[q] = ag[(size_t)(cc + q) * 1024]; H[q] = ag[(size_t)(cc + q) * 1024 + 512]; }
#pragma unroll
            for (int q = 0; q < 8; ++q) hst = A[q] * hst + H[q]; }
        for (; cc < chunk; ++cc) { const float A = ag[(size_t)cc * 1024], H = ag[(size_t)cc * 1024 + 512]; hst = A * hst + H; }
    }
    __syncthreads();
#pragma unroll
    for (int hf = 0; hf < 2; ++hf) {
        const size_t tk0 = tokb + 32 * hf;
        unsigned ad1[32]; bf16_t gr1[32];
        if (hf == 0) {
#pragma unroll
            for (int tt = 0; tt < 32; ++tt) { ad1[tt] = AD[(tokb + 32 + tt) * DR + c]; gr1[tt] = ZB[(tokb + 32 + tt) * DIN + 2048 + c]; } }
#pragma unroll
        for (int tt = 0; tt < 32; ++tt) { const unsigned pk = ad0[tt]; hst = (1.0f - bf_lo(pk)) * hst + bf_hi(pk);
            const float gv = bf2f(gr0[tt]); const float y2 = 1.5957691216057308f * (gv + 0.044715f * gv * gv * gv);
            at[tt * 68 + lane] = hst * gv * sigm(y2); }
        asm volatile("s_waitcnt lgkmcnt(0)" ::: "memory");
        f32x4 ov[8]; float ss = 0.f;
#pragma unroll
        for (int q = 0; q < 8; ++q) { ov[q] = *(const LAS f32x4*)(at + ql * 68 + 32 * hh + 4 * q); ss += (ov[q][0] * ov[q][0] + ov[q][1] * ov[q][1]) + (ov[q][2] * ov[q][2] + ov[q][3] * ov[q][3]); }
        ss += __shfl_xor(ss, 32);
        if (hh == 0) part[(hf * 32 + ql) * 8 + g] = ss;
        __syncthreads();
        const LAS f32x4* pp = (const LAS f32x4*)(part + (hf * 32 + ql) * 8); const f32x4 p0 = pp[0], p1 = pp[1];
        const float rstd = rsqrtf(((p0[0] + p0[1]) + (p0[2] + p0[3]) + (p1[0] + p1[1]) + (p1[2] + p1[3])) * (1.0f / DR) + EPS);
        bf16_t* mo = (bf16_t*)(ws_ + WS_MIX) + (tk0 + ql) * D + DA + g * 64 + 32 * hh;
#pragma unroll
        for (int q = 0; q < 4; ++q) { u32x4 wv; wv.x = cvt_pk_bf16(ov[2 * q][0] * rstd, ov[2 * q][1] * rstd); wv.y = cvt_pk_bf16(ov[2 * q][2] * rstd, ov[2 * q][3] * rstd);
            wv.z = cvt_pk_bf16(ov[2 * q + 1][0] * rstd, ov[2 * q + 1][1] * rstd); wv.w = cvt_pk_bf16(ov[2 * q + 1][2] * rstd, ov[2 * q + 1][3] * rstd); *(u32x4*)(mo + 8 * q) = wv; }
        if (hf == 0) {
#pragma unroll
            for (int tt = 0; tt < 32; ++tt) { ad0[tt] = ad1[tt]; gr0[tt] = gr1[tt]; } }
    }
}

__device__ __forceinline__ void attn_merge_unit(const Params& p, int unit) {
    unsigned char* const ws_ = opaque_ptr(p.ws);
    const int tid = opaque_tid(), lane = tid & 63, w = tid >> 6;
    const bf16_t* OB = (const bf16_t*)(ws_ + WS_OB); const float* LSE = (const float*)(ws_ + WS_LSE);
#pragma unroll 1
    for (int tg = 0; tg < 8; tg += 4) {
        float ls[4][3]; u32x4 ov[4][3];
#pragma unroll
        for (int t4 = 0; t4 < 4; ++t4) { const size_t tok = (size_t)unit * 64 + w * 8 + tg + t4;
#pragma unroll
            for (int br = 0; br < 3; ++br) { ls[t4][br] = LSE[((size_t)br * M + tok) * NH + (lane >> 3)]; ov[t4][br] = *(const u32x4*)(OB + ((size_t)br * M + tok) * DA + 8 * lane); } }
#pragma unroll
        for (int t4 = 0; t4 < 4; ++t4) { const size_t tok = (size_t)unit * 64 + w * 8 + tg + t4;
            const float mx = fmaxf(ls[t4][0], fmaxf(ls[t4][1], ls[t4][2]));
            float wb[3];
#pragma unroll
            for (int br = 0; br < 3; ++br) wb[br] = __builtin_amdgcn_exp2f(ls[t4][br] - mx);
            const float wi = 1.0f / (wb[0] + wb[1] + wb[2]);
            float o[8];
#pragma unroll
            for (int q = 0; q < 4; ++q) { float lo = 0.f, hi = 0.f;
#pragma unroll
                for (int br = 0; br < 3; ++br) { lo += wb[br] * bf_lo(ov[t4][br][q]); hi += wb[br] * bf_hi(ov[t4][br][q]); }
                o[2 * q] = lo * wi; o[2 * q + 1] = hi * wi; }
            float ss = 0.f;
#pragma unroll
            for (int q = 0; q < 8; ++q) ss += o[q] * o[q];
            ss = wave_sum(ss);
            const float rstd = rsqrtf(ss * (1.0f / DA) + EPS);
            u32x4 wv; wv.x = cvt_pk_bf16(o[0] * rstd, o[1] * rstd); wv.y = cvt_pk_bf16(o[2] * rstd, o[3] * rstd); wv.z = cvt_pk_bf16(o[4] * rstd, o[5] * rstd); wv.w = cvt_pk_bf16(o[6] * rstd, o[7] * rstd);
            *(u32x4*)((bf16_t*)(ws_ + WS_MIX) + tok * D + 8 * lane) = wv; }
    }
}
__device__ __forceinline__ void ph_mix1(const Params& p, LAS unsigned char* lds, int l) {
    SP_DECL;
    SP_BEGIN();
    { unsigned char* const ws_ = opaque_ptr(p.ws); const int tid = opaque_tid();
      { LAS float* T = (LAS float*)(lds + 98304); const float* BT = (const float*)(ws_ + WS_BT); const float* BND = (const float*)(ws_ + WS_BND) + l * 24;
        for (int i = tid; i < 24 * 192; i += NTHR) T[i] = BT[i] - BND[i / 192]; }
      AttnPf pf;
      if (gridDim.x == 256) {
          const int xcd = blockIdx.x & 7, rank = blockIdx.x >> 3;
#define ATT_ITEM(k) ((((k) % 3) << 9) + ((2 * xcd + (k) / 3) << 5) + rank)
          attn_issue((const bf16_t*)(ws_ + WS_ZB), ATT_ITEM(0), tid, pf, 7);
#pragma unroll 1
          for (int k = 0; k < 6; ++k) attn_item(p, lds, l, ATT_ITEM(k), pf, k < 5 ? ATT_ITEM(k + 1) : -1);
#undef ATT_ITEM
      } else {
          int it = blockIdx.x;
          if (it < 1536) attn_issue((const bf16_t*)(ws_ + WS_ZB), it, tid, pf, 7);
          for (; it < 1536; it += gridDim.x) { const int nx = it + (int)gridDim.x; attn_item(p, lds, l, it, pf, nx < 1536 ? nx : -1); }
      } }
    SP_SYNC(); SP_END(1); SP_BEGIN();
    for (int u = blockIdx.x; u < 256; u += gridDim.x) rnn_agg_unit(p, lds, l, xcd_unit(u));
    SP_SYNC(); SP_END(2);
    if (l == 0) convert_queue(p, lds, l, false);
}
__device__ __forceinline__ void ph_mix2(const Params& p, LAS unsigned char* lds, int l) {
    SP_DECL;
    for (int u = blockIdx.x; u < 256; u += gridDim.x) { SP_BEGIN(); rnn_final_unit(p, lds, l, xcd_unit(u)); SP_SYNC(); SP_END(6); SP_BEGIN(); attn_merge_unit(p, xcd_unit(u)); SP_SYNC(); SP_END(7); }
}
#define DYN_LDS extern __shared__ __attribute__((aligned(16))) unsigned char smem_[]; LAS unsigned char* lds = (LAS unsigned char*)smem_

#define XB_TMO      128
#define XB_XCNT(j)  (256  + 64 * (j))
#define XB_XSUB(j)  (1280 + 64 * (j))
#define XB_XGEN(j)  (2304 + 64 * (j))
#define XB_TOP      3328
#define XB_TOPGEN   3392
#define XCD_BAR_WORDS 3456
#define XB_SPIN_CAP (1u << 18)
__device__ __forceinline__ unsigned xb_ld(unsigned* p)              { return __hip_atomic_load(p, __ATOMIC_RELAXED, __HIP_MEMORY_SCOPE_AGENT); }
__device__ __forceinline__ unsigned xb_add(unsigned* p, unsigned v) { return __hip_atomic_fetch_add(p, v, __ATOMIC_RELAXED, __HIP_MEMORY_SCOPE_AGENT); }
__device__ __forceinline__ unsigned xb_xcc_id() { return (unsigned)__builtin_amdgcn_s_getreg((3 << 11) | 20) & 0xFu; }
#define XB_SPIN(cond, bar) do { unsigned _sp = 0; while (cond) { __builtin_amdgcn_s_sleep(1); \
    if ((++_sp & 255u) == 0u) { if (xb_ld(&(bar)[XB_TMO])) break; if (_sp > XB_SPIN_CAP) { atomicAdd(&(bar)[XB_TMO], 1u); break; } } } } while (0)
struct XcdBarrier { unsigned* bar; unsigned x; volatile LAS unsigned* st; };
__device__ __forceinline__ XcdBarrier xcd_barrier_post(unsigned* bar, volatile LAS unsigned* st) {
    XcdBarrier b; b.bar = bar; b.x = xb_xcc_id(); b.st = st;
    if (threadIdx.x == 0) (void)xb_add(&bar[XB_XCNT(b.x)], 1u);
    return b;
}
__device__ __forceinline__ void xcd_barrier_complete(unsigned* bar, unsigned x, unsigned& nloc, unsigned& nx, unsigned& stdc) {
    const unsigned G = gridDim.x * gridDim.y * gridDim.z;
    unsigned sum, cnt, mine, sd, sp = 0u;
    for (;;) {
        sum = 0u; cnt = 0u; mine = 0u; sd = 1u;
#pragma unroll
        for (unsigned j = 0; j < 16; ++j) { const unsigned c = xb_ld(&bar[XB_XCNT(j)]); sum += c; cnt += (c > 0u) ? 1u : 0u; mine = (j == x) ? c : mine; sd = (c == (j < 8u ? 32u : 0u)) ? sd : 0u; }
        if (sum == G) break;
        __builtin_amdgcn_s_sleep(1);
        if ((++sp & 255u) == 0u) { if (xb_ld(&bar[XB_TMO])) break; if (sp > XB_SPIN_CAP) { atomicAdd(&bar[XB_TMO], 1u); break; } }
    }
    nloc = mine > 0u ? mine : 1u; nx = cnt > 0u ? cnt : 1u; stdc = sd;
}
template <int NPW>
__device__ __forceinline__ void xcd_barrier(const XcdBarrier& b, const Params& p, int item_base, int dense_first = 0, int dense_lim = 0) {
    asm volatile("s_waitcnt vmcnt(0)" ::: "memory");
    __syncthreads();
    const int tid = opaque_tid();
    unsigned* bar = b.bar; unsigned old = 0u, gen = 0u, tg = 0u; bool last = false, fin = false;
    const unsigned bx = xb_xcc_id();
    if (tid == 0) {
        size_t zb_ = 0; asm volatile("" : "+s"(zb_)); bar = b.bar + zb_;
        __builtin_amdgcn_s_waitcnt(0);
        unsigned nloc = b.st[0], nx = b.st[1];
        if (nloc == 0u) { unsigned sd; xcd_barrier_complete(bar, bx, nloc, nx, sd); b.st[0] = nloc; b.st[1] = nx; b.st[2] = sd; }
        old = xb_add(&bar[XB_XSUB(bx)], 1u);
        gen = old / nloc;
        last = old + 1u == (gen + 1u) * nloc;
        b.st[3] = b.st[2] ? old - gen * nloc : 0xffffu;
        if (last) {
            __builtin_amdgcn_fence(__ATOMIC_RELEASE, "agent");
            asm volatile("s_waitcnt vmcnt(0)" ::: "memory");
            const unsigned og = xb_add(&bar[XB_TOP], 1u);
            tg = og / nx;
            fin = og + 1u == (tg + 1u) * nx;
            if (fin) xb_add(&bar[XB_TOPGEN], 1u);
        }
    }
    if (item_base >= 0) {
        __syncthreads();
        const unsigned rank = b.st[3];
        if (rank < (unsigned)SLOT_RANKS) {
            unsigned char* const ws_ = opaque_ptr(p.ws);
            const int lane = tid & 63, wave = tid >> 6;
            const int it0 = item_base + ((int)(bx * SLOT_RANKS + rank) * NWAVE + wave) * NPW;
#pragma unroll
            for (int i = 0; i + 2 <= NPW; i += 2) {
                TrItem ta, tb; dec_exp(p, ws_, it0 + i, ta); dec_exp(p, ws_, it0 + i + 1, tb);
                f32x4 va[8], vb[8]; float ga[8], gb[8];
                tr_load(ta, lane, va, ga); tr_load(tb, lane, vb, gb);
                tr_store8(ta, lane, va, ga, nullptr); tr_store8(tb, lane, vb, gb, nullptr); }
            if constexpr (NPW & 1) {
                TrItem t; dec_exp(p, ws_, it0 + NPW - 1, t);
                f32x4 v[8]; float g[8];
                tr_load(t, lane, v, g); tr_store8(t, lane, v, g, nullptr); }
            { const int di = dense_first + ((int)(bx * SLOT_RANKS + rank) * NWAVE + wave);
              if (di < dense_lim) { TrItem t; dec_dense(p, ws_, di, t); f32x4 v[8]; float g[8]; tr_load(t, lane, v, g); tr_store(t, lane, v, g, nullptr); } }
        }
    }
    if (tid == 0) {
        if (last) {
            if (!fin) XB_SPIN(xb_ld(&bar[XB_TOPGEN]) == tg, bar);
            __builtin_amdgcn_fence(__ATOMIC_ACQUIRE, "agent");
            xb_add(&bar[XB_XGEN(bx)], 1u);
            asm volatile("s_waitcnt vmcnt(0)" ::: "memory");
        } else {
            XB_SPIN(xb_ld(&bar[XB_XGEN(bx)]) == gen, bar);
            __builtin_amdgcn_fence(__ATOMIC_ACQUIRE, "agent");
            asm volatile("s_waitcnt vmcnt(0)" ::: "memory");
        }
    }
    __syncthreads();
}

__global__ void __launch_bounds__(512, 2) k_fused(Params p) {
    DYN_LDS;
    if (threadIdx.x < 64) ((LAS unsigned*)(lds + LDS_MISC))[threadIdx.x] = 0u;
    __syncthreads();
    XcdBarrier bar = xcd_barrier_post((unsigned*)(p.ws + WS_CTL), (volatile LAS unsigned*)(lds + LDS_MISC));
    const float* x_in = p.in[0]; float* X = p.out;
    const int* counts = (const int*)(p.ws + WS_CNT);
#ifndef PROBE_MASK
#define PROBE_MASK 0
#endif
#ifndef BARPROBE
#define BARPROBE 0
#endif
#if BARPROBE
#define BAR(id, j, ...) do { const unsigned long long tb_ = __builtin_amdgcn_s_memrealtime(); xcd_barrier<SLOT_N[j]>(bar, p, __VA_ARGS__); if (BARPROBE == (id)) bacc += __builtin_amdgcn_s_memrealtime() - tb_; } while (0)
#else
#define BAR(id, j, ...) xcd_barrier<SLOT_N[j]>(bar, p, __VA_ARGS__)
#endif
#if PROBE_MASK
    unsigned long long tacc = 0, tp = 0;
#define PH_BEGIN() tp = __builtin_amdgcn_s_memrealtime()
#define PH_END(g) do { if (PROBE_MASK & (1 << (g))) tacc += __builtin_amdgcn_s_memrealtime() - tp; } while (0)
#else
#define PH_BEGIN() do {} while (0)
#define PH_END(g) do {} while (0)
#endif
#if BARPROBE
    unsigned long long bacc = 0;
#endif
    PH_BEGIN();
    ph_prologue(p, lds, 3);
    ph_norm(p, lds, x_in, nullptr, 0, nullptr, true, -1);
    BAR(0, 3, slot_off(3)); PH_END(0);
    for (int l = 0; l < DEPTH; ++l) {
        const int cur = l * CONV_ITEMS, nxt = l + 1 < DEPTH ? (l + 1) * CONV_ITEMS : -(1 << 28);
        const int dn = l + 1 < DEPTH ? (l + 1) * PER_L : 0, dl = l + 1 < DEPTH ? dn + PER_L : 0;
        PH_BEGIN(); ph_win(p, lds, l);                               BAR(1, 4, cur + slot_off(4), dn, dl); PH_END(1);
        PH_BEGIN(); ph_mix1(p, lds, l);                              BAR(2, 5, cur + slot_off(5), dn + DSLOT, dl); PH_END(2);
        PH_BEGIN(); ph_mix2(p, lds, l);                              BAR(3, 6, cur + slot_off(6)); PH_END(3);
        PH_BEGIN(); ph_wout(p, lds, l);                              BAR(4, 7, cur + slot_off(7)); PH_END(1);
        PH_BEGIN(); ph_router(p, lds, l);                            BAR(5, 0, nxt + slot_off(0)); PH_END(4);
        PH_BEGIN(); ph_gateup(p, lds, l);                            BAR(6, 1, nxt + slot_off(1)); PH_END(5);
        PH_BEGIN(); ph_down(p, lds, l);                              BAR(7, 2, nxt + slot_off(2)); PH_END(5);
        PH_BEGIN(); ph_norm(p, lds, nullptr, X, 1, counts + l * NE * CNT_STRIDE, l < DEPTH - 1, -1);
        if (l < DEPTH - 1) BAR(8, 3, nxt + slot_off(3));
        PH_END(6);
    }
#if PROBE_MASK
    { const unsigned long long t0 = __builtin_amdgcn_s_memrealtime(); while (__builtin_amdgcn_s_memrealtime() - t0 < tacc) __builtin_amdgcn_s_sleep(8); }
#endif
#if BARPROBE
    { const unsigned long long t0 = __builtin_amdgcn_s_memrealtime(); while (__builtin_amdgcn_s_memrealtime() - t0 < bacc) __builtin_amdgcn_s_sleep(8); }
#endif
#if SUBPROBE
    { __syncthreads(); const unsigned long long tw = *(volatile LAS unsigned*)(lds + LDS_MISC + 64); const unsigned long long t0 = __builtin_amdgcn_s_memrealtime(); while (__builtin_amdgcn_s_memrealtime() - t0 < tw) __builtin_amdgcn_s_sleep(8); }
#endif
}
}

extern "C" void kernel_launch(void* const* d_in, const int* in_sizes, int n_in, void* d_out, int out_size, void* d_ws, size_t ws_size, hipStream_t stream) {
    static int grid = 0;
    if (!grid) {
        (void)hipFuncSetAttribute((const void*)k_fused, hipFuncAttributeMaxDynamicSharedMemorySize, LDS_BYTES);
        int dev = 0, cus = 0, per_cu = 0;
        (void)hipGetDevice(&dev); (void)hipDeviceGetAttribute(&cus, hipDeviceAttributeMultiprocessorCount, dev);
        (void)hipOccupancyMaxActiveBlocksPerMultiprocessor(&per_cu, (const void*)k_fused, 512, LDS_BYTES);
        if (per_cu < 1) fprintf(stderr, "kernel_launch: occupancy query reports %d blocks per CU\n", per_cu);
        (void)hipGetLastError();
        grid = cus > 0 ? cus : 256;
        if (ws_size < WS_END) fprintf(stderr, "kernel_launch: ws_size %zu smaller than expected\n", ws_size);
    }
    Params p{}; for (int i = 0; i < 24; ++i) p.in[i] = (const float*)d_in[i]; p.out = (float*)d_out; p.ws = (unsigned char*)d_ws;
    (void)hipMemsetAsync((unsigned char*)d_ws + WS_CTL, 0, CTL_ZERO, stream);
    k_fused<<<grid, 512, LDS_BYTES, stream>>>(p);
}
```
